# Optimizing an MI355X kernel written in HIP

```python
import jax, jax.numpy as jnp
from jax import lax
import numpy as np

D_MODEL = 1024
BATCH = 8
SEQ = 2048
DEPTH = 4

ROPE_THETA = 10000.0
ROPE_DIM = 64
EPS = 1e-6
NEG_INF = -1e30
ADA_CHUNKS = 6

MLA_HEADS = 8
MLA_Q_RANK = 768
MLA_KV_RANK = 512
MLA_NOPE = 128
MLA_ROPE = ROPE_DIM
MLA_V = 128
MLA_Q_BLOCK = 128

DIL_PAIRS = ((128, 1), (512, 4), (2048, 16))
DIL_GROUPS = len(DIL_PAIRS)
DIL_HEADS = 8
DIL_HEAD_DIM = ROPE_DIM
DIL_BLOCK = 64
DIL_W = DIL_GROUPS * DIL_HEADS * DIL_HEAD_DIM

RET_HEADS = 8
RET_QK_DIM = ROPE_DIM
RET_V_DIM = 2 * RET_QK_DIM
RET_CHUNK = 128
RET_QK_W = RET_HEADS * RET_QK_DIM
RET_V_W = RET_HEADS * RET_V_DIM

IN_SPLITS = (MLA_Q_RANK, MLA_KV_RANK, MLA_ROPE,
             DIL_W, DIL_W, DIL_W,
             RET_QK_W, RET_QK_W, RET_V_W, RET_V_W,
             D_MODEL, D_MODEL, D_MODEL)
IN_COLS = sum(IN_SPLITS)

D_FF = 2816
N_EXPERTS = 8
TOP_K = 2
D_FF_EXPERT = 3584
MOE_BLOCK = 256
N_DENSE = (DEPTH + 1) // 2
N_MOE = DEPTH // 2

kernel_name = 'hybrid_mla_dilated_retention_moe_encoder'


def rmsnorm(x, g):
    xf = x.astype(jnp.float32)
    y = xf * lax.rsqrt(jnp.mean(xf * xf, axis=-1, keepdims=True) + EPS)
    return (y * g.astype(jnp.float32)).astype(x.dtype)


def rope_tables(positions):
    inv_freq = ROPE_THETA ** (-jnp.arange(0, ROPE_DIM, 2, dtype=jnp.float32) / ROPE_DIM)
    ang = positions.astype(jnp.float32)[..., None] * inv_freq
    return jnp.cos(ang), jnp.sin(ang)


def apply_rope(t, cos, sin):
    c = cos[:, :, None, :].astype(t.dtype)
    s = sin[:, :, None, :].astype(t.dtype)
    t1, t2 = jnp.split(t, 2, axis=-1)
    return jnp.concatenate([t1 * c - t2 * s, t2 * c + t1 * s], axis=-1)


def split_columns(t, sizes):
    out, start = [], 0
    for n in sizes:
        out.append(t[..., start:start + n])
        start += n
    return out


def mla_attention(q_nope, q_rope, k_nope, k_rope, v):
    B_, S_, H, _ = q_nope.shape
    nqb = S_ // MLA_Q_BLOCK
    scale = (MLA_NOPE + MLA_ROPE) ** -0.5

    def blocks(t):
        return jnp.moveaxis(t.reshape((B_, nqb, MLA_Q_BLOCK) + t.shape[2:]), 1, 0)

    def attend(qs):
        qn, qr = qs
        s = (jnp.einsum('bqhd,bkhd->bhqk', qn, k_nope)
             + jnp.einsum('bqhr,bkr->bhqk', qr, k_rope))
        p = jax.nn.softmax(s.astype(jnp.float32) * scale, axis=-1).astype(v.dtype)
        return jnp.einsum('bhqk,bkhd->bqhd', p, v)

    o = lax.map(attend, (blocks(q_nope), blocks(q_rope)))
    return jnp.moveaxis(o, 0, 1).reshape(B_, S_, H * MLA_V)


def dilated_attention(q, k, v, dilation, band):
    B_, S_, H, dh = q.shape
    L = S_ // dilation
    nb = -(-L // DIL_BLOCK)
    Lp = nb * DIL_BLOCK

    def sub(t):
        t = t.reshape(B_, L, dilation, H, dh).transpose(0, 2, 1, 3, 4)
        return jnp.pad(t, ((0, 0), (0, 0), (0, Lp - L), (0, 0), (0, 0)))

    def neighbours(t):
        tp = jnp.pad(t, ((0, 0), (0, 0), (DIL_BLOCK, DIL_BLOCK), (0, 0), (0, 0)))
        tp = tp.reshape(B_, dilation, nb + 2, DIL_BLOCK, H, dh)
        return jnp.concatenate([tp[:, :, :-2], tp[:, :, 1:-1], tp[:, :, 2:]], axis=3)

    qb = sub(q).reshape(B_, dilation, nb, DIL_BLOCK, H, dh)
    kw = neighbours(sub(k))
    vw = neighbours(sub(v))
    jq = jnp.arange(nb)[:, None] * DIL_BLOCK + jnp.arange(DIL_BLOCK)[None, :]
    jk = (jnp.arange(nb)[:, None] - 1) * DIL_BLOCK + jnp.arange(3 * DIL_BLOCK)[None, :]
    valid = ((jnp.abs(jq[:, :, None] - jk[:, None, :]) <= band)
             & (jk[:, None, :] >= 0) & (jk[:, None, :] < L))
    s = jnp.einsum('brnqhd,brnkhd->brnhqk', qb, kw).astype(jnp.float32) * (dh ** -0.5)
    s = jnp.where(valid[None, None, :, None], s, NEG_INF)
    lse = jax.nn.logsumexp(s, axis=-1, keepdims=True)
    p = jnp.exp(s - lse).astype(v.dtype)
    o = jnp.einsum('brnhqk,brnkhd->brnqhd', p, vw)
    lse = lse[..., 0].transpose(0, 1, 2, 4, 3)

    def unsub(t):
        t = t.reshape((B_, dilation, Lp) + t.shape[4:])[:, :, :L]
        t = jnp.moveaxis(t, 1, 2)
        return t.reshape((B_, S_) + t.shape[3:])

    return unsub(o), unsub(lse)


def retention_scan(q, k, v, log_gamma, inclusive):
    B_, S_, H, dk = q.shape
    dv = v.shape[-1]
    C = RET_CHUNK
    nc = S_ // C

    def chunks(t):
        return t.reshape(B_, nc, C, H, t.shape[-1]).transpose(1, 0, 3, 2, 4)

    idx = jnp.arange(C, dtype=jnp.float32)
    diff = idx[:, None] - idx[None, :]
    mask = (diff >= 0) if inclusive else (diff > 0)
    intra = jnp.where(mask, jnp.exp(log_gamma[:, None, None] * jnp.where(mask, diff, 0.0)), 0.0)
    q_dec = jnp.exp(log_gamma[:, None] * (idx + 1.0))[:, :, None]
    k_dec = jnp.exp(log_gamma[:, None] * (C - 1.0 - idx))[:, :, None]
    c_dec = jnp.exp(log_gamma * C)[:, None, None]

    def step(state, inp):
        qc, kc, vc = inp
        s = jnp.einsum('bhqd,bhkd->bhqk', qc, kc) * intra
        y = (jnp.einsum('bhqk,bhkv->bhqv', s, vc)
             + jnp.einsum('bhqd,bhdv->bhqv', qc, state) * q_dec)
        state = c_dec * state + jnp.einsum('bhkd,bhkv->bhdv', kc * k_dec, vc)
        return state, y

    init = jnp.zeros((B_, H, dk, dv), jnp.float32)
    _, ys = lax.scan(step, init, (chunks(q), chunks(k), chunks(v)))
    return ys.transpose(1, 0, 3, 2, 4).reshape(B_, S_, H, dv)


def token_mixer(h, cos, sin, w_in, q_norm, w_uq, kv_norm, w_ukv, ret_log_decay, ret_norm,
                w_br_mla, w_br_dil, w_br_ret, w_out):
    B_, S_, _ = h.shape
    proj = jnp.einsum('bsd,dn->bsn', h, w_in)
    (cq, ckv, kr, dq, dk, dv, rq, rk, rv, rg, ga, gb, gc) = split_columns(proj, IN_SPLITS)

    cq = rmsnorm(cq, q_norm)
    ckv = rmsnorm(ckv, kv_norm)
    q = jnp.einsum('bsr,rn->bsn', cq, w_uq).reshape(B_, S_, MLA_HEADS, MLA_NOPE + MLA_ROPE)
    q_nope = q[..., :MLA_NOPE]
    q_rope = apply_rope(q[..., MLA_NOPE:], cos, sin)
    kv = jnp.einsum('bsr,rn->bsn', ckv, w_ukv).reshape(B_, S_, MLA_HEADS, MLA_NOPE + MLA_V)
    k_nope, v_mla = kv[..., :MLA_NOPE], kv[..., MLA_NOPE:]
    k_rope = apply_rope(kr[:, :, None, :], cos, sin)[:, :, 0]
    y_mla = mla_attention(q_nope, q_rope, k_nope, k_rope, v_mla)

    n_dh = DIL_GROUPS * DIL_HEADS
    qd = apply_rope(dq.reshape(B_, S_, n_dh, DIL_HEAD_DIM), cos, sin)
    kd = apply_rope(dk.reshape(B_, S_, n_dh, DIL_HEAD_DIM), cos, sin)
    qd = qd.reshape(B_, S_, DIL_GROUPS, DIL_HEADS, DIL_HEAD_DIM)
    kd = kd.reshape(B_, S_, DIL_GROUPS, DIL_HEADS, DIL_HEAD_DIM)
    vd = dv.reshape(B_, S_, DIL_GROUPS, DIL_HEADS, DIL_HEAD_DIM)
    outs, lses = [], []
    for g, (window, dilation) in enumerate(DIL_PAIRS):
        o, lse = dilated_attention(qd[:, :, g], kd[:, :, g], vd[:, :, g], dilation, window // (2 * dilation))
        outs.append(o)
        lses.append(lse)
    outs = jnp.stack(outs)
    wts = jax.nn.softmax(jnp.stack(lses), axis=0)
    y_dil = jnp.sum(wts[..., None].astype(outs.dtype) * outs, axis=0).reshape(B_, S_, DIL_HEADS * DIL_HEAD_DIM)

    rq = apply_rope(rq.reshape(B_, S_, RET_HEADS, RET_QK_DIM), cos, sin).astype(jnp.float32)
    rk = (apply_rope(rk.reshape(B_, S_, RET_HEADS, RET_QK_DIM), cos, sin).astype(jnp.float32)
          * (RET_QK_DIM ** -0.5))
    rv = rv.reshape(B_, S_, RET_HEADS, RET_V_DIM).astype(jnp.float32)
    ld = ret_log_decay.astype(jnp.float32)
    fwd = retention_scan(rq, rk, rv, ld[0], True)
    bwd = jnp.flip(retention_scan(jnp.flip(rq, 1), jnp.flip(rk, 1), jnp.flip(rv, 1), ld[1], False), 1)
    yr = fwd + bwd
    mu = jnp.mean(yr, axis=-1, keepdims=True)
    var = jnp.mean(jnp.square(yr - mu), axis=-1, keepdims=True)
    yr = ((yr - mu) * lax.rsqrt(var + EPS)).reshape(B_, S_, RET_V_W) * ret_norm.astype(jnp.float32)
    y_ret = (jax.nn.silu(rg.astype(jnp.float32)) * yr).astype(h.dtype)

    merged = (jax.nn.sigmoid(ga) * jnp.dot(y_mla, w_br_mla)
              + jax.nn.sigmoid(gb) * jnp.dot(y_dil, w_br_dil)
              + jax.nn.sigmoid(gc) * jnp.dot(y_ret, w_br_ret))
    return jnp.dot(merged, w_out)


def swiglu(h, w1, w3, w2):
    return jnp.dot(jax.nn.silu(jnp.dot(h, w1)) * jnp.dot(h, w3), w2)


def moe_swiglu(h, w_router, w1, w3, w2):
    B_, S_, D = h.shape
    t = h.reshape(-1, D)
    T = t.shape[0]
    logits = jnp.dot(t, w_router).astype(jnp.float32)
    top_val, top_idx = lax.top_k(logits, TOP_K)
    top_w = jax.nn.softmax(top_val, axis=-1)
    A = T * TOP_K
    e_flat = top_idx.reshape(-1)
    tok_flat = jnp.arange(A, dtype=jnp.int32) // TOP_K
    w_flat = top_w.reshape(-1)
    order = jnp.argsort(e_flat)
    e_sorted = e_flat[order]
    counts = jnp.bincount(e_flat, length=N_EXPERTS)
    starts = jnp.cumsum(counts) - counts
    padded = (counts + MOE_BLOCK - 1) // MOE_BLOCK * MOE_BLOCK
    pends = jnp.cumsum(padded)
    pstarts = pends - padded
    dest = pstarts[e_sorted] + (jnp.arange(A) - starts[e_sorted])
    NB = -(-A // MOE_BLOCK) + N_EXPERTS
    R = NB * MOE_BLOCK
    row_tok = jnp.zeros((R,), jnp.int32).at[dest].set(tok_flat[order])
    row_w = jnp.zeros((R,), jnp.float32).at[dest].set(w_flat[order])
    block_expert = jnp.minimum(jnp.searchsorted(pends, jnp.arange(NB) * MOE_BLOCK, side='right'), N_EXPERTS - 1)

    def expert_block(args):
        tok, e = args
        xb = t[tok]
        hb = jax.nn.silu(jnp.dot(xb, w1[e])) * jnp.dot(xb, w3[e])
        return jnp.dot(hb, w2[e])

    yb = lax.map(expert_block, (row_tok.reshape(NB, MOE_BLOCK), block_expert)).reshape(R, D)
    y = jax.ops.segment_sum(yb * row_w[:, None].astype(yb.dtype), row_tok, num_segments=T)
    return y.reshape(B_, S_, D)


def setup_inputs(seed: int = 0) -> dict:
    key = jax.random.key(seed)
    keys = iter(jax.random.split(key, 32))
    f32 = jnp.float32

    def w(shape, fan_in, scale=1.0):
        return jax.random.normal(next(keys), shape, f32) * (scale * fan_in ** -0.5)

    def gain(shape):
        return 1.0 + 0.05 * jax.random.normal(next(keys), shape, f32)

    x = jax.random.normal(next(keys), (BATCH, SEQ, D_MODEL), f32)
    c = jax.random.normal(next(keys), (BATCH, D_MODEL), f32)
    positions = (jnp.arange(SEQ, dtype=jnp.int32)[None, :]
                 + jax.random.randint(next(keys), (BATCH, 1), 0, 4096, dtype=jnp.int32))
    ada_w = w((DEPTH, D_MODEL, ADA_CHUNKS * D_MODEL), D_MODEL, 0.5)
    ada_b = 0.01 * jax.random.normal(next(keys), (DEPTH, ADA_CHUNKS * D_MODEL), f32)
    norm_mix = gain((DEPTH, D_MODEL))
    norm_ffn = gain((DEPTH, D_MODEL))
    w_in = w((DEPTH, D_MODEL, IN_COLS), D_MODEL)
    mla_q_norm = gain((DEPTH, MLA_Q_RANK))
    mla_w_uq = w((DEPTH, MLA_Q_RANK, MLA_HEADS * (MLA_NOPE + MLA_ROPE)), MLA_Q_RANK)
    mla_kv_norm = gain((DEPTH, MLA_KV_RANK))
    mla_w_ukv = w((DEPTH, MLA_KV_RANK, MLA_HEADS * (MLA_NOPE + MLA_V)), MLA_KV_RANK)
    expo = -(5.0 + jnp.arange(RET_HEADS, dtype=f32)) + 0.1 * jax.random.normal(next(keys), (DEPTH, 2, RET_HEADS), f32)
    ret_log_decay = jnp.log1p(-jnp.exp2(expo))
    ret_norm = gain((DEPTH, RET_V_W))
    w_br_mla = w((DEPTH, MLA_HEADS * MLA_V, D_MODEL), MLA_HEADS * MLA_V)
    w_br_dil = w((DEPTH, DIL_HEADS * DIL_HEAD_DIM, D_MODEL), DIL_HEADS * DIL_HEAD_DIM)
    w_br_ret = w((DEPTH, RET_V_W, D_MODEL), RET_V_W)
    w_out = w((DEPTH, D_MODEL, D_MODEL), D_MODEL)
    ffn_w1 = w((N_DENSE, D_MODEL, D_FF), D_MODEL)
    ffn_w3 = w((N_DENSE, D_MODEL, D_FF), D_MODEL)
    ffn_w2 = w((N_DENSE, D_FF, D_MODEL), D_FF)
    moe_router = w((N_MOE, D_MODEL, N_EXPERTS), D_MODEL)
    moe_w1 = w((N_MOE, N_EXPERTS, D_MODEL, D_FF_EXPERT), D_MODEL)
    moe_w3 = w((N_MOE, N_EXPERTS, D_MODEL, D_FF_EXPERT), D_MODEL)
    moe_w2 = w((N_MOE, N_EXPERTS, D_FF_EXPERT, D_MODEL), D_FF_EXPERT)
    final_norm = gain((D_MODEL,))
    return {'x': x, 'c': c, 'positions': positions, 'ada_w': ada_w, 'ada_b': ada_b,
            'norm_mix': norm_mix, 'norm_ffn': norm_ffn, 'w_in': w_in,
            'mla_q_norm': mla_q_norm, 'mla_w_uq': mla_w_uq, 'mla_kv_norm': mla_kv_norm, 'mla_w_ukv': mla_w_ukv,
            'ret_log_decay': ret_log_decay, 'ret_norm': ret_norm,
            'w_br_mla': w_br_mla, 'w_br_dil': w_br_dil, 'w_br_ret': w_br_ret, 'w_out': w_out,
            'ffn_w1': ffn_w1, 'ffn_w3': ffn_w3, 'ffn_w2': ffn_w2,
            'moe_router': moe_router, 'moe_w1': moe_w1, 'moe_w3': moe_w3, 'moe_w2': moe_w2,
            'final_norm': final_norm}


def reference(x, c, positions, ada_w, ada_b, norm_mix, norm_ffn, w_in,
              mla_q_norm, mla_w_uq, mla_kv_norm, mla_w_ukv, ret_log_decay, ret_norm,
              w_br_mla, w_br_dil, w_br_ret, w_out, ffn_w1, ffn_w3, ffn_w2,
              moe_router, moe_w1, moe_w3, moe_w2, final_norm):
    cos, sin = rope_tables(positions)
    c_act = jax.nn.silu(c)
    for layer in range(DEPTH):
        mod = jnp.dot(c_act, ada_w[layer]) + ada_b[layer]
        shift1, scale1, gate1, shift2, scale2, gate2 = jnp.split(mod[:, None, :], ADA_CHUNKS, axis=-1)
        h = rmsnorm(x, norm_mix[layer]) * (1.0 + scale1) + shift1
        x = x + gate1 * token_mixer(h, cos, sin, w_in[layer], mla_q_norm[layer], mla_w_uq[layer],
                                    mla_kv_norm[layer], mla_w_ukv[layer], ret_log_decay[layer],
                                    ret_norm[layer], w_br_mla[layer], w_br_dil[layer],
                                    w_br_ret[layer], w_out[layer])
        h = rmsnorm(x, norm_ffn[layer]) * (1.0 + scale2) + shift2
        if layer % 2 == 0:
            i = layer // 2
            f = swiglu(h, ffn_w1[i], ffn_w3[i], ffn_w2[i])
        else:
            i = layer // 2
            f = moe_swiglu(h, moe_router[i], moe_w1[i], moe_w3[i], moe_w2[i])
        x = x + gate2 * f
    return rmsnorm(x, final_norm)
```

```cpp
#include <hip/hip_runtime.h>
#include <cstdio>
#include <cstdint>
#include <cmath>

#define LAS __attribute__((address_space(3)))
typedef unsigned short bf16_t;
typedef short bf16x8 __attribute__((ext_vector_type(8)));
typedef short s16x4 __attribute__((ext_vector_type(4)));
typedef float f32x4 __attribute__((ext_vector_type(4)));
typedef float f32x16 __attribute__((ext_vector_type(16)));
typedef unsigned u32x4 __attribute__((ext_vector_type(4)));
typedef unsigned u32x2 __attribute__((ext_vector_type(2)));

constexpr int T = 16384, DM = 1024, SEQ = 2048, NB_ = 8, DEPTH = 4;
constexpr int IN_COLS = 12096, NIN = 12288;
constexpr int PLAIN_W = 7936, ROPE_W = 4352;
constexpr int QW = 1536, KVW = 2048;
constexpr int DFF = 2816, DFE = 3584, NEXP = 8;
constexpr int MOE_ROWS = (T * 2 / 256 + NEXP) * 256;
constexpr int MOE_NB = MOE_ROWS / 256;
constexpr float EPS = 1e-6f;
constexpr int PC_CQ = 0, PC_CKV = 768, PC_DV = 1280, PC_RV = 2816, PC_RG = 3840, PC_GA = 4864, PC_GB = 5888, PC_GC = 6912;
constexpr int RS_KR = 0, RS_DQ = 1, RS_DK = 25, RS_RQ = 49, RS_RK = 57;

constexpr size_t MiB = 1ull << 20;
constexpr size_t WS_CTL = 0;                       constexpr size_t CTL_BYTES = 1 * MiB;
constexpr size_t WS_MODP = 1 * MiB;
constexpr size_t WS_MOD = 14 * MiB;
constexpr size_t WS_COS = 15 * MiB, WS_SIN = 17 * MiB;
constexpr size_t WS_SSQ = 19 * MiB;
constexpr size_t WS_MOEI = 21 * MiB;
constexpr size_t WS_LSE = 22 * MiB;
constexpr size_t WS_WIN = 24 * MiB;
constexpr size_t WS_WUQ = WS_WIN + 96 * MiB;
constexpr size_t WS_WUKV = WS_WUQ + 9 * MiB;
constexpr size_t WS_WBM = WS_WUKV + 8 * MiB;
constexpr size_t WS_WBD = WS_WBM + 8 * MiB;
constexpr size_t WS_WBR = WS_WBD + 4 * MiB;
constexpr size_t WS_WO = WS_WBR + 8 * MiB;
constexpr size_t WS_W13 = WS_WO + 8 * MiB;
constexpr size_t WS_W2 = WS_W13 + 22 * MiB;
constexpr size_t WS_W13E = WS_W2 + 11 * MiB;
constexpr size_t WS_W2E = WS_W13E + 112 * MiB;
constexpr size_t WS_H = WS_W2E + 56 * MiB;
constexpr size_t WS_PLAIN = WS_H + 32 * MiB;
constexpr size_t WS_ROPE = WS_PLAIN + 248 * MiB;
constexpr size_t WS_Q = WS_ROPE + 136 * MiB;
constexpr size_t WS_KV = WS_Q + 48 * MiB;
constexpr size_t WS_YMLA = WS_KV + 64 * MiB;
constexpr size_t WS_YDIL = WS_YMLA + 32 * MiB;
constexpr size_t WS_YRET = WS_YDIL + 16 * MiB;
constexpr size_t WS_DILO = WS_YRET + 32 * MiB;
constexpr size_t WS_YRF = WS_DILO + 48 * MiB;
constexpr size_t WS_YRB = WS_YRF + 32 * MiB;
constexpr size_t WS_MB = WS_YRB + 32 * MiB;
constexpr size_t WS_END = WS_MB + 32 * MiB;
constexpr size_t WS_MF = WS_KV;
constexpr size_t WS_HID = WS_PLAIN;
constexpr size_t WS_XG = WS_ROPE;
constexpr size_t WS_YB = WS_ROPE + 68 * MiB;
static_assert((size_t)MOE_ROWS * DFE * 2 <= 248 * MiB, "hid");
static_assert((size_t)MOE_ROWS * DM * 2 <= 68 * MiB, "xg");
constexpr int MI_TOKE = 0;
constexpr int MI_TOKW = 2 * T;
constexpr int MI_TOKP = 4 * T;
constexpr int MI_CNT = 6 * T;
constexpr int MI_BLK = 6 * T + 2048 * 8;
static_assert((MI_BLK + 256) * 4 <= (int)MiB, "moei");

constexpr int LDS_RING = 131072;
constexpr int LDS_MISC = LDS_RING;
constexpr int LDS_BYTES = 147456;

__device__ __forceinline__ float bf2f(unsigned b) { return __uint_as_float(b << 16); }
__device__ __forceinline__ unsigned f2bf(float f) { unsigned u = __float_as_uint(f); return (u + 0x7fffu + ((u >> 16) & 1u)) >> 16; }
__device__ __forceinline__ unsigned pk2(float lo, float hi) { unsigned r; asm volatile("v_cvt_pk_bf16_f32 %0, %1, %2" : "=v"(r) : "v"(lo), "v"(hi)); return r; }
__device__ __forceinline__ float fsigmoid(float x) { return 1.0f / (1.0f + __expf(-x)); }
__device__ __forceinline__ float fsilu(float x) { return x / (1.0f + __expf(-x)); }
__device__ __forceinline__ int opaque(int x) { asm volatile("" : "+v"(x)); return x; }
__device__ __forceinline__ float wave_sum(float v) {
#pragma unroll
    for (int o = 1; o < 64; o <<= 1) v += __shfl_xor(v, o);
    return v;
}

#define XB_TMO      128
#define XB_XCNT(j)  (256  + 64 * (j))
#define XB_XSUB(j)  (1280 + 64 * (j))
#define XB_XGEN(j)  (2304 + 64 * (j))
#define XB_TOP      3328
#define XB_TOPGEN   3392
#define XCD_BAR_WORDS 3456
#define XB_SPIN_CAP (1u << 24)
__device__ __forceinline__ unsigned xb_ld(unsigned* p)              { return __hip_atomic_load(p, __ATOMIC_RELAXED, __HIP_MEMORY_SCOPE_AGENT); }
__device__ __forceinline__ unsigned xb_add(unsigned* p, unsigned v) { return __hip_atomic_fetch_add(p, v, __ATOMIC_RELAXED, __HIP_MEMORY_SCOPE_AGENT); }
__device__ __forceinline__ unsigned xb_xcc_id() { return (unsigned)__builtin_amdgcn_s_getreg((3 << 11) | 20) & 0xFu; }
#define XB_SPIN(cond, bar) do { unsigned _sp = 0; while (cond) { __builtin_amdgcn_s_sleep(1); \
    if ((++_sp & 255u) == 0u) { if (xb_ld(&(bar)[XB_TMO])) break; if (_sp > XB_SPIN_CAP) { atomicAdd(&(bar)[XB_TMO], 1u); break; } } } } while (0)
struct XcdBarrier { unsigned* bar; unsigned x; volatile LAS unsigned* st; };
__device__ __forceinline__ XcdBarrier xcd_barrier_post(unsigned* bar, volatile LAS unsigned* st) {
    XcdBarrier b; b.bar = bar; b.x = xb_xcc_id(); b.st = st;
    if (threadIdx.x == 0) (void)xb_add(&bar[XB_XCNT(b.x)], 1u);
    return b;
}
__device__ __forceinline__ void xcd_barrier_complete(unsigned* bar, unsigned x, unsigned& nloc, unsigned& nx) {
    const unsigned G = gridDim.x * gridDim.y * gridDim.z;
    unsigned sum, cnt, mine, sp = 0u;
    for (;;) {
        sum = 0u; cnt = 0u; mine = 0u;
#pragma unroll
        for (unsigned j = 0; j < 16; ++j) { const unsigned c = xb_ld(&bar[XB_XCNT(j)]); sum += c; cnt += (c > 0u) ? 1u : 0u; mine = (j == x) ? c : mine; }
        if (sum == G) break;
        __builtin_amdgcn_s_sleep(1);
        if ((++sp & 255u) == 0u) { if (xb_ld(&bar[XB_TMO])) break; if (sp > XB_SPIN_CAP) { atomicAdd(&bar[XB_TMO], 1u); break; } }
    }
    nloc = mine > 0u ? mine : 1u; nx = cnt > 0u ? cnt : 1u;
}
__device__ __forceinline__ void xcd_barrier(const XcdBarrier& b) {
    asm volatile("s_waitcnt vmcnt(0)" ::: "memory");
    __syncthreads();
    if (threadIdx.x == 0) {
        unsigned* bar = b.bar;
        __builtin_amdgcn_s_waitcnt(0);
        unsigned nloc = b.st[0], nx = b.st[1];
        if (nloc == 0u) { xcd_barrier_complete(bar, b.x, nloc, nx); b.st[0] = nloc; b.st[1] = nx; }
        const unsigned old = xb_add(&bar[XB_XSUB(b.x)], 1u);
        const unsigned gen = old / nloc;
        if (old + 1u == (gen + 1u) * nloc) {
            __builtin_amdgcn_fence(__ATOMIC_RELEASE, "agent");
            asm volatile("s_waitcnt vmcnt(0)" ::: "memory");
            const unsigned og = xb_add(&bar[XB_TOP], 1u);
            const unsigned tg = og / nx;
            if (og + 1u == (tg + 1u) * nx) xb_add(&bar[XB_TOPGEN], 1u);
            else XB_SPIN(xb_ld(&bar[XB_TOPGEN]) == tg, bar);
            __builtin_amdgcn_fence(__ATOMIC_ACQUIRE, "agent");
            xb_add(&bar[XB_XGEN(b.x)], 1u);
            asm volatile("s_waitcnt vmcnt(0)" ::: "memory");
        } else {
            XB_SPIN(xb_ld(&bar[XB_XGEN(b.x)]) == gen, bar);
            __builtin_amdgcn_fence(__ATOMIC_ACQUIRE, "agent");
            asm volatile("s_waitcnt vmcnt(0)" ::: "memory");
        }
    }
    __syncthreads();
}

#ifndef ONLY
#define ONLY -1
#endif
#define RUN(n) (ONLY < 0 || ONLY == (n))
struct Params {
    const float* x; const float* c; const int* positions; const float* ada_w; const float* ada_b;
    const float* norm_mix; const float* norm_ffn; const float* w_in; const float* q_norm; const float* w_uq;
    const float* kv_norm; const float* w_ukv; const float* ret_ld; const float* ret_norm;
    const float* w_br_mla; const float* w_br_dil; const float* w_br_ret; const float* w_out;
    const float* ffn_w1; const float* ffn_w3; const float* ffn_w2;
    const float* moe_router; const float* moe_w1; const float* moe_w3; const float* moe_w2; const float* final_norm;
    float* out; unsigned char* ws;
    double inv_freq[32];
};

constexpr int LDS_PTRS = LDS_MISC + 256;
template <class T> __device__ __forceinline__ T* gp(LAS unsigned char* lds, int byteoff) {
    const volatile LAS unsigned* t = (const volatile LAS unsigned*)(lds + LDS_PTRS + byteoff);
    unsigned lo = t[0], hi = t[1]; lo = __builtin_amdgcn_readfirstlane(lo); hi = __builtin_amdgcn_readfirstlane(hi);
    return (T*)(((unsigned long long)hi << 32) | lo); }
#define GP(T, name) gp<T>(F.lds, (int)__builtin_offsetof(Params, name))
#define WSP() gp<unsigned char>(F.lds, (int)__builtin_offsetof(Params, ws))
namespace pg8 {
constexpr int BM = 256, BK = 64, HALF = 128, HTB = HALF * BK * 2, STAGE_BYTES = 8 * HTB, NXCD = 8, WGM = 8;
__device__ __forceinline__ int lds_byte(int r, int c) { const int st = (r >> 4) * 2 + (c >> 5), rr = r & 15, cc = c & 31, ob = rr * 64 + cc * 2; return st * 1024 + (ob ^ (((ob >> 9) & 1) << 5)); }
__device__ __forceinline__ void stage_rc(int b, int& R, int& C) { const int st = b / 1024, sb = b % 1024, swz = sb ^ (((sb >> 9) & 1) << 5); R = (st >> 1) * 16 + swz / 64; C = (st & 1) * 32 + (swz % 64) / 2; }
__device__ __forceinline__ int perm32(int rho) { const int n = rho >> 4, i = rho & 15; return 8 * (i >> 2) + 4 * n + (i & 3); }
struct Unit { int pm, pn; };
struct Gemm { const bf16_t* A; const bf16_t* Bt; int lda, ldb, K; };
struct StaticOrder {
    int nM, nN, nwg, G, c;
    const int* blk_exp; size_t estride;
    __device__ void init(int nM_, int nN_, int G_, int c_) { nM = nM_; nN = nN_; nwg = nM * nN; G = G_; c = c_; blk_exp = nullptr; estride = 0; }
    __device__ bool next(int i, Unit& u) const {
        const long L = (long)i * G + c; if (L >= nwg) return false;
        int wgid = (int)L; { const int q = nwg / NXCD, r = nwg % NXCD, xcd = wgid % NXCD, off = wgid / NXCD; wgid = (xcd < r ? xcd * (q + 1) : r * (q + 1) + (xcd - r) * q) + off; }
        const int nig = WGM * nN, gid = wgid / nig, fm = gid * WGM, gsz = (nM - fm) < WGM ? (nM - fm) : WGM;
        u.pm = fm + ((wgid % nig) % gsz); u.pn = (wgid % nig) / gsz; return true;
    }
    __device__ __forceinline__ const char* a_ptr(const Gemm& g, const Unit& u) const { return (const char*)(g.A + (size_t)u.pm * 256 * g.lda); }
    __device__ __forceinline__ const char* b_ptr(const Gemm& g, const Unit& u) const {
        size_t e = 0; if (blk_exp) e = (size_t)__builtin_amdgcn_readfirstlane(__hip_atomic_load(blk_exp + u.pm, __ATOMIC_RELAXED, __HIP_MEMORY_SCOPE_AGENT)) * estride;
        return (const char*)(g.Bt + e + (size_t)u.pn * 256 * g.ldb); }
};

template <class Epi, class Sched>
__device__ __forceinline__ void gemm_phase(LAS unsigned char* lds, const Gemm g, const Sched& S, const Epi& E) {
    const int tid = opaque(threadIdx.x), wid = __builtin_amdgcn_readfirstlane(tid >> 6), lane = tid & 63, wr = wid >> 2, wc = wid & 3, fr = lane & 15, fq = lane >> 4;
    const int K = g.K, nt = K / BK;
    unsigned voffA[2], voffB[2];
#pragma unroll
    for (int i = 0; i < 2; ++i) { int R, C; stage_rc(tid * 16 + i * 8192, R, C); const int Rb = (R & ~31) + perm32(R & 31);
        voffA[i] = (unsigned)(R * g.lda + C) * 2u; voffB[i] = (unsigned)(Rb * g.ldb + C) * 2u; }
    const size_t kstep = (size_t)(BK * 2);
    const size_t hstepA = (size_t)HALF * g.lda * 2, hstepB = (size_t)HALF * g.ldb * 2;
    const unsigned ldsw = (unsigned)wid * 1024u;
    const int aoff = lds_byte(wr * 64 + fr, fq * 8), boff = lds_byte(wc * 32 + fr, fq * 8);
#define PG8_SA(b, h) (((b) * 2 + (h)) * HTB)
#define PG8_SB(b, h) ((4 + (b) * 2 + (h)) * HTB)
#define PG8_STAGE(bufoff, gbase, voff) do { _Pragma("unroll") for (int _i = 0; _i < 2; ++_i) \
        __builtin_amdgcn_global_load_lds((const unsigned*)((const char*)(gbase) + (voff)[_i]), (LAS unsigned*)(lds + (bufoff) + ldsw + _i * 8192), 16, 0, 0); } while (0)
#define PG8_LDA(dst, b, h) do { _Pragma("unroll") for (int m = 0; m < 4; ++m) _Pragma("unroll") for (int k = 0; k < 2; ++k) dst[m][k] = *(const LAS bf16x8*)(lds + PG8_SA(b, h) + aoff + m * 2048 + k * 1024); } while (0)
#define PG8_LDB(dst, b, h) do { _Pragma("unroll") for (int n = 0; n < 2; ++n) _Pragma("unroll") for (int k = 0; k < 2; ++k) dst[n][k] = *(const LAS bf16x8*)(lds + PG8_SB(b, h) + boff + n * 2048 + k * 1024); } while (0)
#define PG8_MMA(ai, bj, At, Bt) do { __builtin_amdgcn_s_setprio(1); _Pragma("unroll") for (int m = 0; m < 4; ++m) _Pragma("unroll") for (int n = 0; n < 2; ++n) _Pragma("unroll") for (int k = 0; k < 2; ++k) \
        acc[ai][bj][m][n] = __builtin_amdgcn_mfma_f32_16x16x32_bf16(Bt[n][k], At[m][k], acc[ai][bj][m][n], 0, 0, 0); __builtin_amdgcn_s_setprio(0); } while (0)
#define PG8_WAIT_V(n) asm volatile("s_waitcnt vmcnt(" #n ")" ::: "memory")
#define PG8_WAIT_L(n) asm volatile("s_waitcnt lgkmcnt(" #n ")" ::: "memory")
#define PG8_BAR __builtin_amdgcn_s_barrier()
#define PG8_SCHED __builtin_amdgcn_sched_barrier(0)
    Unit cur, nxt; int ui = 0;
    if (!S.next(0, cur)) return;
    f32x4 acc[2][2][4][2];
#pragma unroll
    for (int a = 0; a < 2; ++a)
#pragma unroll
        for (int b = 0; b < 2; ++b)
#pragma unroll
            for (int m = 0; m < 4; ++m)
#pragma unroll
                for (int n = 0; n < 2; ++n) acc[a][b][m][n] = (f32x4){0.f, 0.f, 0.f, 0.f};
    bf16x8 At[4][2], B0[2][2], B1[2][2];
    const char* cA = S.a_ptr(g, cur); const char* cB = S.b_ptr(g, cur);
    PG8_STAGE(PG8_SB(0, 0), cB, voffB); PG8_STAGE(PG8_SB(0, 1), cB + hstepB, voffB); PG8_STAGE(PG8_SA(0, 0), cA, voffA); PG8_STAGE(PG8_SA(0, 1), cA + hstepA, voffA);
    if (wr == 1) PG8_BAR;
    PG8_WAIT_V(2); PG8_BAR;
    PG8_STAGE(PG8_SB(1, 0), cB + kstep, voffB); PG8_STAGE(PG8_SA(1, 0), cA + kstep, voffA); PG8_STAGE(PG8_SB(1, 1), cB + hstepB + kstep, voffB);
    PG8_WAIT_V(6); PG8_BAR;
    for (;;) {
        const bool has_next = S.next(ui + 1, nxt);
        const char* nA = has_next ? S.a_ptr(g, nxt) : cA; const char* nB = has_next ? S.b_ptr(g, nxt) : cB;
        for (int t = 0; t < nt; t += 2) {
            const bool last = (t == nt - 2);
            const char* a1 = cA + (size_t)(t + 1) * kstep;
            const char* a2 = last ? nA : cA + (size_t)(t + 2) * kstep; const char* b2 = last ? nB : cB + (size_t)(t + 2) * kstep;
            const char* a3 = a2 + kstep; const char* b3 = b2 + kstep;
            PG8_LDB(B0, 0, 0); PG8_LDB(B1, 0, 1); PG8_SCHED; PG8_LDA(At, 0, 0); PG8_STAGE(PG8_SA(1, 1), a1 + hstepA, voffA);
            PG8_WAIT_V(8); PG8_WAIT_L(0); PG8_BAR; PG8_MMA(0, 0, At, B0); PG8_MMA(0, 1, At, B1); PG8_BAR; PG8_SCHED;
            PG8_LDA(At, 0, 1); PG8_STAGE(PG8_SB(0, 0), b2, voffB); PG8_STAGE(PG8_SB(0, 1), b2 + hstepB, voffB); PG8_STAGE(PG8_SA(0, 0), a2, voffA);
            PG8_WAIT_V(8); PG8_WAIT_L(0); PG8_BAR; PG8_MMA(1, 0, At, B0); PG8_MMA(1, 1, At, B1); PG8_BAR; PG8_SCHED;
            PG8_LDB(B0, 1, 0); PG8_LDB(B1, 1, 1); PG8_SCHED; PG8_LDA(At, 1, 0); PG8_STAGE(PG8_SA(0, 1), a2 + hstepA, voffA);
            PG8_WAIT_V(8); PG8_WAIT_L(0); PG8_BAR; PG8_MMA(0, 0, At, B0); PG8_MMA(0, 1, At, B1); PG8_BAR; PG8_SCHED;
            PG8_LDA(At, 1, 1); PG8_STAGE(PG8_SB(1, 0), b3, voffB); PG8_STAGE(PG8_SB(1, 1), b3 + hstepB, voffB); PG8_STAGE(PG8_SA(1, 0), a3, voffA);
            PG8_WAIT_V(8); PG8_WAIT_L(0); PG8_BAR; PG8_MMA(1, 0, At, B0); PG8_MMA(1, 1, At, B1); PG8_BAR; PG8_SCHED;
        }
        if (wr == 0) PG8_BAR;
        E(acc, cur, wr, wc, fr, fq);
        if (!has_next) break;
#pragma unroll
        for (int a = 0; a < 2; ++a)
#pragma unroll
            for (int b = 0; b < 2; ++b)
#pragma unroll
                for (int m = 0; m < 4; ++m)
#pragma unroll
                    for (int n = 0; n < 2; ++n) acc[a][b][m][n] = (f32x4){0.f, 0.f, 0.f, 0.f};
        cur = nxt; cA = nA; cB = nB; ++ui;
        if (wr == 1) PG8_BAR;
    }
    PG8_WAIT_V(0);
    PG8_BAR;
#undef PG8_SA
#undef PG8_SB
#undef PG8_STAGE
#undef PG8_LDA
#undef PG8_LDB
#undef PG8_MMA
#undef PG8_WAIT_V
#undef PG8_WAIT_L
#undef PG8_BAR
#undef PG8_SCHED
}
}
using pg8::Unit;
typedef const f32x4 (&AccRef)[2][2][4][2];

__device__ __forceinline__ u32x4 pack8(f32x4 v0, f32x4 v1) { u32x4 w; w.x = pk2(v0[0], v0[1]); w.y = pk2(v0[2], v0[3]); w.z = pk2(v1[0], v1[1]); w.w = pk2(v1[2], v1[3]); return w; }

struct EpiIn {
    bf16_t* plain; bf16_t* rope; float* ssq; const float* cosT; const float* sinT;
    __device__ __forceinline__ void operator()(AccRef acc, const Unit& u, int wr, int wc, int fr, int fq) const {
        const int row0 = u.pm * 256 + wr * 64 + fr;
        if (u.pn < 31) {
            const int col0 = u.pn * 256 + wc * 32 + 8 * fq;
            const int act = u.pn >= 19 ? 1 : (u.pn >= 15 ? 2 : 0);
#pragma unroll
            for (int ai = 0; ai < 2; ++ai)
#pragma unroll
                for (int m = 0; m < 4; ++m) {
                    const int row = row0 + ai * 128 + m * 16;
                    bf16_t* rowp = plain + (size_t)row * PLAIN_W + col0;
                    float ss = 0.f;
#pragma unroll
                    for (int bj = 0; bj < 2; ++bj) {
                        f32x4 v0 = acc[ai][bj][m][0], v1 = acc[ai][bj][m][1];
                        if (u.pn < 5) {
#pragma unroll
                            for (int j = 0; j < 4; ++j) ss += v0[j] * v0[j] + v1[j] * v1[j];
                        }
                        if (act == 1) {
#pragma unroll
                            for (int j = 0; j < 4; ++j) { v0[j] = fsigmoid(v0[j]); v1[j] = fsigmoid(v1[j]); }
                        } else if (act == 2) {
#pragma unroll
                            for (int j = 0; j < 4; ++j) { v0[j] = fsilu(v0[j]); v1[j] = fsilu(v1[j]); }
                        }
                        *(u32x4*)(rowp + bj * 128) = pack8(v0, v1);
                    }
                    if (u.pn < 5) {
                        ss += __shfl_xor(ss, 16); ss += __shfl_xor(ss, 32);
                        if (fq == 0) ssq[(size_t)row * 20 + u.pn * 4 + wc] = ss;
                    }
                }
        } else {
            const int slot = (u.pn - 31) * 4 + wc;
#pragma unroll
            for (int ai = 0; ai < 2; ++ai)
#pragma unroll
                for (int m = 0; m < 4; ++m) {
                    const int row = row0 + ai * 128 + m * 16;
                    const f32x4 c0 = *(const f32x4*)(cosT + (size_t)row * 32 + 8 * fq), c1 = *(const f32x4*)(cosT + (size_t)row * 32 + 8 * fq + 4);
                    const f32x4 s0 = *(const f32x4*)(sinT + (size_t)row * 32 + 8 * fq), s1 = *(const f32x4*)(sinT + (size_t)row * 32 + 8 * fq + 4);
                    const f32x4 a0 = acc[ai][0][m][0], a1 = acc[ai][0][m][1], b0 = acc[ai][1][m][0], b1 = acc[ai][1][m][1];
                    const f32x4 o10 = a0 * c0 - b0 * s0, o11 = a1 * c1 - b1 * s1, o20 = b0 * c0 + a0 * s0, o21 = b1 * c1 + a1 * s1;
                    bf16_t* rowp = rope + (size_t)row * ROPE_W + slot * 64 + 8 * fq;
                    *(u32x4*)(rowp) = pack8(o10, o11);
                    *(u32x4*)(rowp + 32) = pack8(o20, o21);
                }
        }
    }
};
struct EpiQ {
    bf16_t* q; const float* ssq; const float* cosT; const float* sinT; float c2;
    __device__ __forceinline__ void operator()(AccRef acc, const Unit& u, int wr, int wc, int fr, int fq) const {
        const int row0 = u.pm * 256 + wr * 64 + fr;
#pragma unroll
        for (int ai = 0; ai < 2; ++ai)
#pragma unroll
            for (int m = 0; m < 4; ++m) {
                const int row = row0 + ai * 128 + m * 16;
                const f32x4 p0 = *(const f32x4*)(ssq + (size_t)row * 20), p1 = *(const f32x4*)(ssq + (size_t)row * 20 + 4), p2 = *(const f32x4*)(ssq + (size_t)row * 20 + 8);
                const float tot = ((p0[0] + p0[1]) + (p0[2] + p0[3])) + ((p1[0] + p1[1]) + (p1[2] + p1[3])) + ((p2[0] + p2[1]) + (p2[2] + p2[3]));
                const float rs = c2 / sqrtf(tot * (1.0f / 768.0f) + EPS);
                if (u.pn < 4) {
#pragma unroll
                    for (int bj = 0; bj < 2; ++bj) {
                        bf16_t* dst = q + (size_t)row * QW + (2 * u.pn + bj) * 192 + wc * 32 + 8 * fq;
                        *(u32x4*)dst = pack8(acc[ai][bj][m][0] * rs, acc[ai][bj][m][1] * rs);
                    }
                } else {
                    const int head = (u.pn - 4) * 4 + wc;
                    const f32x4 c0 = *(const f32x4*)(cosT + (size_t)row * 32 + 8 * fq), c1 = *(const f32x4*)(cosT + (size_t)row * 32 + 8 * fq + 4);
                    const f32x4 s0 = *(const f32x4*)(sinT + (size_t)row * 32 + 8 * fq), s1 = *(const f32x4*)(sinT + (size_t)row * 32 + 8 * fq + 4);
                    const f32x4 a0 = acc[ai][0][m][0] * rs, a1 = acc[ai][0][m][1] * rs, b0 = acc[ai][1][m][0] * rs, b1 = acc[ai][1][m][1] * rs;
                    bf16_t* dst = q + (size_t)row * QW + head * 192 + 128 + 8 * fq;
                    *(u32x4*)dst = pack8(a0 * c0 - b0 * s0, a1 * c1 - b1 * s1);
                    *(u32x4*)(dst + 32) = pack8(b0 * c0 + a0 * s0, b1 * c1 + a1 * s1);
                }
            }
    }
};
struct EpiKV {
    bf16_t* kv; const float* ssq;
    __device__ __forceinline__ void operator()(AccRef acc, const Unit& u, int wr, int wc, int fr, int fq) const {
        const int row0 = u.pm * 256 + wr * 64 + fr, col0 = u.pn * 256 + wc * 32 + 8 * fq;
#pragma unroll
        for (int ai = 0; ai < 2; ++ai)
#pragma unroll
            for (int m = 0; m < 4; ++m) {
                const int row = row0 + ai * 128 + m * 16;
                const f32x4 p0 = *(const f32x4*)(ssq + (size_t)row * 20 + 12), p1 = *(const f32x4*)(ssq + (size_t)row * 20 + 16);
                const float tot = ((p0[0] + p0[1]) + (p0[2] + p0[3])) + ((p1[0] + p1[1]) + (p1[2] + p1[3]));
                const float rs = 1.0f / sqrtf(tot * (1.0f / 512.0f) + EPS);
#pragma unroll
                for (int bj = 0; bj < 2; ++bj)
                    *(u32x4*)(kv + (size_t)row * KVW + col0 + bj * 128) = pack8(acc[ai][bj][m][0] * rs, acc[ai][bj][m][1] * rs);
            }
    }
};
struct EpiBr {
    float* mf; bf16_t* mb; const bf16_t* gate; int mode;
    __device__ __forceinline__ void operator()(AccRef acc, const Unit& u, int wr, int wc, int fr, int fq) const {
        const int row0 = u.pm * 256 + wr * 64 + fr, col0 = u.pn * 256 + wc * 32 + 8 * fq;
#pragma unroll
        for (int ai = 0; ai < 2; ++ai)
#pragma unroll
            for (int m = 0; m < 4; ++m) {
                const int row = row0 + ai * 128 + m * 16;
#pragma unroll
                for (int bj = 0; bj < 2; ++bj) {
                    const int col = col0 + bj * 128;
                    const u32x4 gw = *(const u32x4*)(gate + (size_t)row * PLAIN_W + col);
                    f32x4 g0 = {bf2f(gw.x & 0xffffu), bf2f(gw.x >> 16), bf2f(gw.y & 0xffffu), bf2f(gw.y >> 16)};
                    f32x4 g1 = {bf2f(gw.z & 0xffffu), bf2f(gw.z >> 16), bf2f(gw.w & 0xffffu), bf2f(gw.w >> 16)};
                    f32x4 v0 = acc[ai][bj][m][0] * g0, v1 = acc[ai][bj][m][1] * g1;
                    float* mp = mf + (size_t)row * DM + col;
                    if (mode != 0) { v0 += *(const f32x4*)mp; v1 += *(const f32x4*)(mp + 4); }
                    if (mode != 2) { *(f32x4*)mp = v0; *(f32x4*)(mp + 4) = v1; }
                    else *(u32x4*)(mb + (size_t)row * DM + col) = pack8(v0, v1);
                }
            }
    }
};
struct EpiRes {
    const float* base; float* out; const float* gate;
    __device__ __forceinline__ void operator()(AccRef acc, const Unit& u, int wr, int wc, int fr, int fq) const {
        const int row0 = u.pm * 256 + wr * 64 + fr, col0 = u.pn * 256 + wc * 32 + 8 * fq;
        const float* gp = gate + (size_t)(u.pm >> 3) * 6144;
        f32x4 g[2][2];
#pragma unroll
        for (int bj = 0; bj < 2; ++bj) { g[bj][0] = *(const f32x4*)(gp + col0 + bj * 128); g[bj][1] = *(const f32x4*)(gp + col0 + bj * 128 + 4); }
#pragma unroll
        for (int ai = 0; ai < 2; ++ai)
#pragma unroll
            for (int m = 0; m < 4; ++m) {
                const size_t off = (size_t)(row0 + ai * 128 + m * 16) * DM + col0;
#pragma unroll
                for (int bj = 0; bj < 2; ++bj) {
                    const f32x4 b0 = *(const f32x4*)(base + off + bj * 128), b1 = *(const f32x4*)(base + off + bj * 128 + 4);
                    *(f32x4*)(out + off + bj * 128) = b0 + g[bj][0] * acc[ai][bj][m][0];
                    *(f32x4*)(out + off + bj * 128 + 4) = b1 + g[bj][1] * acc[ai][bj][m][1];
                }
            }
    }
};
struct EpiSwi {
    bf16_t* hid; int ld;
    __device__ __forceinline__ void operator()(AccRef acc, const Unit& u, int wr, int wc, int fr, int fq) const {
        const int row0 = u.pm * 256 + wr * 64 + fr, col0 = u.pn * 128 + wc * 32 + 8 * fq;
#pragma unroll
        for (int ai = 0; ai < 2; ++ai)
#pragma unroll
            for (int m = 0; m < 4; ++m) {
                f32x4 v0, v1;
#pragma unroll
                for (int j = 0; j < 4; ++j) { v0[j] = fsilu(acc[ai][0][m][0][j]) * acc[ai][1][m][0][j]; v1[j] = fsilu(acc[ai][0][m][1][j]) * acc[ai][1][m][1][j]; }
                *(u32x4*)(hid + (size_t)(row0 + ai * 128 + m * 16) * ld + col0) = pack8(v0, v1);
            }
    }
};
struct EpiPlain {
    bf16_t* o; int ld;
    __device__ __forceinline__ void operator()(AccRef acc, const Unit& u, int wr, int wc, int fr, int fq) const {
        const int row0 = u.pm * 256 + wr * 64 + fr, col0 = u.pn * 256 + wc * 32 + 8 * fq;
#pragma unroll
        for (int ai = 0; ai < 2; ++ai)
#pragma unroll
            for (int m = 0; m < 4; ++m)
#pragma unroll
                for (int bj = 0; bj < 2; ++bj)
                    *(u32x4*)(o + (size_t)(row0 + ai * 128 + m * 16) * ld + col0 + bj * 128) = pack8(acc[ai][bj][m][0], acc[ai][bj][m][1]);
    }
};

struct Frame {
    LAS unsigned char* lds; int tid, lane, wave, G, gw, ngw;
};
__device__ __forceinline__ Frame mkframe(LAS unsigned char* lds) { Frame F; F.lds = lds; F.tid = opaque(threadIdx.x); F.lane = F.tid & 63; F.wave = __builtin_amdgcn_readfirstlane(F.tid >> 6);
    F.G = gridDim.x; F.gw = blockIdx.x * 8 + F.wave; F.ngw = F.G * 8; return F; }

__device__ __forceinline__ void cvt_item(const float* src, int ld, int c0, bool valid, float sn, const float* gain, bf16_t* dst, int Kd, int n0, int k0, LAS float* scr, int lane) {
#pragma unroll 8
    for (int i = 0; i < 32; ++i) { const int kk = 2 * i + (lane >> 5); float v = 0.f; if (valid) v = src[(size_t)(k0 + kk) * ld + c0 + (lane & 31)] * sn; if (gain) v *= gain[k0 + kk]; scr[kk * 33 + (lane & 31)] = v; }
    asm volatile("s_waitcnt lgkmcnt(0)" ::: "memory");
    const int c = lane & 7;
#pragma unroll
    for (int j = 0; j < 4; ++j) { const int n = (lane >> 3) + 8 * j; const LAS float* s = scr + (8 * c) * 33 + n;
        u32x4 o; o.x = pk2(s[0 * 33], s[1 * 33]); o.y = pk2(s[2 * 33], s[3 * 33]); o.z = pk2(s[4 * 33], s[5 * 33]); o.w = pk2(s[6 * 33], s[7 * 33]);
        *(u32x4*)(dst + (size_t)(n0 + n) * Kd + k0 + 8 * c) = o; }
    asm volatile("s_waitcnt lgkmcnt(0)" ::: "memory");
}
__device__ __forceinline__ void win_map(int nb, int& c0, float& sn) {
    const int n0 = nb * 32; sn = 1.f;
    if (n0 < PLAIN_W) {
        if (n0 < PC_DV) { c0 = n0; return; }
        if (n0 < PC_RV) { c0 = 4416 + (n0 - PC_DV); return; }
        if (n0 < PC_RG) { c0 = 6976 + (n0 - PC_RV); return; }
        c0 = 8000 + (n0 - PC_RG); return;
    }
    const int r = n0 - PLAIN_W, tile = r >> 8, p = r & 255, bj = p >> 7, hh = (p & 127) >> 5;
    const int slot = tile * 4 + hh;
    int base;
    if (slot == 0) base = 1280;
    else if (slot < RS_DK) { base = 1344 + (slot - RS_DQ) * 64; sn = 0.125f; }
    else if (slot < RS_RQ) base = 2880 + (slot - RS_DK) * 64;
    else if (slot < RS_RK) base = 5952 + (slot - RS_RQ) * 64;
    else if (slot < 65) { base = 6464 + (slot - RS_RK) * 64; sn = 0.125f; }
    else { c0 = -1; return; }
    c0 = base + bj * 32;
}
__device__ __forceinline__ void p0_convert(Frame& F0, bool moe_only, int moe_layer) {
    Frame F = mkframe(F0.lds);
    LAS float* scr = (LAS float*)(F.lds + F.wave * 16384);
    unsigned char* ws = WSP();
    constexpr int I_WIN = 4 * 16 * 384, I_UQ = 4 * 12 * 48, I_UKV = 4 * 8 * 64, I_BM = 4 * 16 * 32, I_BD = 4 * 8 * 32, I_BR = 4 * 16 * 32, I_WO = 4 * 16 * 32;
    constexpr int I_F13 = 2 * 16 * 176, I_F2 = 2 * 44 * 32, I_M13 = 8 * 16 * 224, I_M2 = 8 * 56 * 32;
    constexpr int I_ALL = I_WIN + I_UQ + I_UKV + I_BM + I_BD + I_BR + I_WO + I_F13 + I_F2;
    const int total = moe_only ? (I_M13 + I_M2) : (I_ALL + I_M13 + I_M2);
    for (int it = F.gw; it < total; it += F.ngw) {
        int r = it;
        if (!moe_only) {
            if (r < I_WIN) { const int l = r / (16 * 384), q = r % (16 * 384), kb = q / 384, nb = q % 384; int c0; float sn; win_map(nb, c0, sn);
                cvt_item(GP(const float, w_in) + (size_t)l * DM * IN_COLS, IN_COLS, c0 < 0 ? 0 : c0, c0 >= 0, sn, nullptr, (bf16_t*)(ws + WS_WIN) + (size_t)l * NIN * DM, DM, nb * 32, kb * 64, scr, F.lane); continue; } r -= I_WIN;
            if (r < I_UQ) { const int l = r / (12 * 48), q = r % (12 * 48), kb = q / 48, nb = q % 48; const int n0 = nb * 32; int c0;
                if (n0 < 1024) { const int head = n0 >> 7; c0 = head * 192 + (n0 & 127); }
                else { const int rr = n0 - 1024, tile = rr >> 8, p = rr & 255, bj = p >> 7, hh = (p & 127) >> 5; c0 = (tile * 4 + hh) * 192 + 128 + bj * 32; }
                cvt_item(GP(const float, w_uq) + (size_t)l * 768 * QW, QW, c0, true, 1.f, GP(const float, q_norm) + l * 768, (bf16_t*)(ws + WS_WUQ) + (size_t)l * QW * 768, 768, n0, kb * 64, scr, F.lane); continue; } r -= I_UQ;
            if (r < I_UKV) { const int l = r / (8 * 64), q = r % (8 * 64), kb = q / 64, nb = q % 64;
                cvt_item(GP(const float, w_ukv) + (size_t)l * 512 * KVW, KVW, nb * 32, true, 1.f, GP(const float, kv_norm) + l * 512, (bf16_t*)(ws + WS_WUKV) + (size_t)l * KVW * 512, 512, nb * 32, kb * 64, scr, F.lane); continue; } r -= I_UKV;
            if (r < I_BM) { const int l = r / (16 * 32), q = r % (16 * 32), kb = q / 32, nb = q % 32;
                cvt_item(GP(const float, w_br_mla) + (size_t)l * DM * DM, DM, nb * 32, true, 1.f, nullptr, (bf16_t*)(ws + WS_WBM) + (size_t)l * DM * DM, DM, nb * 32, kb * 64, scr, F.lane); continue; } r -= I_BM;
            if (r < I_BD) { const int l = r / (8 * 32), q = r % (8 * 32), kb = q / 32, nb = q % 32;
                cvt_item(GP(const float, w_br_dil) + (size_t)l * 512 * DM, DM, nb * 32, true, 1.f, nullptr, (bf16_t*)(ws + WS_WBD) + (size_t)l * DM * 512, 512, nb * 32, kb * 64, scr, F.lane); continue; } r -= I_BD;
            if (r < I_BR) { const int l = r / (16 * 32), q = r % (16 * 32), kb = q / 32, nb = q % 32;
                cvt_item(GP(const float, w_br_ret) + (size_t)l * DM * DM, DM, nb * 32, true, 1.f, nullptr, (bf16_t*)(ws + WS_WBR) + (size_t)l * DM * DM, DM, nb * 32, kb * 64, scr, F.lane); continue; } r -= I_BR;
            if (r < I_WO) { const int l = r / (16 * 32), q = r % (16 * 32), kb = q / 32, nb = q % 32;
                cvt_item(GP(const float, w_out) + (size_t)l * DM * DM, DM, nb * 32, true, 1.f, nullptr, (bf16_t*)(ws + WS_WO) + (size_t)l * DM * DM, DM, nb * 32, kb * 64, scr, F.lane); continue; } r -= I_WO;
            if (r < I_F13) { const int i = r / (16 * 176), q = r % (16 * 176), kb = q / 176, nb = q % 176; const int n0 = nb * 32, tile = n0 >> 8, p = n0 & 255;
                const float* src = (p < 128 ? GP(const float, ffn_w1) : GP(const float, ffn_w3)) + (size_t)i * DM * DFF;
                cvt_item(src, DFF, tile * 128 + (p & 127), true, 1.f, nullptr, (bf16_t*)(ws + WS_W13) + (size_t)i * 5632 * DM, DM, n0, kb * 64, scr, F.lane); continue; } r -= I_F13;
            if (r < I_F2) { const int i = r / (44 * 32), q = r % (44 * 32), kb = q / 32, nb = q % 32;
                cvt_item(GP(const float, ffn_w2) + (size_t)i * DFF * DM, DM, nb * 32, true, 1.f, nullptr, (bf16_t*)(ws + WS_W2) + (size_t)i * DM * DFF, DFF, nb * 32, kb * 64, scr, F.lane); continue; } r -= I_F2;
        }
        if (r < I_M13) { const int e = r / (16 * 224), q = r % (16 * 224), kb = q / 224, nb = q % 224; const int n0 = nb * 32, tile = n0 >> 8, p = n0 & 255;
            const float* src = (p < 128 ? GP(const float, moe_w1) : GP(const float, moe_w3)) + ((size_t)moe_layer * NEXP + e) * DM * DFE;
            cvt_item(src, DFE, tile * 128 + (p & 127), true, 1.f, nullptr, (bf16_t*)(ws + WS_W13E) + (size_t)e * 7168 * DM, DM, n0, kb * 64, scr, F.lane); continue; } r -= I_M13;
        { const int e = r / (56 * 32), q = r % (56 * 32), kb = q / 32, nb = q % 32;
            cvt_item(GP(const float, moe_w2) + ((size_t)moe_layer * NEXP + e) * DFE * DM, DM, nb * 32, true, 1.f, nullptr, (bf16_t*)(ws + WS_W2E) + (size_t)e * DM * DFE, DFE, nb * 32, kb * 64, scr, F.lane); }
    }
}
__device__ __forceinline__ void p0_tables(Frame& F0) {
    Frame F = mkframe(F0.lds);
    float* cosT = (float*)(WSP() + WS_COS); float* sinT = (float*)(WSP() + WS_SIN);
    const int* pos = GP(const int, positions);
    for (int i = blockIdx.x * 512 + F.tid; i < T * 32; i += F.G * 512) {
        const int t = i >> 5, f = i & 31;
        const double rev = (double)pos[t] * ((const volatile LAS double*)(F.lds + LDS_PTRS + (int)__builtin_offsetof(Params, inv_freq)))[f] * 0.15915494309189533577;
        const double fr = rev - __builtin_rint(rev);
        cosT[i] = __builtin_amdgcn_cosf((float)fr); sinT[i] = __builtin_amdgcn_sinf((float)fr);
    }
    float* modp = (float*)(WSP() + WS_MODP);
    for (int it = F.gw; it < 4 * 96 * 16; it += F.ngw) {
        const int sl = it & 15, cg = (it >> 4) % 96, l = it / (16 * 96);
        const int n = cg * 64 + F.lane;
        float acc[8];
#pragma unroll
        for (int b = 0; b < 8; ++b) acc[b] = 0.f;
        const float* w = GP(const float, ada_w) + (size_t)l * DM * 6144 + n; const float* cp = GP(const float, c);
        for (int k = sl * 64; k < sl * 64 + 64; ++k) {
            const float wv = w[(size_t)k * 6144];
#pragma unroll
            for (int b = 0; b < 8; ++b) { const float cv = cp[b * DM + k]; acc[b] += fsilu(cv) * wv; }
        }
#pragma unroll
        for (int b = 0; b < 8; ++b) modp[(((size_t)sl * 4 + l) * 8 + b) * 6144 + n] = acc[b];
    }
}
__device__ __forceinline__ void p0_modreduce(Frame& F0) {
    Frame F = mkframe(F0.lds);
    const float* modp = (const float*)(WSP() + WS_MODP); float* mod = (float*)(WSP() + WS_MOD);
    for (int i = blockIdx.x * 512 + F.tid; i < 4 * 8 * 6144; i += F.G * 512) {
        const int n = i % 6144, l = i / (8 * 6144);
        float s = GP(const float, ada_b)[l * 6144 + n];
        for (int sl = 0; sl < 16; ++sl) s += modp[(size_t)sl * 4 * 8 * 6144 + i];
        mod[i] = s;
    }
}

template <bool COMBINE, bool ROUTER, bool FINAL>
__device__ __forceinline__ void phase_norm(Frame& F0, const float* xin, float* xout, const float* gvec, const float* scale, const float* shift, const float* gate2,
                                           const float* wr) {
    Frame F = mkframe(F0.lds);
    bf16_t* H = (bf16_t*)(WSP() + WS_H);
    int* moei = (int*)(WSP() + WS_MOEI);
    const bf16_t* YB = (const bf16_t*)(WSP() + WS_YB);
    for (int ch = F.gw; ch < T / 8; ch += F.ngw) {
        int cnt[8];
#pragma unroll
        for (int e = 0; e < 8; ++e) cnt[e] = 0;
        for (int rr = 0; rr < 8; ++rr) {
            const int row = ch * 8 + rr, b = row >> 11;
            const f32x4* xr = (const f32x4*)(xin + (size_t)row * DM) + F.lane;
            f32x4 v[4];
#pragma unroll
            for (int j = 0; j < 4; ++j) v[j] = xr[64 * j];
            if (COMBINE) {
                const int p0 = moei[MI_TOKP + 2 * row], p1 = moei[MI_TOKP + 2 * row + 1];
                const float w0 = __int_as_float(moei[MI_TOKW + 2 * row]), w1 = __int_as_float(moei[MI_TOKW + 2 * row + 1]);
#pragma unroll
                for (int j = 0; j < 4; ++j) {
                    const u32x2 a = *((const u32x2*)(YB + (size_t)p0 * DM) + F.lane + 64 * j), c = *((const u32x2*)(YB + (size_t)p1 * DM) + F.lane + 64 * j);
                    const f32x4 g = *((const f32x4*)(gate2 + (size_t)b * 6144) + F.lane + 64 * j);
                    f32x4 y; y[0] = w0 * bf2f(a.x & 0xffffu) + w1 * bf2f(c.x & 0xffffu); y[1] = w0 * bf2f(a.x >> 16) + w1 * bf2f(c.x >> 16);
                    y[2] = w0 * bf2f(a.y & 0xffffu) + w1 * bf2f(c.y & 0xffffu); y[3] = w0 * bf2f(a.y >> 16) + w1 * bf2f(c.y >> 16);
                    v[j] = v[j] + g * y;
                }
                if (!FINAL) {
#pragma unroll
                    for (int j = 0; j < 4; ++j) *((f32x4*)(xout + (size_t)row * DM) + F.lane + 64 * j) = v[j];
                }
            }
            float s = 0.f;
#pragma unroll
            for (int j = 0; j < 4; ++j) s += (v[j][0] * v[j][0] + v[j][1] * v[j][1]) + (v[j][2] * v[j][2] + v[j][3] * v[j][3]);
            const float rs = 1.0f / sqrtf(wave_sum(s) * (1.0f / DM) + EPS);
            if (FINAL) {
#pragma unroll
                for (int j = 0; j < 4; ++j) { const f32x4 g = *((const f32x4*)gvec + F.lane + 64 * j); *((f32x4*)(xout + (size_t)row * DM) + F.lane + 64 * j) = v[j] * rs * g; }
                continue;
            }
            f32x4 h[4];
#pragma unroll
            for (int j = 0; j < 4; ++j) {
                const f32x4 g = *((const f32x4*)gvec + F.lane + 64 * j), sc = *((const f32x4*)(scale + (size_t)b * 6144) + F.lane + 64 * j), sh = *((const f32x4*)(shift + (size_t)b * 6144) + F.lane + 64 * j);
                h[j] = v[j] * rs * g * (1.0f + sc) + sh;
                u32x2 o; o.x = pk2(h[j][0], h[j][1]); o.y = pk2(h[j][2], h[j][3]);
                *((u32x2*)(H + (size_t)row * DM) + F.lane + 64 * j) = o;
            }
            if (ROUTER) {
                float lg[8];
#pragma unroll
                for (int e = 0; e < 8; ++e) lg[e] = 0.f;
#pragma unroll
                for (int j = 0; j < 4; ++j)
#pragma unroll
                    for (int q = 0; q < 4; ++q) {
                        const int k = 4 * F.lane + 256 * j + q;
                        const f32x4 w0 = *(const f32x4*)(wr + (size_t)k * 8), w1 = *(const f32x4*)(wr + (size_t)k * 8 + 4);
                        const float hv = h[j][q];
                        lg[0] += hv * w0[0]; lg[1] += hv * w0[1]; lg[2] += hv * w0[2]; lg[3] += hv * w0[3];
                        lg[4] += hv * w1[0]; lg[5] += hv * w1[1]; lg[6] += hv * w1[2]; lg[7] += hv * w1[3];
                    }
#pragma unroll
                for (int e = 0; e < 8; ++e) lg[e] = wave_sum(lg[e]);
                int e0 = 0; float v0 = lg[0];
#pragma unroll
                for (int e = 1; e < 8; ++e) if (lg[e] > v0) { v0 = lg[e]; e0 = e; }
                int e1 = -1; float v1 = -3.0e38f;
#pragma unroll
                for (int e = 0; e < 8; ++e) if (e != e0 && lg[e] > v1) { v1 = lg[e]; e1 = e; }
                const float ex = __expf(v1 - v0), w0 = 1.0f / (1.0f + ex), w1 = ex / (1.0f + ex);
                if (F.lane == 0) { moei[MI_TOKE + 2 * row] = e0; moei[MI_TOKE + 2 * row + 1] = e1; moei[MI_TOKW + 2 * row] = __float_as_int(w0); moei[MI_TOKW + 2 * row + 1] = __float_as_int(w1); }
#pragma unroll
                for (int e = 0; e < 8; ++e) cnt[e] += (e == e0) + (e == e1);
            }
        }
        if (ROUTER && F.lane == 0) {
#pragma unroll
            for (int e = 0; e < 8; ++e) moei[MI_CNT + ch * 8 + e] = cnt[e];
        }
    }
}

__device__ __forceinline__ void phase_moe_gather(Frame& F0) {
    Frame F = mkframe(F0.lds);
    int* moei = (int*)(WSP() + WS_MOEI);
    LAS int* pre = (LAS int*)F.lds;
    LAS int* seg = (LAS int*)(F.lds + 65536);
    LAS int* pst = (LAS int*)(F.lds + 65536 + 4096);
    const int e = F.tid & 7, sg = F.tid >> 3;
    {
        int run = 0;
        for (int i = 0; i < 32; ++i) { const int ch = sg * 32 + i; const int c = moei[MI_CNT + ch * 8 + e]; pre[ch * 8 + e] = run; run += c; }
        seg[sg * 8 + e] = run;
    }
    __syncthreads();
    if (F.tid < 8) {
        int run = 0;
        for (int s = 0; s < 64; ++s) { const int c = seg[s * 8 + F.tid]; seg[s * 8 + F.tid] = run; run += c; }
        seg[64 * 8 + F.tid] = run;
    }
    __syncthreads();
    if (F.tid < 8) {
        const int tot = seg[64 * 8 + F.tid]; const int padded = (tot + 255) & ~255;
        int ps = 0;
        for (int q = 0; q < 8; ++q) { const int pq = __shfl(padded, q); if (q < F.tid) ps += pq; }
        pst[F.tid] = ps;
        if (blockIdx.x == 0) {
            for (int q = 0; q < (padded >> 8); ++q) moei[MI_BLK + 1 + (ps >> 8) + q] = F.tid;
            if (F.tid == 7) moei[MI_BLK] = (ps + padded) >> 8;
        }
    }
    __syncthreads();
    const bf16_t* H = (const bf16_t*)(WSP() + WS_H); bf16_t* XG = (bf16_t*)(WSP() + WS_XG);
    for (int ch = F.gw; ch < T / 8; ch += F.ngw) {
        const int a = F.lane & 15; const int row = ch * 8 + (a >> 1);
        const int ea = moei[MI_TOKE + 2 * row + (a & 1)];
        int rank = 0;
        for (int q = 0; q < 16; ++q) { const int eq = __shfl(ea, q); if (q < a && eq == ea) ++rank; }
        const int dest = pst[ea] + seg[(ch >> 5) * 8 + ea] + pre[ch * 8 + ea] + rank;
        if (F.lane < 16) moei[MI_TOKP + 2 * row + (a & 1)] = dest;
        for (int q = 0; q < 16; ++q) {
            const int dq = __shfl(dest, q); const int rq = ch * 8 + (q >> 1);
            const u32x4* s = (const u32x4*)(H + (size_t)rq * DM); u32x4* d = (u32x4*)(XG + (size_t)dq * DM);
            d[F.lane] = s[F.lane]; d[F.lane + 64] = s[F.lane + 64];
        }
    }
    __syncthreads();
}

namespace mla {
constexpr int KROW = 400;
constexpr int SHM_K = 64 * KROW, SHM_V = 64 * 128 * 2;
constexpr int OFF_V = 0, OFF_K = 2 * SHM_V, OFF_WS = 2 * SHM_V + 2 * SHM_K;
__device__ __forceinline__ int crow(int r, int hi) { return (r & 3) + 8 * (r >> 2) + 4 * hi; }
__device__ __forceinline__ int v_st(int k, int c) { const int kk = (k & ~0xC) | ((k & 4) << 1) | ((k & 8) >> 1); return ((kk >> 3) * 4 + (c >> 5)) * 512 + ((kk & 7) * 32 + (c & 31)) * 2; }
__device__ __forceinline__ int v_rd_base(int lane) { return ((lane & 3) << 3) | (((lane >> 2) & 3) << 6) | (((lane >> 4) & 1) << 5) | (((lane >> 5) & 1) << 8); }
constexpr int v_rd_off(int d0, int ks, int half) { return d0 * 512 + ks * 4096 + half * 2048; }
template <int OFF> __device__ __forceinline__ s16x4 tr_read(LAS unsigned char* vb) { return __builtin_amdgcn_ds_read_tr16_b64_v4i16((LAS s16x4*)(vb + OFF)); }
template <int D0> __device__ __forceinline__ void pv_one(f32x16& od, LAS unsigned char* vb, bf16x8 pa0, bf16x8 pa1, bf16x8 pa2, bf16x8 pa3) {
    const s16x4 l0 = tr_read<v_rd_off(D0, 0, 0)>(vb), h0 = tr_read<v_rd_off(D0, 0, 1)>(vb), l1 = tr_read<v_rd_off(D0, 1, 0)>(vb), h1 = tr_read<v_rd_off(D0, 1, 1)>(vb);
    const s16x4 l2 = tr_read<v_rd_off(D0, 2, 0)>(vb), h2 = tr_read<v_rd_off(D0, 2, 1)>(vb), l3 = tr_read<v_rd_off(D0, 3, 0)>(vb), h3 = tr_read<v_rd_off(D0, 3, 1)>(vb);
#define PK(L, H) (bf16x8){L[0], L[1], L[2], L[3], H[0], H[1], H[2], H[3]}
    od = __builtin_amdgcn_mfma_f32_32x32x16_bf16(pa0, PK(l0, h0), od, 0, 0, 0);
    od = __builtin_amdgcn_mfma_f32_32x32x16_bf16(pa1, PK(l1, h1), od, 0, 0, 0);
    od = __builtin_amdgcn_mfma_f32_32x32x16_bf16(pa2, PK(l2, h2), od, 0, 0, 0);
    od = __builtin_amdgcn_mfma_f32_32x32x16_bf16(pa3, PK(l3, h3), od, 0, 0, 0);
#undef PK
}
__device__ __forceinline__ void unit(const bf16_t* Qb, const bf16_t* Kn, const bf16_t* Kr, const bf16_t* Vh, bf16_t* Ob, LAS unsigned char* lds, int tid) {
    const int wid = tid >> 6, lane = tid & 63, r32 = lane & 31, hi = lane >> 5;
    LAS unsigned char* V_lds = lds + OFF_V; LAS unsigned char* K_lds = lds + OFF_K;
    LAS float* wsf = (LAS float*)(lds + OFF_WS) + wid * 64; LAS float* li_l = wsf; LAS float* al_l = wsf + 32;
    float m_reg = -1e30f, l_reg = 0.f; f32x16 o[4];
#pragma unroll
    for (int d = 0; d < 4; ++d)
#pragma unroll
        for (int r = 0; r < 16; ++r) o[d][r] = 0.f;
    bf16x8 qr[12];
    const bf16_t* Qw = Qb + (size_t)(wid * 32 + r32) * QW + hi * 8;
#pragma unroll
    for (int d0 = 0; d0 < 12; ++d0) qr[d0] = *(const bf16x8*)(Qw + d0 * 16);
    const int sr = tid >> 4, sc = (tid & 15) * 8, vst0 = v_st(sr, sc), vst1 = v_st(32 + sr, sc);
    const int rr = tid >> 3, rc = (tid & 7) * 8;
    LAS unsigned char* vb0 = V_lds + v_rd_base(lane);
    bf16x8 vs0, vs1, ks0, ks1, kr0;
#define SLOAD(k0) do { vs0 = *(const bf16x8*)(Vh + (size_t)((k0) + sr) * KVW + sc); vs1 = *(const bf16x8*)(Vh + (size_t)((k0) + 32 + sr) * KVW + sc); \
    ks0 = *(const bf16x8*)(Kn + (size_t)((k0) + sr) * KVW + sc); ks1 = *(const bf16x8*)(Kn + (size_t)((k0) + 32 + sr) * KVW + sc); \
    kr0 = *(const bf16x8*)(Kr + (size_t)((k0) + rr) * ROPE_W + rc); } while (0)
#define SWRITE(b) do { *(LAS bf16x8*)(V_lds + (b) * SHM_V + vst0) = vs0; *(LAS bf16x8*)(V_lds + (b) * SHM_V + vst1) = vs1; \
    *(LAS bf16x8*)(K_lds + (b) * SHM_K + sr * KROW + sc * 2) = ks0; *(LAS bf16x8*)(K_lds + (b) * SHM_K + (32 + sr) * KROW + sc * 2) = ks1; \
    *(LAS bf16x8*)(K_lds + (b) * SHM_K + rr * KROW + 256 + rc * 2) = kr0; } while (0)
    constexpr int NT = SEQ / 64;
    SLOAD(0); SWRITE(0); __syncthreads();
    for (int j = 0; j < NT; ++j) {
        const int bsel = j & 1;
        f32x16 p0, p1;
#pragma unroll
        for (int r = 0; r < 16; ++r) { p0[r] = 0.f; p1[r] = 0.f; }
        LAS unsigned char* Kb = K_lds + bsel * SHM_K;
#pragma unroll
        for (int d0 = 0; d0 < 12; ++d0) { const int cb = (d0 * 16 + hi * 8) * 2;
            const bf16x8 b0 = *(const LAS bf16x8*)(Kb + r32 * KROW + cb), b1 = *(const LAS bf16x8*)(Kb + (32 + r32) * KROW + cb);
            p0 = __builtin_amdgcn_mfma_f32_32x32x16_bf16(b0, qr[d0], p0, 0, 0, 0);
            p1 = __builtin_amdgcn_mfma_f32_32x32x16_bf16(b1, qr[d0], p1, 0, 0, 0); }
        float pmax = p0[0];
#pragma unroll
        for (int r = 1; r < 16; ++r) pmax = fmaxf(pmax, p0[r]);
#pragma unroll
        for (int r = 0; r < 16; ++r) pmax = fmaxf(pmax, p1[r]);
        { auto sw = __builtin_amdgcn_permlane32_swap(__float_as_uint(pmax), __float_as_uint(pmax), false, false); pmax = fmaxf(__uint_as_float(sw[0]), __uint_as_float(sw[1])); }
        float alpha = 1.f;
        if (!__all(pmax - m_reg <= 11.0f)) { const float mn = fmaxf(m_reg, pmax); alpha = __builtin_amdgcn_exp2f(m_reg - mn); m_reg = mn; }
#pragma unroll
        for (int r = 0; r < 16; ++r) { p0[r] = __builtin_amdgcn_exp2f(p0[r] - m_reg); p1[r] = __builtin_amdgcn_exp2f(p1[r] - m_reg); }
        float ps = 0.f;
#pragma unroll
        for (int r = 0; r < 16; ++r) ps += p0[r];
#pragma unroll
        for (int r = 0; r < 16; ++r) ps += p1[r];
        { auto sw = __builtin_amdgcn_permlane32_swap(__float_as_uint(ps), __float_as_uint(ps), false, false); ps = __uint_as_float(sw[0]) + __uint_as_float(sw[1]); }
        l_reg = l_reg * alpha + ps;
        if (__any(alpha < 1.f)) {
            if (hi == 0) al_l[r32] = alpha;
            asm volatile("s_waitcnt lgkmcnt(0)" ::: "memory");
#pragma unroll
            for (int r = 0; r < 16; ++r) { const float al = al_l[crow(r, hi)];
#pragma unroll
                for (int d = 0; d < 4; ++d) o[d][r] *= al; }
        }
        bf16x8 pa0, pa1, pa2, pa3;
#define PK4(P_, BASE, OUT) do { unsigned a0 = pk2(P_[BASE + 0], P_[BASE + 1]), a1 = pk2(P_[BASE + 2], P_[BASE + 3]); \
    unsigned b0 = pk2(P_[BASE + 4], P_[BASE + 5]), b1 = pk2(P_[BASE + 6], P_[BASE + 7]); \
    auto r0 = __builtin_amdgcn_permlane32_swap(a0, b0, false, false); auto r1 = __builtin_amdgcn_permlane32_swap(a1, b1, false, false); \
    u32x4 w = {r0[0], r1[0], r0[1], r1[1]}; OUT = *reinterpret_cast<bf16x8*>(&w); } while (0)
        PK4(p0, 0, pa0); PK4(p0, 8, pa1); PK4(p1, 0, pa2); PK4(p1, 8, pa3);
#undef PK4
        LAS unsigned char* vb = vb0 + bsel * SHM_V;
        pv_one<0>(o[0], vb, pa0, pa1, pa2, pa3); pv_one<1>(o[1], vb, pa0, pa1, pa2, pa3); pv_one<2>(o[2], vb, pa0, pa1, pa2, pa3); pv_one<3>(o[3], vb, pa0, pa1, pa2, pa3);
        if (j + 1 < NT) { SLOAD((j + 1) * 64); SWRITE(bsel ^ 1); }
        __syncthreads();
    }
    if (hi == 0) li_l[r32] = l_reg;
    asm volatile("s_waitcnt lgkmcnt(0)" ::: "memory");
    bf16_t* Ow = Ob + (size_t)(wid * 32) * DM;
#pragma unroll
    for (int r = 0; r < 16; ++r) { const int orow = crow(r, hi); const float rl = 1.0f / li_l[orow];
#pragma unroll
        for (int d0 = 0; d0 < 4; ++d0) Ow[(size_t)orow * DM + d0 * 32 + r32] = (bf16_t)f2bf(o[d0][r] * rl); }
    __syncthreads();
#undef SLOAD
#undef SWRITE
}
}
__device__ __forceinline__ void phase_mla(Frame& F0) {
    Frame F = mkframe(F0.lds);
    const bf16_t* Q = (const bf16_t*)(WSP() + WS_Q); const bf16_t* KV = (const bf16_t*)(WSP() + WS_KV); const bf16_t* RP = (const bf16_t*)(WSP() + WS_ROPE);
    bf16_t* Y = (bf16_t*)(WSP() + WS_YMLA);
    for (int u = blockIdx.x; u < 512; u += F.G) {
        const int qb = u & 7, h = (u >> 3) & 7, b = u >> 6;
        const size_t t0 = (size_t)b * SEQ;
        mla::unit(Q + (t0 + qb * 256) * QW + h * 192, KV + t0 * KVW + h * 256, RP + t0 * ROPE_W + RS_KR * 64, KV + t0 * KVW + h * 256 + 128,
                  Y + (t0 + qb * 256) * DM + h * 128, F.lds, F.tid);
    }
}

__device__ __forceinline__ void phase_dilated(Frame& F0) {
    Frame F = mkframe(F0.lds);
    const bf16_t* RP = (const bf16_t*)(WSP() + WS_ROPE); const bf16_t* PL = (const bf16_t*)(WSP() + WS_PLAIN);
    bf16_t* DO = (bf16_t*)(WSP() + WS_DILO); float* LSE = (float*)(WSP() + WS_LSE);
    constexpr int LD = 72;
    const int slot = F.wave >> 2, qt = F.wave & 3, tt = F.tid & 255, g4 = F.lane >> 4, l15 = F.lane & 15;
    LAS bf16_t* Kl = (LAS bf16_t*)(F.lds + slot * 55296); LAS bf16_t* Vl = Kl + 192 * LD;
    for (int pair = blockIdx.x; pair < 3072; pair += F.G) {
        const int it = pair * 2 + slot;
        const int b = it / 768, rem = it % 768, g = rem >> 8, hh = (rem >> 5) & 7, blk = rem & 31;
        const int sh = 2 * g, nbk = 32 >> sh, L = SEQ >> sh;
        const int r = blk / nbk, n = blk % nbk;
#pragma unroll
        for (int q = 0; q < 6; ++q) {
            const int ci = tt + 256 * q, c = ci >> 3, col8 = (ci & 7) * 8;
            const int jk = (n - 1) * 64 + c; const bool ok = (jk >= 0) && (jk < L);
            bf16x8 kv = {0, 0, 0, 0, 0, 0, 0, 0}, vv = {0, 0, 0, 0, 0, 0, 0, 0};
            if (ok) { const size_t tok = (size_t)b * SEQ + ((size_t)jk << sh) + r;
                kv = *(const bf16x8*)(RP + tok * ROPE_W + (RS_DK + g * 8 + hh) * 64 + col8);
                vv = *(const bf16x8*)(PL + tok * PLAIN_W + PC_DV + (g * 8 + hh) * 64 + col8); }
            *(LAS bf16x8*)(Kl + c * LD + col8) = kv; *(LAS bf16x8*)(Vl + c * LD + col8) = vv;
        }
        __syncthreads();
        const int iq = qt * 16 + l15;
        const size_t tokq = (size_t)b * SEQ + ((size_t)(n * 64 + iq) << sh) + r;
        bf16x8 qf[2];
#pragma unroll
        for (int ks = 0; ks < 2; ++ks) qf[ks] = *(const bf16x8*)(RP + tokq * ROPE_W + (RS_DQ + g * 8 + hh) * 64 + ks * 32 + 8 * g4);
        f32x4 s[12];
#pragma unroll
        for (int ct = 0; ct < 12; ++ct) { s[ct] = (f32x4){0.f, 0.f, 0.f, 0.f};
#pragma unroll
            for (int ks = 0; ks < 2; ++ks) { const bf16x8 kf = *(const LAS bf16x8*)(Kl + (16 * ct + l15) * LD + ks * 32 + 8 * g4);
                s[ct] = __builtin_amdgcn_mfma_f32_16x16x32_bf16(kf, qf[ks], s[ct], 0, 0, 0); } }
        float mx = -1e30f;
#pragma unroll
        for (int ct = 0; ct < 12; ++ct)
#pragma unroll
            for (int rg = 0; rg < 4; ++rg) { const int c = 16 * ct + 4 * g4 + rg; const int jk = (n - 1) * 64 + c; const int df = c - 64 - iq;
                const bool ok = (jk >= 0) && (jk < L) && (df >= -64) && (df <= 64);
                s[ct][rg] = ok ? s[ct][rg] : -1e30f; mx = fmaxf(mx, s[ct][rg]); }
        mx = fmaxf(mx, __shfl_xor(mx, 16)); mx = fmaxf(mx, __shfl_xor(mx, 32));
        float sum = 0.f;
#pragma unroll
        for (int ct = 0; ct < 12; ++ct)
#pragma unroll
            for (int rg = 0; rg < 4; ++rg) { const float pv = __builtin_amdgcn_exp2f((s[ct][rg] - mx) * 1.4426950408889634f); s[ct][rg] = pv; sum += pv; }
        sum += __shfl_xor(sum, 16); sum += __shfl_xor(sum, 32);
        const float inv = 1.0f / sum;
        f32x4 o[4];
#pragma unroll
        for (int dt = 0; dt < 4; ++dt) o[dt] = (f32x4){0.f, 0.f, 0.f, 0.f};
#pragma unroll
        for (int s2 = 0; s2 < 6; ++s2) {
            u32x4 pw; pw.x = pk2(s[2 * s2][0], s[2 * s2][1]); pw.y = pk2(s[2 * s2][2], s[2 * s2][3]); pw.z = pk2(s[2 * s2 + 1][0], s[2 * s2 + 1][1]); pw.w = pk2(s[2 * s2 + 1][2], s[2 * s2 + 1][3]);
            const bf16x8 pf = *reinterpret_cast<bf16x8*>(&pw);
#pragma unroll
            for (int dt = 0; dt < 4; ++dt) {
                LAS bf16_t* va = Vl + (32 * s2 + 4 * g4 + ((F.lane >> 2) & 3)) * LD + 16 * dt + 4 * (F.lane & 3);
                const s16x4 lo = __builtin_amdgcn_ds_read_tr16_b64_v4i16((LAS s16x4*)va), hi = __builtin_amdgcn_ds_read_tr16_b64_v4i16((LAS s16x4*)(va + 16 * LD));
                const bf16x8 vf = {lo[0], lo[1], lo[2], lo[3], hi[0], hi[1], hi[2], hi[3]};
                o[dt] = __builtin_amdgcn_mfma_f32_16x16x32_bf16(vf, pf, o[dt], 0, 0, 0);
            }
        }
        bf16_t* dst = DO + ((size_t)g * T + tokq) * 512 + hh * 64 + 4 * g4;
#pragma unroll
        for (int dt = 0; dt < 4; ++dt) { u32x2 w; w.x = pk2(o[dt][0] * inv, o[dt][1] * inv); w.y = pk2(o[dt][2] * inv, o[dt][3] * inv); *(u32x2*)(dst + 16 * dt) = w; }
        if (g4 == 0) LSE[((size_t)g * T + tokq) * 8 + hh] = mx + __logf(sum);
        __syncthreads();
    }
}
__device__ __forceinline__ void phase_dil_merge(Frame& F0) {
    Frame F = mkframe(F0.lds);
    const bf16_t* DO = (const bf16_t*)(WSP() + WS_DILO); const float* LSE = (const float*)(WSP() + WS_LSE); bf16_t* Y = (bf16_t*)(WSP() + WS_YDIL);
    for (int t = F.gw; t < T; t += F.ngw) {
        const int hh = F.lane >> 3;
        const float l0 = LSE[(size_t)t * 8 + hh], l1 = LSE[((size_t)T + t) * 8 + hh], l2 = LSE[((size_t)2 * T + t) * 8 + hh];
        const float m = fmaxf(l0, fmaxf(l1, l2)); const float e0 = __expf(l0 - m), e1 = __expf(l1 - m), e2 = __expf(l2 - m); const float is = 1.0f / (e0 + e1 + e2);
        const float w[3] = {e0 * is, e1 * is, e2 * is};
        float acc[8];
#pragma unroll
        for (int j = 0; j < 8; ++j) acc[j] = 0.f;
#pragma unroll
        for (int g = 0; g < 3; ++g) { const u32x4 v = *((const u32x4*)(DO + ((size_t)g * T + t) * 512) + F.lane);
            acc[0] += w[g] * bf2f(v.x & 0xffffu); acc[1] += w[g] * bf2f(v.x >> 16); acc[2] += w[g] * bf2f(v.y & 0xffffu); acc[3] += w[g] * bf2f(v.y >> 16);
            acc[4] += w[g] * bf2f(v.z & 0xffffu); acc[5] += w[g] * bf2f(v.z >> 16); acc[6] += w[g] * bf2f(v.w & 0xffffu); acc[7] += w[g] * bf2f(v.w >> 16); }
        u32x4 o; o.x = pk2(acc[0], acc[1]); o.y = pk2(acc[2], acc[3]); o.z = pk2(acc[4], acc[5]); o.w = pk2(acc[6], acc[7]);
        *((u32x4*)(Y + (size_t)t * 512) + F.lane) = o;
    }
}

__device__ __forceinline__ void phase_retention(Frame& F0, int layer) {
    Frame F = mkframe(F0.lds);
    const bf16_t* RP = (const bf16_t*)(WSP() + WS_ROPE); const bf16_t* PL = (const bf16_t*)(WSP() + WS_PLAIN);
    constexpr int LQ = 72, LV = 136;
    LAS bf16_t* Ql = (LAS bf16_t*)F.lds; LAS bf16_t* Kl = Ql + 128 * LQ; LAS bf16_t* K2l = Kl + 128 * LQ; LAS bf16_t* Stl = K2l + 128 * LQ; LAS bf16_t* Vl = Stl + 128 * LQ;
    const int w = F.wave, g4 = F.lane >> 4, l15 = F.lane & 15;
    for (int u = blockIdx.x; u < 128; u += F.G) {
        const int b = u >> 4, hh = (u >> 1) & 7, dir = u & 1;
        const float lg = GP(const float, ret_ld)[(layer * 2 + dir) * 8 + hh];
        bf16_t* YR = (bf16_t*)(WSP() + (dir ? WS_YRB : WS_YRF));
        f32x4 st[4];
#pragma unroll
        for (int k = 0; k < 4; ++k) st[k] = (f32x4){0.f, 0.f, 0.f, 0.f};
        for (int i = F.tid; i < 128 * LQ / 2; i += 512) ((LAS unsigned*)Stl)[i] = 0u;
        const float cdec = __expf(lg * 128.0f);
        for (int c = 0; c < 16; ++c) {
#pragma unroll
            for (int q = 0; q < 2; ++q) { const int ci = F.tid + 512 * q, i = ci >> 3, col8 = (ci & 7) * 8;
                const size_t tok = (size_t)b * SEQ + (dir ? (SEQ - 1 - (128 * c + i)) : (128 * c + i));
                const bf16x8 qv = *(const bf16x8*)(RP + tok * ROPE_W + (RS_RQ + hh) * 64 + col8), kv = *(const bf16x8*)(RP + tok * ROPE_W + (RS_RK + hh) * 64 + col8);
                *(LAS bf16x8*)(Ql + i * LQ + col8) = qv; *(LAS bf16x8*)(Kl + i * LQ + col8) = kv;
                const float kd = __expf(lg * (float)(127 - i));
                u32x4 kw = *reinterpret_cast<const u32x4*>(&kv), k2;
                k2.x = pk2(bf2f(kw.x & 0xffffu) * kd, bf2f(kw.x >> 16) * kd); k2.y = pk2(bf2f(kw.y & 0xffffu) * kd, bf2f(kw.y >> 16) * kd);
                k2.z = pk2(bf2f(kw.z & 0xffffu) * kd, bf2f(kw.z >> 16) * kd); k2.w = pk2(bf2f(kw.w & 0xffffu) * kd, bf2f(kw.w >> 16) * kd);
                *(LAS u32x4*)(K2l + i * LQ + col8) = k2; }
#pragma unroll
            for (int q = 0; q < 4; ++q) { const int ci = F.tid + 512 * q, i = ci >> 4, col8 = (ci & 15) * 8;
                const size_t tok = (size_t)b * SEQ + (dir ? (SEQ - 1 - (128 * c + i)) : (128 * c + i));
                *(LAS bf16x8*)(Vl + i * LV + col8) = *(const bf16x8*)(PL + tok * PLAIN_W + PC_RV + hh * 128 + col8); }
            __syncthreads();
            const int iq = 16 * w + l15;
            bf16x8 qf[2];
#pragma unroll
            for (int ks = 0; ks < 2; ++ks) qf[ks] = *(const LAS bf16x8*)(Ql + iq * LQ + ks * 32 + 8 * g4);
            f32x4 y[8];
            const float qd = __expf(lg * (float)(iq + 1));
#pragma unroll
            for (int dvt = 0; dvt < 8; ++dvt) { y[dvt] = (f32x4){0.f, 0.f, 0.f, 0.f};
#pragma unroll
                for (int ks = 0; ks < 2; ++ks) { const bf16x8 sf = *(const LAS bf16x8*)(Stl + (16 * dvt + l15) * LQ + ks * 32 + 8 * g4);
                    y[dvt] = __builtin_amdgcn_mfma_f32_16x16x32_bf16(sf, qf[ks], y[dvt], 0, 0, 0); }
                y[dvt] = y[dvt] * qd; }
            f32x4 s[8];
#pragma unroll
            for (int jt = 0; jt < 8; ++jt) { s[jt] = (f32x4){0.f, 0.f, 0.f, 0.f};
#pragma unroll
                for (int ks = 0; ks < 2; ++ks) { const bf16x8 kf = *(const LAS bf16x8*)(Kl + (16 * jt + l15) * LQ + ks * 32 + 8 * g4);
                    s[jt] = __builtin_amdgcn_mfma_f32_16x16x32_bf16(kf, qf[ks], s[jt], 0, 0, 0); }
#pragma unroll
                for (int rg = 0; rg < 4; ++rg) { const int j = 16 * jt + 4 * g4 + rg; const int df = iq - j; const bool ok = dir ? (df > 0) : (df >= 0);
                    s[jt][rg] = ok ? s[jt][rg] * __expf(lg * (float)df) : 0.f; } }
#pragma unroll
            for (int s2 = 0; s2 < 4; ++s2) {
                u32x4 pw; pw.x = pk2(s[2 * s2][0], s[2 * s2][1]); pw.y = pk2(s[2 * s2][2], s[2 * s2][3]); pw.z = pk2(s[2 * s2 + 1][0], s[2 * s2 + 1][1]); pw.w = pk2(s[2 * s2 + 1][2], s[2 * s2 + 1][3]);
                const bf16x8 pf = *reinterpret_cast<bf16x8*>(&pw);
#pragma unroll
                for (int dvt = 0; dvt < 8; ++dvt) {
                    LAS bf16_t* va = Vl + (32 * s2 + 4 * g4 + ((F.lane >> 2) & 3)) * LV + 16 * dvt + 4 * (F.lane & 3);
                    const s16x4 lo = __builtin_amdgcn_ds_read_tr16_b64_v4i16((LAS s16x4*)va), hi = __builtin_amdgcn_ds_read_tr16_b64_v4i16((LAS s16x4*)(va + 16 * LV));
                    const bf16x8 vf = {lo[0], lo[1], lo[2], lo[3], hi[0], hi[1], hi[2], hi[3]};
                    y[dvt] = __builtin_amdgcn_mfma_f32_16x16x32_bf16(vf, pf, y[dvt], 0, 0, 0);
                }
            }
            { const size_t tok = (size_t)b * SEQ + (dir ? (SEQ - 1 - (128 * c + iq)) : (128 * c + iq));
              bf16_t* dst = YR + tok * DM + hh * 128 + 4 * g4;
#pragma unroll
              for (int dvt = 0; dvt < 8; ++dvt) { u32x2 wv; wv.x = pk2(y[dvt][0], y[dvt][1]); wv.y = pk2(y[dvt][2], y[dvt][3]); *(u32x2*)(dst + 16 * dvt) = wv; } }
            f32x4 nu[4];
#pragma unroll
            for (int dkt = 0; dkt < 4; ++dkt) nu[dkt] = (f32x4){0.f, 0.f, 0.f, 0.f};
#pragma unroll
            for (int s2 = 0; s2 < 4; ++s2) {
                LAS bf16_t* va = Vl + (32 * s2 + 8 * g4 + ((F.lane >> 2) & 3)) * LV + 16 * w + 4 * (F.lane & 3);
                const s16x4 vlo = __builtin_amdgcn_ds_read_tr16_b64_v4i16((LAS s16x4*)va), vhi = __builtin_amdgcn_ds_read_tr16_b64_v4i16((LAS s16x4*)(va + 4 * LV));
                const bf16x8 vf = {vlo[0], vlo[1], vlo[2], vlo[3], vhi[0], vhi[1], vhi[2], vhi[3]};
#pragma unroll
                for (int dkt = 0; dkt < 4; ++dkt) {
                    LAS bf16_t* ka = K2l + (32 * s2 + 8 * g4 + ((F.lane >> 2) & 3)) * LQ + 16 * dkt + 4 * (F.lane & 3);
                    const s16x4 klo = __builtin_amdgcn_ds_read_tr16_b64_v4i16((LAS s16x4*)ka), khi = __builtin_amdgcn_ds_read_tr16_b64_v4i16((LAS s16x4*)(ka + 4 * LQ));
                    const bf16x8 kf = {klo[0], klo[1], klo[2], klo[3], khi[0], khi[1], khi[2], khi[3]};
                    nu[dkt] = __builtin_amdgcn_mfma_f32_16x16x32_bf16(vf, kf, nu[dkt], 0, 0, 0);
                }
            }
#pragma unroll
            for (int dkt = 0; dkt < 4; ++dkt) st[dkt] = st[dkt] * cdec + nu[dkt];
            __syncthreads();
#pragma unroll
            for (int dkt = 0; dkt < 4; ++dkt)
#pragma unroll
                for (int rg = 0; rg < 4; ++rg) Stl[(16 * w + 4 * g4 + rg) * LQ + 16 * dkt + l15] = (bf16_t)f2bf(st[dkt][rg]);
        }
        __syncthreads();
    }
}
__device__ __forceinline__ void phase_ret_final(Frame& F0, int layer) {
    Frame F = mkframe(F0.lds);
    const bf16_t* YF = (const bf16_t*)(WSP() + WS_YRF); const bf16_t* YBk = (const bf16_t*)(WSP() + WS_YRB); const bf16_t* PL = (const bf16_t*)(WSP() + WS_PLAIN);
    bf16_t* Y = (bf16_t*)(WSP() + WS_YRET); const float* rn = GP(const float, ret_norm) + layer * DM;
    for (int t = F.gw; t < T; t += F.ngw) {
        float v[16];
#pragma unroll
        for (int h2 = 0; h2 < 2; ++h2) { const u32x4 a = *((const u32x4*)(YF + (size_t)t * DM) + F.lane * 2 + h2), c = *((const u32x4*)(YBk + (size_t)t * DM) + F.lane * 2 + h2);
            const unsigned aw[4] = {a.x, a.y, a.z, a.w}, cw[4] = {c.x, c.y, c.z, c.w};
#pragma unroll
            for (int j = 0; j < 4; ++j) { v[h2 * 8 + 2 * j] = bf2f(aw[j] & 0xffffu) + bf2f(cw[j] & 0xffffu); v[h2 * 8 + 2 * j + 1] = bf2f(aw[j] >> 16) + bf2f(cw[j] >> 16); } }
        float s = 0.f;
#pragma unroll
        for (int j = 0; j < 16; ++j) s += v[j];
        s += __shfl_xor(s, 1); s += __shfl_xor(s, 2); s += __shfl_xor(s, 4);
        const float mu = s * (1.0f / 128.0f); float q = 0.f;
#pragma unroll
        for (int j = 0; j < 16; ++j) { v[j] -= mu; q += v[j] * v[j]; }
        q += __shfl_xor(q, 1); q += __shfl_xor(q, 2); q += __shfl_xor(q, 4);
        const float rstd = 1.0f / sqrtf(q * (1.0f / 128.0f) + EPS);
        u32x4 o[2];
#pragma unroll
        for (int h2 = 0; h2 < 2; ++h2) { const u32x4 gw = *((const u32x4*)(PL + (size_t)t * PLAIN_W + PC_RG) + F.lane * 2 + h2);
            const unsigned gq[4] = {gw.x, gw.y, gw.z, gw.w}; unsigned ow[4];
#pragma unroll
            for (int j = 0; j < 4; ++j) { const int c = F.lane * 16 + h2 * 8 + 2 * j;
                ow[j] = pk2(v[h2 * 8 + 2 * j] * rstd * rn[c] * bf2f(gq[j] & 0xffffu), v[h2 * 8 + 2 * j + 1] * rstd * rn[c + 1] * bf2f(gq[j] >> 16)); }
            o[h2] = (u32x4){ow[0], ow[1], ow[2], ow[3]}; }
        *((u32x4*)(Y + (size_t)t * DM) + F.lane * 2) = o[0]; *((u32x4*)(Y + (size_t)t * DM) + F.lane * 2 + 1) = o[1];
    }
}

__global__ void __launch_bounds__(512, 2) fwd_kernel(Params P) {
    extern __shared__ __attribute__((aligned(16))) unsigned char lds_raw[];
    Frame F = mkframe((LAS unsigned char*)lds_raw);
    {
        volatile LAS unsigned* misc = (volatile LAS unsigned*)(F.lds + LDS_MISC);
        if (F.tid < 64) misc[F.tid] = 0u;
        if (F.tid < (int)(sizeof(Params) / 4)) ((volatile LAS unsigned*)(F.lds + LDS_PTRS))[F.tid] = ((const unsigned*)&P)[F.tid];
        __syncthreads();
        (void)xcd_barrier_post((unsigned*)(WSP() + WS_CTL) + 4096, misc + 8);
    }
#define GRID_BAR() do { XcdBarrier b_; b_.bar = (unsigned*)(WSP() + WS_CTL) + 4096; b_.x = (unsigned)__builtin_amdgcn_readfirstlane(opaque((int)xb_xcc_id())); \
        b_.st = (volatile LAS unsigned*)(F.lds + LDS_MISC) + 8; xcd_barrier(b_); } while (0)
#define WSB(off) (WSP() + (off))
#define MODL (((const float*)WSB(WS_MOD)) + (size_t)layer * 8 * 6144)
#define XOUT GP(float, out)
    const int bx = blockIdx.x;

    if (RUN(0)) p0_convert(F, false, 0);
    if (RUN(1)) p0_tables(F);
    GRID_BAR();
    if (RUN(1)) p0_modreduce(F);
    GRID_BAR();

    for (int layer = 0; layer < DEPTH; ++layer) {
        if (RUN(2)) {
            const float* xin = layer == 0 ? GP(const float, x) : (const float*)XOUT;
            if (layer > 0 && ((layer - 1) & 1)) {
                const float* modp = ((const float*)WSB(WS_MOD)) + (size_t)(layer - 1) * 8 * 6144;
                phase_norm<true, false, false>(F, xin, XOUT, GP(const float, norm_mix) + layer * DM, MODL + 1024, MODL, modp + 5 * 1024, nullptr);
            } else {
                phase_norm<false, false, false>(F, xin, XOUT, GP(const float, norm_mix) + layer * DM, MODL + 1024, MODL, nullptr, nullptr);
            }
        }
        if (RUN(0) && layer == 2) p0_convert(F, true, 1);
        GRID_BAR();
        if (RUN(3)) {
            pg8::Gemm g{(const bf16_t*)WSB(WS_H), (const bf16_t*)WSB(WS_WIN) + (size_t)layer * NIN * DM, DM, DM, DM};
            pg8::StaticOrder S; S.init(T / 256, NIN / 256, F.G, bx);
            EpiIn E{(bf16_t*)WSB(WS_PLAIN), (bf16_t*)WSB(WS_ROPE), (float*)WSB(WS_SSQ), (const float*)WSB(WS_COS), (const float*)WSB(WS_SIN)};
            pg8::gemm_phase(F.lds, g, S, E);
        }
        GRID_BAR();
        if (RUN(4)) {
            pg8::Gemm g{(const bf16_t*)WSB(WS_PLAIN) + PC_CQ, (const bf16_t*)WSB(WS_WUQ) + (size_t)layer * QW * 768, PLAIN_W, 768, 768};
            pg8::StaticOrder S; S.init(T / 256, QW / 256, F.G, bx);
            EpiQ E{(bf16_t*)WSB(WS_Q), (const float*)WSB(WS_SSQ), (const float*)WSB(WS_COS), (const float*)WSB(WS_SIN), 0.07216878364870322f * 1.4426950408889634f};
            pg8::gemm_phase(F.lds, g, S, E);
        }
        if (RUN(5)) {
            pg8::Gemm g{(const bf16_t*)WSB(WS_PLAIN) + PC_CKV, (const bf16_t*)WSB(WS_WUKV) + (size_t)layer * KVW * 512, PLAIN_W, 512, 512};
            pg8::StaticOrder S; S.init(T / 256, KVW / 256, F.G, bx);
            EpiKV E{(bf16_t*)WSB(WS_KV), (const float*)WSB(WS_SSQ)};
            pg8::gemm_phase(F.lds, g, S, E);
        }
        if (RUN(6)) phase_retention(F, layer);
        if (RUN(7)) phase_dilated(F);
        GRID_BAR();
        if (RUN(8)) phase_mla(F);
        if (RUN(9)) phase_dil_merge(F);
        if (RUN(9)) phase_ret_final(F, layer);
        GRID_BAR();
        if (RUN(10)) {
            pg8::StaticOrder S; S.init(T / 256, DM / 256, F.G, bx);
            { pg8::Gemm g{(const bf16_t*)WSB(WS_YMLA), (const bf16_t*)WSB(WS_WBM) + (size_t)layer * DM * DM, DM, DM, DM};
              EpiBr E{(float*)WSB(WS_MF), (bf16_t*)WSB(WS_MB), (const bf16_t*)WSB(WS_PLAIN) + PC_GA, 0}; pg8::gemm_phase(F.lds, g, S, E); }
            { pg8::Gemm g{(const bf16_t*)WSB(WS_YDIL), (const bf16_t*)WSB(WS_WBD) + (size_t)layer * DM * 512, 512, 512, 512};
              EpiBr E{(float*)WSB(WS_MF), (bf16_t*)WSB(WS_MB), (const bf16_t*)WSB(WS_PLAIN) + PC_GB, 1}; pg8::gemm_phase(F.lds, g, S, E); }
            { pg8::Gemm g{(const bf16_t*)WSB(WS_YRET), (const bf16_t*)WSB(WS_WBR) + (size_t)layer * DM * DM, DM, DM, DM};
              EpiBr E{(float*)WSB(WS_MF), (bf16_t*)WSB(WS_MB), (const bf16_t*)WSB(WS_PLAIN) + PC_GC, 2}; pg8::gemm_phase(F.lds, g, S, E); }
        }
        GRID_BAR();
        if (RUN(11)) {
            pg8::Gemm g{(const bf16_t*)WSB(WS_MB), (const bf16_t*)WSB(WS_WO) + (size_t)layer * DM * DM, DM, DM, DM};
            pg8::StaticOrder S; S.init(T / 256, DM / 256, F.G, bx);
            EpiRes E{layer == 0 ? GP(const float, x) : (const float*)XOUT, XOUT, MODL + 2 * 1024};
            pg8::gemm_phase(F.lds, g, S, E);
        }
        GRID_BAR();
        if (RUN(12)) {
            if (layer & 1) phase_norm<false, true, false>(F, XOUT, XOUT, GP(const float, norm_ffn) + layer * DM, MODL + 4 * 1024, MODL + 3 * 1024, nullptr, GP(const float, moe_router) + (size_t)(layer >> 1) * DM * 8);
            else phase_norm<false, false, false>(F, XOUT, XOUT, GP(const float, norm_ffn) + layer * DM, MODL + 4 * 1024, MODL + 3 * 1024, nullptr, nullptr);
        }
        GRID_BAR();
        if (!(layer & 1)) {
            const int fi = layer >> 1;
            if (RUN(13)) { pg8::Gemm g{(const bf16_t*)WSB(WS_H), (const bf16_t*)WSB(WS_W13) + (size_t)fi * 5632 * DM, DM, DM, DM};
              pg8::StaticOrder S; S.init(T / 256, 5632 / 256, F.G, bx);
              EpiSwi E{(bf16_t*)WSB(WS_HID), DFF}; pg8::gemm_phase(F.lds, g, S, E); }
            GRID_BAR();
            if (RUN(14)) { pg8::Gemm g{(const bf16_t*)WSB(WS_HID), (const bf16_t*)WSB(WS_W2) + (size_t)fi * DM * DFF, DFF, DFF, DFF};
              pg8::StaticOrder S; S.init(T / 256, DM / 256, F.G, bx);
              EpiRes E{XOUT, XOUT, MODL + 5 * 1024}; pg8::gemm_phase(F.lds, g, S, E); }
            GRID_BAR();
        } else {
            if (RUN(15)) phase_moe_gather(F);
            GRID_BAR();
            if (RUN(16)) { const int* moei = (const int*)WSB(WS_MOEI); const int nblk = __builtin_amdgcn_readfirstlane(__hip_atomic_load(moei + MI_BLK, __ATOMIC_RELAXED, __HIP_MEMORY_SCOPE_AGENT));
              pg8::Gemm g{(const bf16_t*)WSB(WS_XG), (const bf16_t*)WSB(WS_W13E), DM, DM, DM};
              pg8::StaticOrder S; S.init(nblk, 7168 / 256, F.G, bx); S.blk_exp = moei + MI_BLK + 1; S.estride = (size_t)7168 * DM;
              EpiSwi E{(bf16_t*)WSB(WS_HID), DFE}; pg8::gemm_phase(F.lds, g, S, E); }
            GRID_BAR();
            if (RUN(17)) { const int* moei = (const int*)WSB(WS_MOEI); const int nblk = __builtin_amdgcn_readfirstlane(__hip_atomic_load(moei + MI_BLK, __ATOMIC_RELAXED, __HIP_MEMORY_SCOPE_AGENT));
              pg8::Gemm g{(const bf16_t*)WSB(WS_HID), (const bf16_t*)WSB(WS_W2E), DFE, DFE, DFE};
              pg8::StaticOrder S; S.init(nblk, DM / 256, F.G, bx); S.blk_exp = moei + MI_BLK + 1; S.estride = (size_t)DM * DFE;
              EpiPlain E{(bf16_t*)WSB(WS_YB), DM}; pg8::gemm_phase(F.lds, g, S, E); }
            GRID_BAR();
        }
    }
    if (RUN(18)) {
        const float* modp = ((const float*)WSB(WS_MOD)) + (size_t)3 * 8 * 6144;
        phase_norm<true, false, true>(F, XOUT, XOUT, GP(const float, final_norm), nullptr, nullptr, modp + 5 * 1024, nullptr);
    }
}

extern "C" void kernel_launch(void* const* d_in, const int* in_sizes, int n_in, void* d_out, int out_size, void* d_ws, size_t ws_size, hipStream_t stream) {
    static int grid = 0;
    if (grid == 0) {
        if (n_in != 26 || in_sizes[0] != T * DM || out_size != T * DM || ws_size < WS_END) {
            fprintf(stderr, "kernel_launch: unexpected shapes / workspace: n_in %d in0 %d out %d ws %zu (need %zu)\n", n_in, n_in > 0 ? in_sizes[0] : -1, out_size, ws_size, (size_t)WS_END);
            grid = -1; return; }
        int dev = 0, cus = 0, per_cu = 0;
        if (hipGetDevice(&dev) != hipSuccess || hipDeviceGetAttribute(&cus, hipDeviceAttributeMultiprocessorCount, dev) != hipSuccess) { grid = -1; return; }
        if (hipFuncSetAttribute((const void*)fwd_kernel, hipFuncAttributeMaxDynamicSharedMemorySize, LDS_BYTES) != hipSuccess) { fprintf(stderr, "kernel_launch: hipFuncSetAttribute failed\n"); grid = -1; return; }
        if (hipOccupancyMaxActiveBlocksPerMultiprocessor(&per_cu, (const void*)fwd_kernel, 512, LDS_BYTES) != hipSuccess || per_cu < 1) {
            fprintf(stderr, "kernel_launch: occupancy query reports %d blocks per CU\n", per_cu); (void)hipGetLastError(); grid = -1; return; }
        grid = cus;
    }
    if (grid < 0) return;
    (void)hipMemsetAsync((char*)d_ws + WS_CTL, 0, CTL_BYTES, stream);
    Params p{};
    const float* const* fin = (const float* const*)d_in;
    p.x = fin[0]; p.c = fin[1]; p.positions = (const int*)d_in[2]; p.ada_w = fin[3]; p.ada_b = fin[4]; p.norm_mix = fin[5]; p.norm_ffn = fin[6]; p.w_in = fin[7];
    p.q_norm = fin[8]; p.w_uq = fin[9]; p.kv_norm = fin[10]; p.w_ukv = fin[11]; p.ret_ld = fin[12]; p.ret_norm = fin[13];
    p.w_br_mla = fin[14]; p.w_br_dil = fin[15]; p.w_br_ret = fin[16]; p.w_out = fin[17]; p.ffn_w1 = fin[18]; p.ffn_w3 = fin[19]; p.ffn_w2 = fin[20];
    p.moe_router = fin[21]; p.moe_w1 = fin[22]; p.moe_w3 = fin[23]; p.moe_w2 = fin[24]; p.final_norm = fin[25];
    p.out = (float*)d_out; p.ws = (unsigned char*)d_ws;
    for (int i = 0; i < 32; ++i) p.inv_freq[i] = std::pow(10000.0, -(double)i / 32.0);
    hipLaunchKernelGGL(fwd_kernel, dim3(grid), dim3(512), LDS_BYTES, stream, p);
    const hipError_t le = hipPeekAtLastError();
    if (le != hipSuccess) fprintf(stderr, "kernel_launch: launch failed: %s\n", hipGetErrorName(le));
}
```

```cpp
#include <hip/hip_runtime.h>
#include <cstdio>
#include <cstdint>
#include <cmath>

#define LAS __attribute__((address_space(3)))
typedef unsigned short bf16_t;
typedef short bf16x8 __attribute__((ext_vector_type(8)));
typedef short s16x4 __attribute__((ext_vector_type(4)));
typedef float f32x4 __attribute__((ext_vector_type(4)));
typedef float f32x16 __attribute__((ext_vector_type(16)));
typedef unsigned u32x4 __attribute__((ext_vector_type(4)));
typedef unsigned u32x2 __attribute__((ext_vector_type(2)));

constexpr int T = 16384, DM = 1024, SEQ = 2048, NB_ = 8, DEPTH = 4;
constexpr int IN_COLS = 12096, NIN = 12288;
constexpr int PLAIN_W = 7936, ROPE_W = 4352;
constexpr int QW = 1536, KVW = 2048;
constexpr int DFF = 2816, DFE = 3584, NEXP = 8;
constexpr int MOE_ROWS = (T * 2 / 256 + NEXP) * 256;
constexpr int MOE_NB = MOE_ROWS / 256;
constexpr float EPS = 1e-6f;
constexpr int PC_CQ = 0, PC_CKV = 768, PC_DV = 1280, PC_RV = 2816, PC_RG = 3840, PC_GA = 4864, PC_GB = 5888, PC_GC = 6912;
constexpr int RS_KR = 0, RS_DQ = 1, RS_DK = 25, RS_RQ = 49, RS_RK = 57;

constexpr size_t MiB = 1ull << 20;
constexpr size_t WS_CTL = 0;                       constexpr size_t CTL_BYTES = 1 * MiB;
constexpr size_t WS_MODP = 1 * MiB;
constexpr size_t WS_MOD = 14 * MiB;
constexpr size_t WS_COS = 15 * MiB, WS_SIN = 17 * MiB;
constexpr size_t WS_SSQ = 19 * MiB;
constexpr size_t WS_MOEI = 21 * MiB;
constexpr size_t WS_LSE = 22 * MiB;
constexpr size_t WS_WIN = 24 * MiB;
constexpr size_t WS_WUQ = WS_WIN + 96 * MiB;
constexpr size_t WS_WUKV = WS_WUQ + 9 * MiB;
constexpr size_t WS_WBM = WS_WUKV + 8 * MiB;
constexpr size_t WS_WBD = WS_WBM + 8 * MiB;
constexpr size_t WS_WBR = WS_WBD + 4 * MiB;
constexpr size_t WS_WO = WS_WBR + 8 * MiB;
constexpr size_t WS_W13 = WS_WO + 8 * MiB;
constexpr size_t WS_W2 = WS_W13 + 22 * MiB;
constexpr size_t WS_W13E = WS_W2 + 11 * MiB;
constexpr size_t WS_W2E = WS_W13E + 112 * MiB;
constexpr size_t WS_H = WS_W2E + 56 * MiB;
constexpr size_t WS_PLAIN = WS_H + 32 * MiB;
constexpr size_t WS_ROPE = WS_PLAIN + 248 * MiB;
constexpr size_t WS_Q = WS_ROPE + 136 * MiB;
constexpr size_t WS_KV = WS_Q + 48 * MiB;
constexpr size_t WS_YMLA = WS_KV + 64 * MiB;
constexpr size_t WS_YDIL = WS_YMLA + 32 * MiB;
constexpr size_t WS_YRET = WS_YDIL + 16 * MiB;
constexpr size_t WS_DILO = WS_YRET + 32 * MiB;
constexpr size_t WS_YRF = WS_DILO + 48 * MiB;
constexpr size_t WS_YRB = WS_YRF + 32 * MiB;
constexpr size_t WS_MB = WS_YRB + 32 * MiB;
constexpr size_t WS_END = WS_MB + 32 * MiB;
constexpr size_t WS_MF = WS_KV;
constexpr size_t WS_HID = WS_PLAIN;
constexpr size_t WS_XG = WS_ROPE;
constexpr size_t WS_YB = WS_ROPE + 68 * MiB;
static_assert((size_t)MOE_ROWS * DFE * 2 <= 248 * MiB, "hid");
static_assert((size_t)MOE_ROWS * DM * 2 <= 68 * MiB, "xg");
constexpr int MI_TOKE = 0;
constexpr int MI_TOKW = 2 * T;
constexpr int MI_TOKP = 4 * T;
constexpr int MI_CNT = 6 * T;
constexpr int MI_BLK = 6 * T + 2048 * 8;
static_assert((MI_BLK + 256) * 4 <= (int)MiB, "moei");

constexpr int LDS_RING = 131072;
constexpr int LDS_MISC = LDS_RING;
constexpr int LDS_BYTES = 147456;

__device__ __forceinline__ float bf2f(unsigned b) { return __uint_as_float(b << 16); }
__device__ __forceinline__ unsigned f2bf(float f) { unsigned u = __float_as_uint(f); return (u + 0x7fffu + ((u >> 16) & 1u)) >> 16; }
__device__ __forceinline__ unsigned pk2(float lo, float hi) { unsigned r; asm volatile("v_cvt_pk_bf16_f32 %0, %1, %2" : "=v"(r) : "v"(lo), "v"(hi)); return r; }
__device__ __forceinline__ float fsigmoid(float x) { return __builtin_amdgcn_rcpf(1.0f + __builtin_amdgcn_exp2f(-1.4426950408889634f * x)); }
__device__ __forceinline__ float fsilu(float x) { return x * fsigmoid(x); }
__device__ __forceinline__ int opaque(int x) { asm volatile("" : "+v"(x)); return x; }
__device__ __forceinline__ float wave_sum(float v) {
#pragma unroll
    for (int o = 1; o < 64; o <<= 1) v += __shfl_xor(v, o);
    return v;
}

#define XB_TMO      128
#define XB_XCNT(j)  (256  + 64 * (j))
#define XB_XSUB(j)  (1280 + 64 * (j))
#define XB_XGEN(j)  (2304 + 64 * (j))
#define XB_TOP      3328
#define XB_TOPGEN   3392
#define XCD_BAR_WORDS 3456
#define XB_SPIN_CAP (1u << 24)
__device__ __forceinline__ unsigned xb_ld(unsigned* p)              { return __hip_atomic_load(p, __ATOMIC_RELAXED, __HIP_MEMORY_SCOPE_AGENT); }
__device__ __forceinline__ unsigned xb_add(unsigned* p, unsigned v) { return __hip_atomic_fetch_add(p, v, __ATOMIC_RELAXED, __HIP_MEMORY_SCOPE_AGENT); }
__device__ __forceinline__ unsigned xb_xcc_id() { return (unsigned)__builtin_amdgcn_s_getreg((3 << 11) | 20) & 0xFu; }
#define XB_SPIN(cond, bar) do { unsigned _sp = 0; while (cond) { __builtin_amdgcn_s_sleep(1); \
    if ((++_sp & 255u) == 0u) { if (xb_ld(&(bar)[XB_TMO])) break; if (_sp > XB_SPIN_CAP) { atomicAdd(&(bar)[XB_TMO], 1u); break; } } } } while (0)
struct XcdBarrier { unsigned* bar; unsigned x; volatile LAS unsigned* st; };
__device__ __forceinline__ XcdBarrier xcd_barrier_post(unsigned* bar, volatile LAS unsigned* st) {
    XcdBarrier b; b.bar = bar; b.x = xb_xcc_id(); b.st = st;
    if (threadIdx.x == 0) (void)xb_add(&bar[XB_XCNT(b.x)], 1u);
    return b;
}
__device__ __forceinline__ void xcd_barrier_complete(unsigned* bar, unsigned x, unsigned& nloc, unsigned& nx) {
    const unsigned G = gridDim.x * gridDim.y * gridDim.z;
    unsigned sum, cnt, mine, sp = 0u;
    for (;;) {
        sum = 0u; cnt = 0u; mine = 0u;
#pragma unroll
        for (unsigned j = 0; j < 16; ++j) { const unsigned c = xb_ld(&bar[XB_XCNT(j)]); sum += c; cnt += (c > 0u) ? 1u : 0u; mine = (j == x) ? c : mine; }
        if (sum == G) break;
        __builtin_amdgcn_s_sleep(1);
        if ((++sp & 255u) == 0u) { if (xb_ld(&bar[XB_TMO])) break; if (sp > XB_SPIN_CAP) { atomicAdd(&bar[XB_TMO], 1u); break; } }
    }
    nloc = mine > 0u ? mine : 1u; nx = cnt > 0u ? cnt : 1u;
}
__device__ __forceinline__ void xcd_barrier(const XcdBarrier& b) {
    asm volatile("s_waitcnt vmcnt(0)" ::: "memory");
    __syncthreads();
    if (threadIdx.x == 0) {
        unsigned* bar = b.bar;
        __builtin_amdgcn_s_waitcnt(0);
        unsigned nloc = b.st[0], nx = b.st[1];
        if (nloc == 0u) { xcd_barrier_complete(bar, b.x, nloc, nx); b.st[0] = nloc; b.st[1] = nx; }
        const unsigned old = xb_add(&bar[XB_XSUB(b.x)], 1u);
        const unsigned gen = old / nloc;
        if (old + 1u == (gen + 1u) * nloc) {
            __builtin_amdgcn_fence(__ATOMIC_RELEASE, "agent");
            asm volatile("s_waitcnt vmcnt(0)" ::: "memory");
            const unsigned og = xb_add(&bar[XB_TOP], 1u);
            const unsigned tg = og / nx;
            if (og + 1u == (tg + 1u) * nx) xb_add(&bar[XB_TOPGEN], 1u);
            else XB_SPIN(xb_ld(&bar[XB_TOPGEN]) == tg, bar);
            __builtin_amdgcn_fence(__ATOMIC_ACQUIRE, "agent");
            xb_add(&bar[XB_XGEN(b.x)], 1u);
            asm volatile("s_waitcnt vmcnt(0)" ::: "memory");
        } else {
            XB_SPIN(xb_ld(&bar[XB_XGEN(b.x)]) == gen, bar);
            __builtin_amdgcn_fence(__ATOMIC_ACQUIRE, "agent");
            asm volatile("s_waitcnt vmcnt(0)" ::: "memory");
        }
    }
    __syncthreads();
}

#ifndef ONLY
#define ONLY -1
#endif
#define RUN(n) (ONLY < 0 || ONLY == (n))
#ifndef DUPN
#define DUPN 17
#endif
#define PH(n) for (int rp_ = 0; rp_ < (RUN(n) ? ((DUPN == (n)) ? 2 : 1) : 0); ++rp_)
struct Params {
    const float* x; const float* c; const int* positions; const float* ada_w; const float* ada_b;
    const float* norm_mix; const float* norm_ffn; const float* w_in; const float* q_norm; const float* w_uq;
    const float* kv_norm; const float* w_ukv; const float* ret_ld; const float* ret_norm;
    const float* w_br_mla; const float* w_br_dil; const float* w_br_ret; const float* w_out;
    const float* ffn_w1; const float* ffn_w3; const float* ffn_w2;
    const float* moe_router; const float* moe_w1; const float* moe_w3; const float* moe_w2; const float* final_norm;
    float* out; unsigned char* ws;
    double inv_freq[32];
};

constexpr int LDS_PTRS = LDS_MISC + 256;
template <class T> __device__ __forceinline__ T* gp(LAS unsigned char* lds, int byteoff) {
    const volatile LAS unsigned* t = (const volatile LAS unsigned*)(lds + LDS_PTRS + byteoff);
    unsigned lo = t[0], hi = t[1]; lo = __builtin_amdgcn_readfirstlane(lo); hi = __builtin_amdgcn_readfirstlane(hi);
    return (T*)(((unsigned long long)hi << 32) | lo); }
#define GP(T, name) gp<T>(F.lds, (int)__builtin_offsetof(Params, name))
#define WSP() gp<unsigned char>(F.lds, (int)__builtin_offsetof(Params, ws))
namespace pg8 {
constexpr int BM = 256, BK = 64, HALF = 128, HTB = HALF * BK * 2, STAGE_BYTES = 8 * HTB, NXCD = 8, WGM = 8;
__device__ __forceinline__ int lds_byte(int r, int c) { const int st = (r >> 4) * 2 + (c >> 5), rr = r & 15, cc = c & 31, ob = rr * 64 + cc * 2; return st * 1024 + (ob ^ (((ob >> 9) & 1) << 5)); }
__device__ __forceinline__ void stage_rc(int b, int& R, int& C) { const int st = b / 1024, sb = b % 1024, swz = sb ^ (((sb >> 9) & 1) << 5); R = (st >> 1) * 16 + swz / 64; C = (st & 1) * 32 + (swz % 64) / 2; }
__device__ __forceinline__ int perm32(int rho) { const int n = rho >> 4, i = rho & 15; return 8 * (i >> 2) + 4 * n + (i & 3); }
struct Unit { int pm, pn; };
struct Gemm { const bf16_t* A; const bf16_t* Bt; int lda, ldb, K; };
struct StaticOrder {
    int nM, nN, nwg, G, c;
    const int* blk_exp; size_t estride;
    __device__ void init(int nM_, int nN_, int G_, int c_) { nM = nM_; nN = nN_; nwg = nM * nN; G = G_; c = c_; blk_exp = nullptr; estride = 0; }
    __device__ bool next(int i, Unit& u) const {
        const long L = (long)i * G + c; if (L >= nwg) return false;
        int wgid = (int)L; { const int q = nwg / NXCD, r = nwg % NXCD, xcd = wgid % NXCD, off = wgid / NXCD; wgid = (xcd < r ? xcd * (q + 1) : r * (q + 1) + (xcd - r) * q) + off; }
        const int nig = WGM * nN, gid = wgid / nig, fm = gid * WGM, gsz = (nM - fm) < WGM ? (nM - fm) : WGM;
        u.pm = fm + ((wgid % nig) % gsz); u.pn = (wgid % nig) / gsz; return true;
    }
    __device__ __forceinline__ const char* a_ptr(const Gemm& g, const Unit& u) const { return (const char*)(g.A + (size_t)u.pm * 256 * g.lda); }
    __device__ __forceinline__ const char* b_ptr(const Gemm& g, const Unit& u) const {
        size_t e = 0; if (blk_exp) e = (size_t)__builtin_amdgcn_readfirstlane(__hip_atomic_load(blk_exp + u.pm, __ATOMIC_RELAXED, __HIP_MEMORY_SCOPE_AGENT)) * estride;
        return (const char*)(g.Bt + e + (size_t)u.pn * 256 * g.ldb); }
};

template <class Epi, class Sched>
__device__ __forceinline__ void gemm_phase(LAS unsigned char* lds, const Gemm g, const Sched& S, const Epi& E) {
    const int tid = opaque(threadIdx.x), wid = __builtin_amdgcn_readfirstlane(tid >> 6), lane = tid & 63, wr = wid >> 2, wc = wid & 3, fr = lane & 15, fq = lane >> 4;
    const int K = g.K, nt = K / BK;
    unsigned voffA[2], voffB[2];
#pragma unroll
    for (int i = 0; i < 2; ++i) { int R, C; stage_rc(tid * 16 + i * 8192, R, C); const int Rb = (R & ~31) + perm32(R & 31);
        voffA[i] = (unsigned)(R * g.lda + C) * 2u; voffB[i] = (unsigned)(Rb * g.ldb + C) * 2u; }
    const size_t kstep = (size_t)(BK * 2);
    const size_t hstepA = (size_t)HALF * g.lda * 2, hstepB = (size_t)HALF * g.ldb * 2;
    const unsigned ldsw = (unsigned)wid * 1024u;
    const int aoff = lds_byte(wr * 64 + fr, fq * 8), boff = lds_byte(wc * 32 + fr, fq * 8);
#define PG8_SA(b, h) (((b) * 2 + (h)) * HTB)
#define PG8_SB(b, h) ((4 + (b) * 2 + (h)) * HTB)
#define PG8_STAGE(bufoff, gbase, voff) do { _Pragma("unroll") for (int _i = 0; _i < 2; ++_i) \
        __builtin_amdgcn_global_load_lds((const unsigned*)((const char*)(gbase) + (voff)[_i]), (LAS unsigned*)(lds + (bufoff) + ldsw + _i * 8192), 16, 0, 0); } while (0)
#define PG8_LDA(dst, b, h) do { _Pragma("unroll") for (int m = 0; m < 4; ++m) _Pragma("unroll") for (int k = 0; k < 2; ++k) dst[m][k] = *(const LAS bf16x8*)(lds + PG8_SA(b, h) + aoff + m * 2048 + k * 1024); } while (0)
#define PG8_LDB(dst, b, h) do { _Pragma("unroll") for (int n = 0; n < 2; ++n) _Pragma("unroll") for (int k = 0; k < 2; ++k) dst[n][k] = *(const LAS bf16x8*)(lds + PG8_SB(b, h) + boff + n * 2048 + k * 1024); } while (0)
#define PG8_MMA(ai, bj, At, Bt) do { __builtin_amdgcn_s_setprio(1); _Pragma("unroll") for (int m = 0; m < 4; ++m) _Pragma("unroll") for (int n = 0; n < 2; ++n) _Pragma("unroll") for (int k = 0; k < 2; ++k) \
        acc[ai][bj][m][n] = __builtin_amdgcn_mfma_f32_16x16x32_bf16(Bt[n][k], At[m][k], acc[ai][bj][m][n], 0, 0, 0); __builtin_amdgcn_s_setprio(0); } while (0)
#define PG8_WAIT_V(n) asm volatile("s_waitcnt vmcnt(" #n ")" ::: "memory")
#define PG8_WAIT_L(n) asm volatile("s_waitcnt lgkmcnt(" #n ")" ::: "memory")
#define PG8_BAR __builtin_amdgcn_s_barrier()
#define PG8_SCHED __builtin_amdgcn_sched_barrier(0)
    Unit cur, nxt; int ui = 0;
    if (!S.next(0, cur)) return;
    f32x4 acc[2][2][4][2];
#pragma unroll
    for (int a = 0; a < 2; ++a)
#pragma unroll
        for (int b = 0; b < 2; ++b)
#pragma unroll
            for (int m = 0; m < 4; ++m)
#pragma unroll
                for (int n = 0; n < 2; ++n) acc[a][b][m][n] = (f32x4){0.f, 0.f, 0.f, 0.f};
    bf16x8 At[4][2], B0[2][2], B1[2][2];
    const char* cA = S.a_ptr(g, cur); const char* cB = S.b_ptr(g, cur);
    PG8_STAGE(PG8_SB(0, 0), cB, voffB); PG8_STAGE(PG8_SB(0, 1), cB + hstepB, voffB); PG8_STAGE(PG8_SA(0, 0), cA, voffA); PG8_STAGE(PG8_SA(0, 1), cA + hstepA, voffA);
    if (wr == 1) PG8_BAR;
    PG8_WAIT_V(2); PG8_BAR;
    PG8_STAGE(PG8_SB(1, 0), cB + kstep, voffB); PG8_STAGE(PG8_SA(1, 0), cA + kstep, voffA); PG8_STAGE(PG8_SB(1, 1), cB + hstepB + kstep, voffB);
    PG8_WAIT_V(6); PG8_BAR;
    for (;;) {
        const bool has_next = S.next(ui + 1, nxt);
        const char* nA = has_next ? S.a_ptr(g, nxt) : cA; const char* nB = has_next ? S.b_ptr(g, nxt) : cB;
        for (int t = 0; t < nt; t += 2) {
            const bool last = (t == nt - 2);
            const char* a1 = cA + (size_t)(t + 1) * kstep;
            const char* a2 = last ? nA : cA + (size_t)(t + 2) * kstep; const char* b2 = last ? nB : cB + (size_t)(t + 2) * kstep;
            const char* a3 = a2 + kstep; const char* b3 = b2 + kstep;
            PG8_LDB(B0, 0, 0); PG8_LDB(B1, 0, 1); PG8_SCHED; PG8_LDA(At, 0, 0); PG8_STAGE(PG8_SA(1, 1), a1 + hstepA, voffA);
            PG8_WAIT_V(8); PG8_WAIT_L(0); PG8_BAR; PG8_MMA(0, 0, At, B0); PG8_MMA(0, 1, At, B1); PG8_BAR; PG8_SCHED;
            PG8_LDA(At, 0, 1); PG8_STAGE(PG8_SB(0, 0), b2, voffB); PG8_STAGE(PG8_SB(0, 1), b2 + hstepB, voffB); PG8_STAGE(PG8_SA(0, 0), a2, voffA);
            PG8_WAIT_V(8); PG8_WAIT_L(0); PG8_BAR; PG8_MMA(1, 0, At, B0); PG8_MMA(1, 1, At, B1); PG8_BAR; PG8_SCHED;
            PG8_LDB(B0, 1, 0); PG8_LDB(B1, 1, 1); PG8_SCHED; PG8_LDA(At, 1, 0); PG8_STAGE(PG8_SA(0, 1), a2 + hstepA, voffA);
            PG8_WAIT_V(8); PG8_WAIT_L(0); PG8_BAR; PG8_MMA(0, 0, At, B0); PG8_MMA(0, 1, At, B1); PG8_BAR; PG8_SCHED;
            PG8_LDA(At, 1, 1); PG8_STAGE(PG8_SB(1, 0), b3, voffB); PG8_STAGE(PG8_SB(1, 1), b3 + hstepB, voffB); PG8_STAGE(PG8_SA(1, 0), a3, voffA);
            PG8_WAIT_V(8); PG8_WAIT_L(0); PG8_BAR; PG8_MMA(1, 0, At, B0); PG8_MMA(1, 1, At, B1); PG8_BAR; PG8_SCHED;
        }
        if (wr == 0) PG8_BAR;
        E(acc, cur, wr, wc, fr, fq);
        if (!has_next) break;
#pragma unroll
        for (int a = 0; a < 2; ++a)
#pragma unroll
            for (int b = 0; b < 2; ++b)
#pragma unroll
                for (int m = 0; m < 4; ++m)
#pragma unroll
                    for (int n = 0; n < 2; ++n) acc[a][b][m][n] = (f32x4){0.f, 0.f, 0.f, 0.f};
        cur = nxt; cA = nA; cB = nB; ++ui;
        if (wr == 1) PG8_BAR;
    }
    PG8_WAIT_V(0);
    PG8_BAR;
#undef PG8_SA
#undef PG8_SB
#undef PG8_STAGE
#undef PG8_LDA
#undef PG8_LDB
#undef PG8_MMA
#undef PG8_WAIT_V
#undef PG8_WAIT_L
#undef PG8_BAR
#undef PG8_SCHED
}
}
using pg8::Unit;
typedef const f32x4 (&AccRef)[2][2][4][2];

__device__ __forceinline__ u32x4 pack8(f32x4 v0, f32x4 v1) { u32x4 w; w.x = pk2(v0[0], v0[1]); w.y = pk2(v0[2], v0[3]); w.z = pk2(v1[0], v1[1]); w.w = pk2(v1[2], v1[3]); return w; }

struct EpiIn {
    bf16_t* plain; bf16_t* rope; float* ssq; const float* cosT; const float* sinT;
    __device__ __forceinline__ void operator()(AccRef acc, const Unit& u, int wr, int wc, int fr, int fq) const {
        const int row0 = u.pm * 256 + wr * 64 + fr;
        if (u.pn < 31) {
            const int col0 = u.pn * 256 + wc * 32 + 8 * fq;
            const int act = u.pn >= 19 ? 1 : (u.pn >= 15 ? 2 : 0);
#pragma unroll
            for (int ai = 0; ai < 2; ++ai)
#pragma unroll
                for (int m = 0; m < 4; ++m) {
                    const int row = row0 + ai * 128 + m * 16;
                    bf16_t* rowp = plain + (size_t)row * PLAIN_W + col0;
                    float ss = 0.f;
#pragma unroll
                    for (int bj = 0; bj < 2; ++bj) {
                        f32x4 v0 = acc[ai][bj][m][0], v1 = acc[ai][bj][m][1];
                        if (u.pn < 5) {
#pragma unroll
                            for (int j = 0; j < 4; ++j) ss += v0[j] * v0[j] + v1[j] * v1[j];
                        }
                        if (act == 1) {
#pragma unroll
                            for (int j = 0; j < 4; ++j) { v0[j] = fsigmoid(v0[j]); v1[j] = fsigmoid(v1[j]); }
                        } else if (act == 2) {
#pragma unroll
                            for (int j = 0; j < 4; ++j) { v0[j] = fsilu(v0[j]); v1[j] = fsilu(v1[j]); }
                        }
                        *(u32x4*)(rowp + bj * 128) = pack8(v0, v1);
                    }
                    if (u.pn < 5) {
                        ss += __shfl_xor(ss, 16); ss += __shfl_xor(ss, 32);
                        if (fq == 0) ssq[(size_t)row * 20 + u.pn * 4 + wc] = ss;
                    }
                }
        } else {
            const int slot = (u.pn - 31) * 4 + wc;
#pragma unroll
            for (int ai = 0; ai < 2; ++ai)
#pragma unroll
                for (int m = 0; m < 4; ++m) {
                    const int row = row0 + ai * 128 + m * 16;
                    const f32x4 c0 = *(const f32x4*)(cosT + (size_t)row * 32 + 8 * fq), c1 = *(const f32x4*)(cosT + (size_t)row * 32 + 8 * fq + 4);
                    const f32x4 s0 = *(const f32x4*)(sinT + (size_t)row * 32 + 8 * fq), s1 = *(const f32x4*)(sinT + (size_t)row * 32 + 8 * fq + 4);
                    const f32x4 a0 = acc[ai][0][m][0], a1 = acc[ai][0][m][1], b0 = acc[ai][1][m][0], b1 = acc[ai][1][m][1];
                    const f32x4 o10 = a0 * c0 - b0 * s0, o11 = a1 * c1 - b1 * s1, o20 = b0 * c0 + a0 * s0, o21 = b1 * c1 + a1 * s1;
                    bf16_t* rowp = rope + (size_t)row * ROPE_W + slot * 64 + 8 * fq;
                    *(u32x4*)(rowp) = pack8(o10, o11);
                    *(u32x4*)(rowp + 32) = pack8(o20, o21);
                }
        }
    }
};
struct EpiQ {
    bf16_t* q; const float* ssq; const float* cosT; const float* sinT; float c2;
    __device__ __forceinline__ void operator()(AccRef acc, const Unit& u, int wr, int wc, int fr, int fq) const {
        const int row0 = u.pm * 256 + wr * 64 + fr;
#pragma unroll
        for (int ai = 0; ai < 2; ++ai)
#pragma unroll
            for (int m = 0; m < 4; ++m) {
                const int row = row0 + ai * 128 + m * 16;
                const f32x4 p0 = *(const f32x4*)(ssq + (size_t)row * 20), p1 = *(const f32x4*)(ssq + (size_t)row * 20 + 4), p2 = *(const f32x4*)(ssq + (size_t)row * 20 + 8);
                const float tot = ((p0[0] + p0[1]) + (p0[2] + p0[3])) + ((p1[0] + p1[1]) + (p1[2] + p1[3])) + ((p2[0] + p2[1]) + (p2[2] + p2[3]));
                const float rs = c2 * __builtin_amdgcn_rsqf(tot * (1.0f / 768.0f) + EPS);
                if (u.pn < 4) {
#pragma unroll
                    for (int bj = 0; bj < 2; ++bj) {
                        bf16_t* dst = q + (size_t)row * QW + (2 * u.pn + bj) * 192 + wc * 32 + 8 * fq;
                        *(u32x4*)dst = pack8(acc[ai][bj][m][0] * rs, acc[ai][bj][m][1] * rs);
                    }
                } else {
                    const int head = (u.pn - 4) * 4 + wc;
                    const f32x4 c0 = *(const f32x4*)(cosT + (size_t)row * 32 + 8 * fq), c1 = *(const f32x4*)(cosT + (size_t)row * 32 + 8 * fq + 4);
                    const f32x4 s0 = *(const f32x4*)(sinT + (size_t)row * 32 + 8 * fq), s1 = *(const f32x4*)(sinT + (size_t)row * 32 + 8 * fq + 4);
                    const f32x4 a0 = acc[ai][0][m][0] * rs, a1 = acc[ai][0][m][1] * rs, b0 = acc[ai][1][m][0] * rs, b1 = acc[ai][1][m][1] * rs;
                    bf16_t* dst = q + (size_t)row * QW + head * 192 + 128 + 8 * fq;
                    *(u32x4*)dst = pack8(a0 * c0 - b0 * s0, a1 * c1 - b1 * s1);
                    *(u32x4*)(dst + 32) = pack8(b0 * c0 + a0 * s0, b1 * c1 + a1 * s1);
                }
            }
    }
};
struct EpiKV {
    bf16_t* kv; const float* ssq;
    __device__ __forceinline__ void operator()(AccRef acc, const Unit& u, int wr, int wc, int fr, int fq) const {
        const int row0 = u.pm * 256 + wr * 64 + fr, col0 = u.pn * 256 + wc * 32 + 8 * fq;
#pragma unroll
        for (int ai = 0; ai < 2; ++ai)
#pragma unroll
            for (int m = 0; m < 4; ++m) {
                const int row = row0 + ai * 128 + m * 16;
                const f32x4 p0 = *(const f32x4*)(ssq + (size_t)row * 20 + 12), p1 = *(const f32x4*)(ssq + (size_t)row * 20 + 16);
                const float tot = ((p0[0] + p0[1]) + (p0[2] + p0[3])) + ((p1[0] + p1[1]) + (p1[2] + p1[3]));
                const float rs = __builtin_amdgcn_rsqf(tot * (1.0f / 512.0f) + EPS);
#pragma unroll
                for (int bj = 0; bj < 2; ++bj)
                    *(u32x4*)(kv + (size_t)row * KVW + col0 + bj * 128) = pack8(acc[ai][bj][m][0] * rs, acc[ai][bj][m][1] * rs);
            }
    }
};
struct EpiBr {
    float* mf; bf16_t* mb; const bf16_t* gate; int mode;
    __device__ __forceinline__ void operator()(AccRef acc, const Unit& u, int wr, int wc, int fr, int fq) const {
        const int row0 = u.pm * 256 + wr * 64 + fr, col0 = u.pn * 256 + wc * 32 + 8 * fq;
#pragma unroll
        for (int ai = 0; ai < 2; ++ai)
#pragma unroll
            for (int m = 0; m < 4; ++m) {
                const int row = row0 + ai * 128 + m * 16;
#pragma unroll
                for (int bj = 0; bj < 2; ++bj) {
                    const int col = col0 + bj * 128;
                    const u32x4 gw = *(const u32x4*)(gate + (size_t)row * PLAIN_W + col);
                    f32x4 g0 = {bf2f(gw.x & 0xffffu), bf2f(gw.x >> 16), bf2f(gw.y & 0xffffu), bf2f(gw.y >> 16)};
                    f32x4 g1 = {bf2f(gw.z & 0xffffu), bf2f(gw.z >> 16), bf2f(gw.w & 0xffffu), bf2f(gw.w >> 16)};
                    f32x4 v0 = acc[ai][bj][m][0] * g0, v1 = acc[ai][bj][m][1] * g1;
                    float* mp = mf + (size_t)row * DM + col;
                    if (mode != 0) { v0 += *(const f32x4*)mp; v1 += *(const f32x4*)(mp + 4); }
                    if (mode != 2) { *(f32x4*)mp = v0; *(f32x4*)(mp + 4) = v1; }
                    else *(u32x4*)(mb + (size_t)row * DM + col) = pack8(v0, v1);
                }
            }
    }
};
struct EpiRes {
    const float* base; float* out; const float* gate;
    __device__ __forceinline__ void operator()(AccRef acc, const Unit& u, int wr, int wc, int fr, int fq) const {
        const int row0 = u.pm * 256 + wr * 64 + fr, col0 = u.pn * 256 + wc * 32 + 8 * fq;
        const float* gp = gate + (size_t)(u.pm >> 3) * 6144;
        f32x4 g[2][2];
#pragma unroll
        for (int bj = 0; bj < 2; ++bj) { g[bj][0] = *(const f32x4*)(gp + col0 + bj * 128); g[bj][1] = *(const f32x4*)(gp + col0 + bj * 128 + 4); }
#pragma unroll
        for (int ai = 0; ai < 2; ++ai)
#pragma unroll
            for (int m = 0; m < 4; ++m) {
                const size_t off = (size_t)(row0 + ai * 128 + m * 16) * DM + col0;
#pragma unroll
                for (int bj = 0; bj < 2; ++bj) {
                    const f32x4 b0 = *(const f32x4*)(base + off + bj * 128), b1 = *(const f32x4*)(base + off + bj * 128 + 4);
                    *(f32x4*)(out + off + bj * 128) = b0 + g[bj][0] * acc[ai][bj][m][0];
                    *(f32x4*)(out + off + bj * 128 + 4) = b1 + g[bj][1] * acc[ai][bj][m][1];
                }
            }
    }
};
struct EpiSwi {
    bf16_t* hid; int ld;
    __device__ __forceinline__ void operator()(AccRef acc, const Unit& u, int wr, int wc, int fr, int fq) const {
        const int row0 = u.pm * 256 + wr * 64 + fr, col0 = u.pn * 128 + wc * 32 + 8 * fq;
#pragma unroll
        for (int ai = 0; ai < 2; ++ai)
#pragma unroll
            for (int m = 0; m < 4; ++m) {
                f32x4 v0, v1;
#pragma unroll
                for (int j = 0; j < 4; ++j) { v0[j] = fsilu(acc[ai][0][m][0][j]) * acc[ai][1][m][0][j]; v1[j] = fsilu(acc[ai][0][m][1][j]) * acc[ai][1][m][1][j]; }
                *(u32x4*)(hid + (size_t)(row0 + ai * 128 + m * 16) * ld + col0) = pack8(v0, v1);
            }
    }
};
struct EpiPlain {
    bf16_t* o; int ld;
    __device__ __forceinline__ void operator()(AccRef acc, const Unit& u, int wr, int wc, int fr, int fq) const {
        const int row0 = u.pm * 256 + wr * 64 + fr, col0 = u.pn * 256 + wc * 32 + 8 * fq;
#pragma unroll
        for (int ai = 0; ai < 2; ++ai)
#pragma unroll
            for (int m = 0; m < 4; ++m)
#pragma unroll
                for (int bj = 0; bj < 2; ++bj)
                    *(u32x4*)(o + (size_t)(row0 + ai * 128 + m * 16) * ld + col0 + bj * 128) = pack8(acc[ai][bj][m][0], acc[ai][bj][m][1]);
    }
};

struct Frame {
    LAS unsigned char* lds; int tid, lane, wave, G, gw, ngw;
};
__device__ __forceinline__ Frame mkframe(LAS unsigned char* lds) { Frame F; F.lds = lds; F.tid = opaque(threadIdx.x); F.lane = F.tid & 63; F.wave = __builtin_amdgcn_readfirstlane(F.tid >> 6);
    F.G = gridDim.x; F.gw = blockIdx.x * 8 + F.wave; F.ngw = F.G * 8; return F; }

__device__ __forceinline__ void cvt_item(const float* src, int ld, int c0, bool valid, float sn, const float* gain, bf16_t* dst, int Kd, int n0, int k0, LAS float* scr, int lane) {
    float v[32];
    if (valid) {
#pragma unroll
        for (int i = 0; i < 32; ++i) v[i] = __builtin_nontemporal_load(src + (size_t)(k0 + 2 * i + (lane >> 5)) * ld + c0 + (lane & 31));
    } else {
#pragma unroll
        for (int i = 0; i < 32; ++i) v[i] = 0.f;
    }
    if (gain) {
#pragma unroll
        for (int i = 0; i < 32; ++i) v[i] *= gain[k0 + 2 * i + (lane >> 5)];
    }
#pragma unroll
    for (int i = 0; i < 32; ++i) scr[(2 * i + (lane >> 5)) * 33 + (lane & 31)] = v[i] * sn;
    asm volatile("s_waitcnt lgkmcnt(0)" ::: "memory");
    const int c = lane & 7;
#pragma unroll
    for (int j = 0; j < 4; ++j) { const int n = (lane >> 3) + 8 * j; const LAS float* s = scr + (8 * c) * 33 + n;
        u32x4 o; o.x = pk2(s[0 * 33], s[1 * 33]); o.y = pk2(s[2 * 33], s[3 * 33]); o.z = pk2(s[4 * 33], s[5 * 33]); o.w = pk2(s[6 * 33], s[7 * 33]);
        *(u32x4*)(dst + (size_t)(n0 + n) * Kd + k0 + 8 * c) = o; }
    asm volatile("s_waitcnt lgkmcnt(0)" ::: "memory");
}
__device__ __forceinline__ void win_map(int nb, int& c0, float& sn) {
    const int n0 = nb * 32; sn = 1.f;
    if (n0 < PLAIN_W) {
        if (n0 < PC_DV) { c0 = n0; return; }
        if (n0 < PC_RV) { c0 = 4416 + (n0 - PC_DV); return; }
        if (n0 < PC_RG) { c0 = 6976 + (n0 - PC_RV); return; }
        c0 = 8000 + (n0 - PC_RG); return;
    }
    const int r = n0 - PLAIN_W, tile = r >> 8, p = r & 255, bj = p >> 7, hh = (p & 127) >> 5;
    const int slot = tile * 4 + hh;
    int base;
    if (slot == 0) base = 1280;
    else if (slot < RS_DK) { base = 1344 + (slot - RS_DQ) * 64; sn = 0.125f; }
    else if (slot < RS_RQ) base = 2880 + (slot - RS_DK) * 64;
    else if (slot < RS_RK) base = 5952 + (slot - RS_RQ) * 64;
    else if (slot < 65) { base = 6464 + (slot - RS_RK) * 64; sn = 0.125f; }
    else { c0 = -1; return; }
    c0 = base + bj * 32;
}
__device__ __forceinline__ void p0_convert(Frame& F0, bool moe_only, int moe_layer) {
    Frame F = mkframe(F0.lds);
    LAS float* scr = (LAS float*)(F.lds + F.wave * 16384);
    unsigned char* ws = WSP();
    constexpr int I_WIN = 4 * 16 * 384, I_UQ = 4 * 12 * 48, I_UKV = 4 * 8 * 64, I_BM = 4 * 16 * 32, I_BD = 4 * 8 * 32, I_BR = 4 * 16 * 32, I_WO = 4 * 16 * 32;
    constexpr int I_F13 = 2 * 16 * 176, I_F2 = 2 * 44 * 32, I_M13 = 8 * 16 * 224, I_M2 = 8 * 56 * 32;
    constexpr int I_ALL = I_WIN + I_UQ + I_UKV + I_BM + I_BD + I_BR + I_WO + I_F13 + I_F2;
    const int total = moe_only ? (I_M13 + I_M2) : (I_ALL + I_M13 + I_M2);
    for (int it = F.gw; it < total; it += F.ngw) {
        int r = it;
        if (!moe_only) {
            if (r < I_WIN) { const int l = r / (16 * 384), q = r % (16 * 384), kb = q / 384, nb = q % 384; int c0; float sn; win_map(nb, c0, sn);
                cvt_item(GP(const float, w_in) + (size_t)l * DM * IN_COLS, IN_COLS, c0 < 0 ? 0 : c0, c0 >= 0, sn, nullptr, (bf16_t*)(ws + WS_WIN) + (size_t)l * NIN * DM, DM, nb * 32, kb * 64, scr, F.lane); continue; } r -= I_WIN;
            if (r < I_UQ) { const int l = r / (12 * 48), q = r % (12 * 48), kb = q / 48, nb = q % 48; const int n0 = nb * 32; int c0;
                if (n0 < 1024) { const int head = n0 >> 7; c0 = head * 192 + (n0 & 127); }
                else { const int rr = n0 - 1024, tile = rr >> 8, p = rr & 255, bj = p >> 7, hh = (p & 127) >> 5; c0 = (tile * 4 + hh) * 192 + 128 + bj * 32; }
                cvt_item(GP(const float, w_uq) + (size_t)l * 768 * QW, QW, c0, true, 1.f, GP(const float, q_norm) + l * 768, (bf16_t*)(ws + WS_WUQ) + (size_t)l * QW * 768, 768, n0, kb * 64, scr, F.lane); continue; } r -= I_UQ;
            if (r < I_UKV) { const int l = r / (8 * 64), q = r % (8 * 64), kb = q / 64, nb = q % 64;
                cvt_item(GP(const float, w_ukv) + (size_t)l * 512 * KVW, KVW, nb * 32, true, 1.f, GP(const float, kv_norm) + l * 512, (bf16_t*)(ws + WS_WUKV) + (size_t)l * KVW * 512, 512, nb * 32, kb * 64, scr, F.lane); continue; } r -= I_UKV;
            if (r < I_BM) { const int l = r / (16 * 32), q = r % (16 * 32), kb = q / 32, nb = q % 32;
                cvt_item(GP(const float, w_br_mla) + (size_t)l * DM * DM, DM, nb * 32, true, 1.f, nullptr, (bf16_t*)(ws + WS_WBM) + (size_t)l * DM * DM, DM, nb * 32, kb * 64, scr, F.lane); continue; } r -= I_BM;
            if (r < I_BD) { const int l = r / (8 * 32), q = r % (8 * 32), kb = q / 32, nb = q % 32;
                cvt_item(GP(const float, w_br_dil) + (size_t)l * 512 * DM, DM, nb * 32, true, 1.f, nullptr, (bf16_t*)(ws + WS_WBD) + (size_t)l * DM * 512, 512, nb * 32, kb * 64, scr, F.lane); continue; } r -= I_BD;
            if (r < I_BR) { const int l = r / (16 * 32), q = r % (16 * 32), kb = q / 32, nb = q % 32;
                cvt_item(GP(const float, w_br_ret) + (size_t)l * DM * DM, DM, nb * 32, true, 1.f, nullptr, (bf16_t*)(ws + WS_WBR) + (size_t)l * DM * DM, DM, nb * 32, kb * 64, scr, F.lane); continue; } r -= I_BR;
            if (r < I_WO) { const int l = r / (16 * 32), q = r % (16 * 32), kb = q / 32, nb = q % 32;
                cvt_item(GP(const float, w_out) + (size_t)l * DM * DM, DM, nb * 32, true, 1.f, nullptr, (bf16_t*)(ws + WS_WO) + (size_t)l * DM * DM, DM, nb * 32, kb * 64, scr, F.lane); continue; } r -= I_WO;
            if (r < I_F13) { const int i = r / (16 * 176), q = r % (16 * 176), kb = q / 176, nb = q % 176; const int n0 = nb * 32, tile = n0 >> 8, p = n0 & 255;
                const float* src = (p < 128 ? GP(const float, ffn_w1) : GP(const float, ffn_w3)) + (size_t)i * DM * DFF;
                cvt_item(src, DFF, tile * 128 + (p & 127), true, 1.f, nullptr, (bf16_t*)(ws + WS_W13) + (size_t)i * 5632 * DM, DM, n0, kb * 64, scr, F.lane); continue; } r -= I_F13;
            if (r < I_F2) { const int i = r / (44 * 32), q = r % (44 * 32), kb = q / 32, nb = q % 32;
                cvt_item(GP(const float, ffn_w2) + (size_t)i * DFF * DM, DM, nb * 32, true, 1.f, nullptr, (bf16_t*)(ws + WS_W2) + (size_t)i * DM * DFF, DFF, nb * 32, kb * 64, scr, F.lane); continue; } r -= I_F2;
        }
        if (r < I_M13) { const int e = r / (16 * 224), q = r % (16 * 224), kb = q / 224, nb = q % 224; const int n0 = nb * 32, tile = n0 >> 8, p = n0 & 255;
            const float* src = (p < 128 ? GP(const float, moe_w1) : GP(const float, moe_w3)) + ((size_t)moe_layer * NEXP + e) * DM * DFE;
            cvt_item(src, DFE, tile * 128 + (p & 127), true, 1.f, nullptr, (bf16_t*)(ws + WS_W13E) + (size_t)e * 7168 * DM, DM, n0, kb * 64, scr, F.lane); continue; } r -= I_M13;
        { const int e = r / (56 * 32), q = r % (56 * 32), kb = q / 32, nb = q % 32;
            cvt_item(GP(const float, moe_w2) + ((size_t)moe_layer * NEXP + e) * DFE * DM, DM, nb * 32, true, 1.f, nullptr, (bf16_t*)(ws + WS_W2E) + (size_t)e * DM * DFE, DFE, nb * 32, kb * 64, scr, F.lane); }
    }    __syncthreads();
}
__device__ __forceinline__ void p0_tables(Frame& F0) {
    Frame F = mkframe(F0.lds);
    float* cosT = (float*)(WSP() + WS_COS); float* sinT = (float*)(WSP() + WS_SIN);
    const int* pos = GP(const int, positions);
    for (int i = blockIdx.x * 512 + F.tid; i < T * 32; i += F.G * 512) {
        const int t = i >> 5, f = i & 31;
        const double rev = (double)pos[t] * ((const volatile LAS double*)(F.lds + LDS_PTRS + (int)__builtin_offsetof(Params, inv_freq)))[f] * 0.15915494309189533577;
        const double fr = rev - __builtin_rint(rev);
        cosT[i] = __builtin_amdgcn_cosf((float)fr); sinT[i] = __builtin_amdgcn_sinf((float)fr);
    }
    float* modp = (float*)(WSP() + WS_MODP);
    LAS float* cact = (LAS float*)F.lds;
    { const float* cp = GP(const float, c); for (int i = F.tid; i < 8 * DM; i += 512) cact[i] = fsilu(cp[i]); }
    __syncthreads();
    for (int it = F.gw; it < 4 * 96 * 16; it += F.ngw) {
        const int sl = it & 15, cg = (it >> 4) % 96, l = it / (16 * 96);
        const int n = cg * 64 + F.lane;
        float acc[8];
#pragma unroll
        for (int b = 0; b < 8; ++b) acc[b] = 0.f;
        const float* w = GP(const float, ada_w) + (size_t)l * DM * 6144 + n + (size_t)sl * 64 * 6144;
#pragma unroll 1
        for (int k8 = 0; k8 < 8; ++k8) {
            float wv[8];
#pragma unroll
            for (int q = 0; q < 8; ++q) wv[q] = __builtin_nontemporal_load(w + (size_t)(k8 * 8 + q) * 6144);
#pragma unroll
            for (int q = 0; q < 8; ++q)
#pragma unroll
                for (int b = 0; b < 8; ++b) acc[b] += cact[b * DM + sl * 64 + k8 * 8 + q] * wv[q];
        }
#pragma unroll
        for (int b = 0; b < 8; ++b) modp[(((size_t)sl * 4 + l) * 8 + b) * 6144 + n] = acc[b];
    }
    __syncthreads();
}
__device__ __forceinline__ void p0_modreduce(Frame& F0) {
    Frame F = mkframe(F0.lds);
    const float* modp = (const float*)(WSP() + WS_MODP); float* mod = (float*)(WSP() + WS_MOD);
    for (int i = blockIdx.x * 512 + F.tid; i < 4 * 8 * 6144; i += F.G * 512) {
        const int n = i % 6144, l = i / (8 * 6144);
        float s = GP(const float, ada_b)[l * 6144 + n];
        for (int sl = 0; sl < 16; ++sl) s += modp[(size_t)sl * 4 * 8 * 6144 + i];
        mod[i] = s;
    }
}

template <bool COMBINE, bool ROUTER, bool FINAL>
__device__ __forceinline__ void phase_norm(Frame& F0, const float* xin, float* xout, const float* gvec, const float* scale, const float* shift, const float* gate2,
                                           const float* wr) {
    Frame F = mkframe(F0.lds);
    bf16_t* H = (bf16_t*)(WSP() + WS_H);
    int* moei = (int*)(WSP() + WS_MOEI);
    const bf16_t* YB = (const bf16_t*)(WSP() + WS_YB);
    for (int ch = F.gw; ch < T / 8; ch += F.ngw) {
        int cnt[8];
#pragma unroll
        for (int e = 0; e < 8; ++e) cnt[e] = 0;
        for (int rr = 0; rr < 8; ++rr) {
            const int row = ch * 8 + rr, b = row >> 11;
            const f32x4* xr = (const f32x4*)(xin + (size_t)row * DM) + F.lane;
            f32x4 v[4];
#pragma unroll
            for (int j = 0; j < 4; ++j) v[j] = xr[64 * j];
            if (COMBINE) {
                const int p0 = moei[MI_TOKP + 2 * row], p1 = moei[MI_TOKP + 2 * row + 1];
                const float w0 = __int_as_float(moei[MI_TOKW + 2 * row]), w1 = __int_as_float(moei[MI_TOKW + 2 * row + 1]);
#pragma unroll
                for (int j = 0; j < 4; ++j) {
                    const u32x2 a = *((const u32x2*)(YB + (size_t)p0 * DM) + F.lane + 64 * j), c = *((const u32x2*)(YB + (size_t)p1 * DM) + F.lane + 64 * j);
                    const f32x4 g = *((const f32x4*)(gate2 + (size_t)b * 6144) + F.lane + 64 * j);
                    f32x4 y; y[0] = w0 * bf2f(a.x & 0xffffu) + w1 * bf2f(c.x & 0xffffu); y[1] = w0 * bf2f(a.x >> 16) + w1 * bf2f(c.x >> 16);
                    y[2] = w0 * bf2f(a.y & 0xffffu) + w1 * bf2f(c.y & 0xffffu); y[3] = w0 * bf2f(a.y >> 16) + w1 * bf2f(c.y >> 16);
                    v[j] = v[j] + g * y;
                }
                if (!FINAL) {
#pragma unroll
                    for (int j = 0; j < 4; ++j) *((f32x4*)(xout + (size_t)row * DM) + F.lane + 64 * j) = v[j];
                }
            }
            float s = 0.f;
#pragma unroll
            for (int j = 0; j < 4; ++j) s += (v[j][0] * v[j][0] + v[j][1] * v[j][1]) + (v[j][2] * v[j][2] + v[j][3] * v[j][3]);
            const float rs = 1.0f / sqrtf(wave_sum(s) * (1.0f / DM) + EPS);
            if (FINAL) {
#pragma unroll
                for (int j = 0; j < 4; ++j) { const f32x4 g = *((const f32x4*)gvec + F.lane + 64 * j); *((f32x4*)(xout + (size_t)row * DM) + F.lane + 64 * j) = v[j] * rs * g; }
                continue;
            }
            f32x4 h[4];
#pragma unroll
            for (int j = 0; j < 4; ++j) {
                const f32x4 g = *((const f32x4*)gvec + F.lane + 64 * j), sc = *((const f32x4*)(scale + (size_t)b * 6144) + F.lane + 64 * j), sh = *((const f32x4*)(shift + (size_t)b * 6144) + F.lane + 64 * j);
                h[j] = v[j] * rs * g * (1.0f + sc) + sh;
                u32x2 o; o.x = pk2(h[j][0], h[j][1]); o.y = pk2(h[j][2], h[j][3]);
                *((u32x2*)(H + (size_t)row * DM) + F.lane + 64 * j) = o;
            }
            if (ROUTER) {
                float lg[8];
#pragma unroll
                for (int e = 0; e < 8; ++e) lg[e] = 0.f;
#pragma unroll
                for (int j = 0; j < 4; ++j)
#pragma unroll
                    for (int q = 0; q < 4; ++q) {
                        const int k = 4 * F.lane + 256 * j + q;
                        const f32x4 w0 = *(const f32x4*)(wr + (size_t)k * 8), w1 = *(const f32x4*)(wr + (size_t)k * 8 + 4);
                        const float hv = h[j][q];
                        lg[0] += hv * w0[0]; lg[1] += hv * w0[1]; lg[2] += hv * w0[2]; lg[3] += hv * w0[3];
                        lg[4] += hv * w1[0]; lg[5] += hv * w1[1]; lg[6] += hv * w1[2]; lg[7] += hv * w1[3];
                    }
#pragma unroll
                for (int e = 0; e < 8; ++e) lg[e] = wave_sum(lg[e]);
                int e0 = 0; float v0 = lg[0];
#pragma unroll
                for (int e = 1; e < 8; ++e) if (lg[e] > v0) { v0 = lg[e]; e0 = e; }
                int e1 = -1; float v1 = -3.0e38f;
#pragma unroll
                for (int e = 0; e < 8; ++e) if (e != e0 && lg[e] > v1) { v1 = lg[e]; e1 = e; }
                const float ex = __expf(v1 - v0), w0 = 1.0f / (1.0f + ex), w1 = ex / (1.0f + ex);
                if (F.lane == 0) { moei[MI_TOKE + 2 * row] = e0; moei[MI_TOKE + 2 * row + 1] = e1; moei[MI_TOKW + 2 * row] = __float_as_int(w0); moei[MI_TOKW + 2 * row + 1] = __float_as_int(w1); }
#pragma unroll
                for (int e = 0; e < 8; ++e) cnt[e] += (e == e0) + (e == e1);
            }
        }
        if (ROUTER && F.lane == 0) {
#pragma unroll
            for (int e = 0; e < 8; ++e) moei[MI_CNT + ch * 8 + e] = cnt[e];
        }
    }
}

__device__ __forceinline__ void phase_moe_gather(Frame& F0) {
    Frame F = mkframe(F0.lds);
    int* moei = (int*)(WSP() + WS_MOEI);
    LAS int* pre = (LAS int*)F.lds;
    LAS int* seg = (LAS int*)(F.lds + 65536);
    LAS int* pst = (LAS int*)(F.lds + 65536 + 4096);
    const int e = F.tid & 7, sg = F.tid >> 3;
    {
        int run = 0;
        for (int i = 0; i < 32; ++i) { const int ch = sg * 32 + i; const int c = moei[MI_CNT + ch * 8 + e]; pre[ch * 8 + e] = run; run += c; }
        seg[sg * 8 + e] = run;
    }
    __syncthreads();
    if (F.tid < 8) {
        int run = 0;
        for (int s = 0; s < 64; ++s) { const int c = seg[s * 8 + F.tid]; seg[s * 8 + F.tid] = run; run += c; }
        seg[64 * 8 + F.tid] = run;
    }
    __syncthreads();
    if (F.tid < 8) {
        const int tot = seg[64 * 8 + F.tid]; const int padded = (tot + 255) & ~255;
        int ps = 0;
        for (int q = 0; q < 8; ++q) { const int pq = __shfl(padded, q); if (q < F.tid) ps += pq; }
        pst[F.tid] = ps;
        if (blockIdx.x == 0) {
            for (int q = 0; q < (padded >> 8); ++q) moei[MI_BLK + 1 + (ps >> 8) + q] = F.tid;
            if (F.tid == 7) moei[MI_BLK] = (ps + padded) >> 8;
        }
    }
    __syncthreads();
    const bf16_t* H = (const bf16_t*)(WSP() + WS_H); bf16_t* XG = (bf16_t*)(WSP() + WS_XG);
    for (int ch = F.gw; ch < T / 8; ch += F.ngw) {
        const int a = F.lane & 15; const int row = ch * 8 + (a >> 1);
        const int ea = moei[MI_TOKE + 2 * row + (a & 1)];
        int rank = 0;
        for (int q = 0; q < 16; ++q) { const int eq = __shfl(ea, q); if (q < a && eq == ea) ++rank; }
        const int dest = pst[ea] + seg[(ch >> 5) * 8 + ea] + pre[ch * 8 + ea] + rank;
        if (F.lane < 16) moei[MI_TOKP + 2 * row + (a & 1)] = dest;
        for (int q = 0; q < 16; ++q) {
            const int dq = __shfl(dest, q); const int rq = ch * 8 + (q >> 1);
            const u32x4* s = (const u32x4*)(H + (size_t)rq * DM); u32x4* d = (u32x4*)(XG + (size_t)dq * DM);
            d[F.lane] = s[F.lane]; d[F.lane + 64] = s[F.lane + 64];
        }
    }
    __syncthreads();
}

namespace mla {
constexpr int KROW = 400;
constexpr int SHM_K = 64 * KROW, SHM_V = 64 * 128 * 2;
constexpr int OFF_V = 0, OFF_K = 2 * SHM_V, OFF_WS = 2 * SHM_V + 2 * SHM_K;
__device__ __forceinline__ int crow(int r, int hi) { return (r & 3) + 8 * (r >> 2) + 4 * hi; }
__device__ __forceinline__ int v_st(int k, int c) { const int kk = (k & ~0xC) | ((k & 4) << 1) | ((k & 8) >> 1); return ((kk >> 3) * 4 + (c >> 5)) * 512 + ((kk & 7) * 32 + (c & 31)) * 2; }
__device__ __forceinline__ int v_rd_base(int lane) { return ((lane & 3) << 3) | (((lane >> 2) & 3) << 6) | (((lane >> 4) & 1) << 5) | (((lane >> 5) & 1) << 8); }
constexpr int v_rd_off(int d0, int ks, int half) { return d0 * 512 + ks * 4096 + half * 2048; }
template <int OFF> __device__ __forceinline__ s16x4 tr_read(LAS unsigned char* vb) { return __builtin_amdgcn_ds_read_tr16_b64_v4i16((LAS s16x4*)(vb + OFF)); }
template <int D0> __device__ __forceinline__ void pv_one(f32x16& od, LAS unsigned char* vb, bf16x8 pa0, bf16x8 pa1, bf16x8 pa2, bf16x8 pa3) {
    const s16x4 l0 = tr_read<v_rd_off(D0, 0, 0)>(vb), h0 = tr_read<v_rd_off(D0, 0, 1)>(vb), l1 = tr_read<v_rd_off(D0, 1, 0)>(vb), h1 = tr_read<v_rd_off(D0, 1, 1)>(vb);
    const s16x4 l2 = tr_read<v_rd_off(D0, 2, 0)>(vb), h2 = tr_read<v_rd_off(D0, 2, 1)>(vb), l3 = tr_read<v_rd_off(D0, 3, 0)>(vb), h3 = tr_read<v_rd_off(D0, 3, 1)>(vb);
#define PK(L, H) (bf16x8){L[0], L[1], L[2], L[3], H[0], H[1], H[2], H[3]}
    od = __builtin_amdgcn_mfma_f32_32x32x16_bf16(pa0, PK(l0, h0), od, 0, 0, 0);
    od = __builtin_amdgcn_mfma_f32_32x32x16_bf16(pa1, PK(l1, h1), od, 0, 0, 0);
    od = __builtin_amdgcn_mfma_f32_32x32x16_bf16(pa2, PK(l2, h2), od, 0, 0, 0);
    od = __builtin_amdgcn_mfma_f32_32x32x16_bf16(pa3, PK(l3, h3), od, 0, 0, 0);
#undef PK
}
__device__ __forceinline__ void unit(const bf16_t* Qb, const bf16_t* Kn, const bf16_t* Kr, const bf16_t* Vh, bf16_t* Ob, LAS unsigned char* lds, int tid) {
    const int wid = tid >> 6, lane = tid & 63, r32 = lane & 31, hi = lane >> 5;
    LAS unsigned char* V_lds = lds + OFF_V; LAS unsigned char* K_lds = lds + OFF_K;
    LAS float* wsf = (LAS float*)(lds + OFF_WS) + wid * 64; LAS float* li_l = wsf; LAS float* al_l = wsf + 32;
    float m_reg = -1e30f, l_reg = 0.f; f32x16 o[4];
#pragma unroll
    for (int d = 0; d < 4; ++d)
#pragma unroll
        for (int r = 0; r < 16; ++r) o[d][r] = 0.f;
    bf16x8 qr[12];
    const bf16_t* Qw = Qb + (size_t)(wid * 32 + r32) * QW + hi * 8;
#pragma unroll
    for (int d0 = 0; d0 < 12; ++d0) qr[d0] = *(const bf16x8*)(Qw + d0 * 16);
    const int sr = tid >> 4, sc = (tid & 15) * 8, vst0 = v_st(sr, sc), vst1 = v_st(32 + sr, sc);
    const int rr = tid >> 3, rc = (tid & 7) * 8;
    LAS unsigned char* vb0 = V_lds + v_rd_base(lane);
    bf16x8 vs0, vs1, ks0, ks1, kr0;
#define SLOAD(k0) do { vs0 = *(const bf16x8*)(Vh + (size_t)((k0) + sr) * KVW + sc); vs1 = *(const bf16x8*)(Vh + (size_t)((k0) + 32 + sr) * KVW + sc); \
    ks0 = *(const bf16x8*)(Kn + (size_t)((k0) + sr) * KVW + sc); ks1 = *(const bf16x8*)(Kn + (size_t)((k0) + 32 + sr) * KVW + sc); \
    kr0 = *(const bf16x8*)(Kr + (size_t)((k0) + rr) * ROPE_W + rc); } while (0)
#define SWRITE(b) do { *(LAS bf16x8*)(V_lds + (b) * SHM_V + vst0) = vs0; *(LAS bf16x8*)(V_lds + (b) * SHM_V + vst1) = vs1; \
    *(LAS bf16x8*)(K_lds + (b) * SHM_K + sr * KROW + sc * 2) = ks0; *(LAS bf16x8*)(K_lds + (b) * SHM_K + (32 + sr) * KROW + sc * 2) = ks1; \
    *(LAS bf16x8*)(K_lds + (b) * SHM_K + rr * KROW + 256 + rc * 2) = kr0; } while (0)
    constexpr int NT = SEQ / 64;
    SLOAD(0); SWRITE(0); __syncthreads();
    for (int j = 0; j < NT; ++j) {
        const int bsel = j & 1;
        f32x16 p0, p1;
#pragma unroll
        for (int r = 0; r < 16; ++r) { p0[r] = 0.f; p1[r] = 0.f; }
        LAS unsigned char* Kb = K_lds + bsel * SHM_K;
#pragma unroll
        for (int d0 = 0; d0 < 12; ++d0) { const int cb = (d0 * 16 + hi * 8) * 2;
            const bf16x8 b0 = *(const LAS bf16x8*)(Kb + r32 * KROW + cb), b1 = *(const LAS bf16x8*)(Kb + (32 + r32) * KROW + cb);
            p0 = __builtin_amdgcn_mfma_f32_32x32x16_bf16(b0, qr[d0], p0, 0, 0, 0);
            p1 = __builtin_amdgcn_mfma_f32_32x32x16_bf16(b1, qr[d0], p1, 0, 0, 0); }
        float pmax = p0[0];
#pragma unroll
        for (int r = 1; r < 16; ++r) pmax = fmaxf(pmax, p0[r]);
#pragma unroll
        for (int r = 0; r < 16; ++r) pmax = fmaxf(pmax, p1[r]);
        { auto sw = __builtin_amdgcn_permlane32_swap(__float_as_uint(pmax), __float_as_uint(pmax), false, false); pmax = fmaxf(__uint_as_float(sw[0]), __uint_as_float(sw[1])); }
        float alpha = 1.f;
        if (!__all(pmax - m_reg <= 11.0f)) { const float mn = fmaxf(m_reg, pmax); alpha = __builtin_amdgcn_exp2f(m_reg - mn); m_reg = mn; }
#pragma unroll
        for (int r = 0; r < 16; ++r) { p0[r] = __builtin_amdgcn_exp2f(p0[r] - m_reg); p1[r] = __builtin_amdgcn_exp2f(p1[r] - m_reg); }
        float ps = 0.f;
#pragma unroll
        for (int r = 0; r < 16; ++r) ps += p0[r];
#pragma unroll
        for (int r = 0; r < 16; ++r) ps += p1[r];
        { auto sw = __builtin_amdgcn_permlane32_swap(__float_as_uint(ps), __float_as_uint(ps), false, false); ps = __uint_as_float(sw[0]) + __uint_as_float(sw[1]); }
        l_reg = l_reg * alpha + ps;
        if (__any(alpha < 1.f)) {
            if (hi == 0) al_l[r32] = alpha;
            asm volatile("s_waitcnt lgkmcnt(0)" ::: "memory");
#pragma unroll
            for (int r = 0; r < 16; ++r) { const float al = al_l[crow(r, hi)];
#pragma unroll
                for (int d = 0; d < 4; ++d) o[d][r] *= al; }
        }
        bf16x8 pa0, pa1, pa2, pa3;
#define PK4(P_, BASE, OUT) do { unsigned a0 = pk2(P_[BASE + 0], P_[BASE + 1]), a1 = pk2(P_[BASE + 2], P_[BASE + 3]); \
    unsigned b0 = pk2(P_[BASE + 4], P_[BASE + 5]), b1 = pk2(P_[BASE + 6], P_[BASE + 7]); \
    auto r0 = __builtin_amdgcn_permlane32_swap(a0, b0, false, false); auto r1 = __builtin_amdgcn_permlane32_swap(a1, b1, false, false); \
    u32x4 w = {r0[0], r1[0], r0[1], r1[1]}; OUT = *reinterpret_cast<bf16x8*>(&w); } while (0)
        PK4(p0, 0, pa0); PK4(p0, 8, pa1); PK4(p1, 0, pa2); PK4(p1, 8, pa3);
#undef PK4
        LAS unsigned char* vb = vb0 + bsel * SHM_V;
        pv_one<0>(o[0], vb, pa0, pa1, pa2, pa3); pv_one<1>(o[1], vb, pa0, pa1, pa2, pa3); pv_one<2>(o[2], vb, pa0, pa1, pa2, pa3); pv_one<3>(o[3], vb, pa0, pa1, pa2, pa3);
        if (j + 1 < NT) { SLOAD((j + 1) * 64); SWRITE(bsel ^ 1); }
        __syncthreads();
    }
    if (hi == 0) li_l[r32] = l_reg;
    asm volatile("s_waitcnt lgkmcnt(0)" ::: "memory");
    bf16_t* Ow = Ob + (size_t)(wid * 32) * DM;
#pragma unroll
    for (int r = 0; r < 16; ++r) { const int orow = crow(r, hi); const float rl = 1.0f / li_l[orow];
#pragma unroll
        for (int d0 = 0; d0 < 4; ++d0) Ow[(size_t)orow * DM + d0 * 32 + r32] = (bf16_t)f2bf(o[d0][r] * rl); }
    __syncthreads();
#undef SLOAD
#undef SWRITE
}
}
__device__ __forceinline__ void phase_mla(Frame& F0) {
    Frame F = mkframe(F0.lds);
    const bf16_t* Q = (const bf16_t*)(WSP() + WS_Q); const bf16_t* KV = (const bf16_t*)(WSP() + WS_KV); const bf16_t* RP = (const bf16_t*)(WSP() + WS_ROPE);
    bf16_t* Y = (bf16_t*)(WSP() + WS_YMLA);
    for (int u = blockIdx.x; u < 512; u += F.G) {
        const int qb = u & 7, h = (u >> 3) & 7, b = u >> 6;
        const size_t t0 = (size_t)b * SEQ;
        mla::unit(Q + (t0 + qb * 256) * QW + h * 192, KV + t0 * KVW + h * 256, RP + t0 * ROPE_W + RS_KR * 64, KV + t0 * KVW + h * 256 + 128,
                  Y + (t0 + qb * 256) * DM + h * 128, F.lds, F.tid);
    }
}

__device__ __forceinline__ void phase_dilated(Frame& F0) {
    Frame F = mkframe(F0.lds);
    const bf16_t* RP = (const bf16_t*)(WSP() + WS_ROPE); const bf16_t* PL = (const bf16_t*)(WSP() + WS_PLAIN);
    bf16_t* DO = (bf16_t*)(WSP() + WS_DILO); float* LSE = (float*)(WSP() + WS_LSE);
    constexpr int LD = 72;
    const int slot = F.wave >> 2, qt = F.wave & 3, tt = F.tid & 255, g4 = F.lane >> 4, l15 = F.lane & 15;
    LAS bf16_t* Kl = (LAS bf16_t*)(F.lds + slot * 55296); LAS bf16_t* Vl = Kl + 192 * LD;
    for (int pair = blockIdx.x; pair < 3072; pair += F.G) {
        const int it = pair * 2 + slot;
        const int b = it / 768, rem = it % 768, g = rem >> 8, hh = (rem >> 5) & 7, blk = rem & 31;
        const int sh = 2 * g, nbk = 32 >> sh, L = SEQ >> sh;
        const int r = blk / nbk, n = blk % nbk;
#pragma unroll
        for (int q = 0; q < 6; ++q) {
            const int ci = tt + 256 * q, c = ci >> 3, col8 = (ci & 7) * 8;
            const int jk = (n - 1) * 64 + c; const bool ok = (jk >= 0) && (jk < L);
            bf16x8 kv = {0, 0, 0, 0, 0, 0, 0, 0}, vv = {0, 0, 0, 0, 0, 0, 0, 0};
            if (ok) { const size_t tok = (size_t)b * SEQ + ((size_t)jk << sh) + r;
                kv = *(const bf16x8*)(RP + tok * ROPE_W + (RS_DK + g * 8 + hh) * 64 + col8);
                vv = *(const bf16x8*)(PL + tok * PLAIN_W + PC_DV + (g * 8 + hh) * 64 + col8); }
            *(LAS bf16x8*)(Kl + c * LD + col8) = kv; *(LAS bf16x8*)(Vl + c * LD + col8) = vv;
        }
        __syncthreads();
        const int iq = qt * 16 + l15;
        const size_t tokq = (size_t)b * SEQ + ((size_t)(n * 64 + iq) << sh) + r;
        bf16x8 qf[2];
#pragma unroll
        for (int ks = 0; ks < 2; ++ks) qf[ks] = *(const bf16x8*)(RP + tokq * ROPE_W + (RS_DQ + g * 8 + hh) * 64 + ks * 32 + 8 * g4);
        f32x4 s[12];
#pragma unroll
        for (int ct = 0; ct < 12; ++ct) { s[ct] = (f32x4){0.f, 0.f, 0.f, 0.f};
#pragma unroll
            for (int ks = 0; ks < 2; ++ks) { const bf16x8 kf = *(const LAS bf16x8*)(Kl + (16 * ct + l15) * LD + ks * 32 + 8 * g4);
                s[ct] = __builtin_amdgcn_mfma_f32_16x16x32_bf16(kf, qf[ks], s[ct], 0, 0, 0); } }
        float mx = -1e30f;
#pragma unroll
        for (int ct = 0; ct < 12; ++ct)
#pragma unroll
            for (int rg = 0; rg < 4; ++rg) { const int c = 16 * ct + 4 * g4 + rg; const int jk = (n - 1) * 64 + c; const int df = c - 64 - iq;
                const bool ok = (jk >= 0) && (jk < L) && (df >= -64) && (df <= 64);
                s[ct][rg] = ok ? s[ct][rg] : -1e30f; mx = fmaxf(mx, s[ct][rg]); }
        mx = fmaxf(mx, __shfl_xor(mx, 16)); mx = fmaxf(mx, __shfl_xor(mx, 32));
        float sum = 0.f;
#pragma unroll
        for (int ct = 0; ct < 12; ++ct)
#pragma unroll
            for (int rg = 0; rg < 4; ++rg) { const float pv = __builtin_amdgcn_exp2f((s[ct][rg] - mx) * 1.4426950408889634f); s[ct][rg] = pv; sum += pv; }
        sum += __shfl_xor(sum, 16); sum += __shfl_xor(sum, 32);
        const float inv = 1.0f / sum;
        f32x4 o[4];
#pragma unroll
        for (int dt = 0; dt < 4; ++dt) o[dt] = (f32x4){0.f, 0.f, 0.f, 0.f};
#pragma unroll
        for (int s2 = 0; s2 < 6; ++s2) {
            u32x4 pw; pw.x = pk2(s[2 * s2][0], s[2 * s2][1]); pw.y = pk2(s[2 * s2][2], s[2 * s2][3]); pw.z = pk2(s[2 * s2 + 1][0], s[2 * s2 + 1][1]); pw.w = pk2(s[2 * s2 + 1][2], s[2 * s2 + 1][3]);
            const bf16x8 pf = *reinterpret_cast<bf16x8*>(&pw);
#pragma unroll
            for (int dt = 0; dt < 4; ++dt) {
                LAS bf16_t* va = Vl + (32 * s2 + 4 * g4 + ((F.lane >> 2) & 3)) * LD + 16 * dt + 4 * (F.lane & 3);
                const s16x4 lo = __builtin_amdgcn_ds_read_tr16_b64_v4i16((LAS s16x4*)va), hi = __builtin_amdgcn_ds_read_tr16_b64_v4i16((LAS s16x4*)(va + 16 * LD));
                const bf16x8 vf = {lo[0], lo[1], lo[2], lo[3], hi[0], hi[1], hi[2], hi[3]};
                o[dt] = __builtin_amdgcn_mfma_f32_16x16x32_bf16(vf, pf, o[dt], 0, 0, 0);
            }
        }
        bf16_t* dst = DO + ((size_t)g * T + tokq) * 512 + hh * 64 + 4 * g4;
#pragma unroll
        for (int dt = 0; dt < 4; ++dt) { u32x2 w; w.x = pk2(o[dt][0] * inv, o[dt][1] * inv); w.y = pk2(o[dt][2] * inv, o[dt][3] * inv); *(u32x2*)(dst + 16 * dt) = w; }
        if (g4 == 0) LSE[((size_t)g * T + tokq) * 8 + hh] = mx + __logf(sum);
        __syncthreads();
    }
}
__device__ __forceinline__ void phase_dil_merge(Frame& F0) {
    Frame F = mkframe(F0.lds);
    const bf16_t* DO = (const bf16_t*)(WSP() + WS_DILO); const float* LSE = (const float*)(WSP() + WS_LSE); bf16_t* Y = (bf16_t*)(WSP() + WS_YDIL);
    for (int t = F.gw; t < T; t += F.ngw) {
        const int hh = F.lane >> 3;
        const float l0 = LSE[(size_t)t * 8 + hh], l1 = LSE[((size_t)T + t) * 8 + hh], l2 = LSE[((size_t)2 * T + t) * 8 + hh];
        const float m = fmaxf(l0, fmaxf(l1, l2)); const float e0 = __expf(l0 - m), e1 = __expf(l1 - m), e2 = __expf(l2 - m); const float is = 1.0f / (e0 + e1 + e2);
        const float w[3] = {e0 * is, e1 * is, e2 * is};
        float acc[8];
#pragma unroll
        for (int j = 0; j < 8; ++j) acc[j] = 0.f;
#pragma unroll
        for (int g = 0; g < 3; ++g) { const u32x4 v = *((const u32x4*)(DO + ((size_t)g * T + t) * 512) + F.lane);
            acc[0] += w[g] * bf2f(v.x & 0xffffu); acc[1] += w[g] * bf2f(v.x >> 16); acc[2] += w[g] * bf2f(v.y & 0xffffu); acc[3] += w[g] * bf2f(v.y >> 16);
            acc[4] += w[g] * bf2f(v.z & 0xffffu); acc[5] += w[g] * bf2f(v.z >> 16); acc[6] += w[g] * bf2f(v.w & 0xffffu); acc[7] += w[g] * bf2f(v.w >> 16); }
        u32x4 o; o.x = pk2(acc[0], acc[1]); o.y = pk2(acc[2], acc[3]); o.z = pk2(acc[4], acc[5]); o.w = pk2(acc[6], acc[7]);
        *((u32x4*)(Y + (size_t)t * 512) + F.lane) = o;
    }
}

__device__ __forceinline__ void phase_retention(Frame& F0, int layer) {
    Frame F = mkframe(F0.lds);
    const bf16_t* RP = (const bf16_t*)(WSP() + WS_ROPE); const bf16_t* PL = (const bf16_t*)(WSP() + WS_PLAIN);
    constexpr int LQ = 72, LV = 136;
    LAS bf16_t* Ql = (LAS bf16_t*)F.lds; LAS bf16_t* Kl = Ql + 128 * LQ; LAS bf16_t* K2l = Kl + 128 * LQ; LAS bf16_t* Stl = K2l + 128 * LQ; LAS bf16_t* Vl = Stl + 128 * LQ;
    const int w = F.wave, g4 = F.lane >> 4, l15 = F.lane & 15;
    for (int u = blockIdx.x; u < 128; u += F.G) {
        const int b = u >> 4, hh = (u >> 1) & 7, dir = u & 1;
        const float lg = GP(const float, ret_ld)[(layer * 2 + dir) * 8 + hh];
        bf16_t* YR = (bf16_t*)(WSP() + (dir ? WS_YRB : WS_YRF));
        f32x4 st[4];
#pragma unroll
        for (int k = 0; k < 4; ++k) st[k] = (f32x4){0.f, 0.f, 0.f, 0.f};
        for (int i = F.tid; i < 128 * LQ / 2; i += 512) ((LAS unsigned*)Stl)[i] = 0u;
        const float cdec = __expf(lg * 128.0f);
        for (int c = 0; c < 16; ++c) {
#pragma unroll
            for (int q = 0; q < 2; ++q) { const int ci = F.tid + 512 * q, i = ci >> 3, col8 = (ci & 7) * 8;
                const size_t tok = (size_t)b * SEQ + (dir ? (SEQ - 1 - (128 * c + i)) : (128 * c + i));
                const bf16x8 qv = *(const bf16x8*)(RP + tok * ROPE_W + (RS_RQ + hh) * 64 + col8), kv = *(const bf16x8*)(RP + tok * ROPE_W + (RS_RK + hh) * 64 + col8);
                *(LAS bf16x8*)(Ql + i * LQ + col8) = qv; *(LAS bf16x8*)(Kl + i * LQ + col8) = kv;
                const float kd = __expf(lg * (float)(127 - i));
                u32x4 kw = *reinterpret_cast<const u32x4*>(&kv), k2;
                k2.x = pk2(bf2f(kw.x & 0xffffu) * kd, bf2f(kw.x >> 16) * kd); k2.y = pk2(bf2f(kw.y & 0xffffu) * kd, bf2f(kw.y >> 16) * kd);
                k2.z = pk2(bf2f(kw.z & 0xffffu) * kd, bf2f(kw.z >> 16) * kd); k2.w = pk2(bf2f(kw.w & 0xffffu) * kd, bf2f(kw.w >> 16) * kd);
                *(LAS u32x4*)(K2l + i * LQ + col8) = k2; }
#pragma unroll
            for (int q = 0; q < 4; ++q) { const int ci = F.tid + 512 * q, i = ci >> 4, col8 = (ci & 15) * 8;
                const size_t tok = (size_t)b * SEQ + (dir ? (SEQ - 1 - (128 * c + i)) : (128 * c + i));
                *(LAS bf16x8*)(Vl + i * LV + col8) = *(const bf16x8*)(PL + tok * PLAIN_W + PC_RV + hh * 128 + col8); }
            __syncthreads();
            const int iq = 16 * w + l15;
            bf16x8 qf[2];
#pragma unroll
            for (int ks = 0; ks < 2; ++ks) qf[ks] = *(const LAS bf16x8*)(Ql + iq * LQ + ks * 32 + 8 * g4);
            f32x4 y[8];
            const float qd = __expf(lg * (float)(iq + 1));
#pragma unroll
            for (int dvt = 0; dvt < 8; ++dvt) { y[dvt] = (f32x4){0.f, 0.f, 0.f, 0.f};
#pragma unroll
                for (int ks = 0; ks < 2; ++ks) { const bf16x8 sf = *(const LAS bf16x8*)(Stl + (16 * dvt + l15) * LQ + ks * 32 + 8 * g4);
                    y[dvt] = __builtin_amdgcn_mfma_f32_16x16x32_bf16(sf, qf[ks], y[dvt], 0, 0, 0); }
                y[dvt] = y[dvt] * qd; }
            f32x4 s[8];
#pragma unroll
            for (int jt = 0; jt < 8; ++jt) { s[jt] = (f32x4){0.f, 0.f, 0.f, 0.f};
#pragma unroll
                for (int ks = 0; ks < 2; ++ks) { const bf16x8 kf = *(const LAS bf16x8*)(Kl + (16 * jt + l15) * LQ + ks * 32 + 8 * g4);
                    s[jt] = __builtin_amdgcn_mfma_f32_16x16x32_bf16(kf, qf[ks], s[jt], 0, 0, 0); }
#pragma unroll
                for (int rg = 0; rg < 4; ++rg) { const int j = 16 * jt + 4 * g4 + rg; const int df = iq - j; const bool ok = dir ? (df > 0) : (df >= 0);
                    s[jt][rg] = ok ? s[jt][rg] * __expf(lg * (float)df) : 0.f; } }
#pragma unroll
            for (int s2 = 0; s2 < 4; ++s2) {
                u32x4 pw; pw.x = pk2(s[2 * s2][0], s[2 * s2][1]); pw.y = pk2(s[2 * s2][2], s[2 * s2][3]); pw.z = pk2(s[2 * s2 + 1][0], s[2 * s2 + 1][1]); pw.w = pk2(s[2 * s2 + 1][2], s[2 * s2 + 1][3]);
                const bf16x8 pf = *reinterpret_cast<bf16x8*>(&pw);
#pragma unroll
                for (int dvt = 0; dvt < 8; ++dvt) {
                    LAS bf16_t* va = Vl + (32 * s2 + 4 * g4 + ((F.lane >> 2) & 3)) * LV + 16 * dvt + 4 * (F.lane & 3);
                    const s16x4 lo = __builtin_amdgcn_ds_read_tr16_b64_v4i16((LAS s16x4*)va), hi = __builtin_amdgcn_ds_read_tr16_b64_v4i16((LAS s16x4*)(va + 16 * LV));
                    const bf16x8 vf = {lo[0], lo[1], lo[2], lo[3], hi[0], hi[1], hi[2], hi[3]};
                    y[dvt] = __builtin_amdgcn_mfma_f32_16x16x32_bf16(vf, pf, y[dvt], 0, 0, 0);
                }
            }
            { const size_t tok = (size_t)b * SEQ + (dir ? (SEQ - 1 - (128 * c + iq)) : (128 * c + iq));
              bf16_t* dst = YR + tok * DM + hh * 128 + 4 * g4;
#pragma unroll
              for (int dvt = 0; dvt < 8; ++dvt) { u32x2 wv; wv.x = pk2(y[dvt][0], y[dvt][1]); wv.y = pk2(y[dvt][2], y[dvt][3]); *(u32x2*)(dst + 16 * dvt) = wv; } }
            f32x4 nu[4];
#pragma unroll
            for (int dkt = 0; dkt < 4; ++dkt) nu[dkt] = (f32x4){0.f, 0.f, 0.f, 0.f};
#pragma unroll
            for (int s2 = 0; s2 < 4; ++s2) {
                LAS bf16_t* va = Vl + (32 * s2 + 8 * g4 + ((F.lane >> 2) & 3)) * LV + 16 * w + 4 * (F.lane & 3);
                const s16x4 vlo = __builtin_amdgcn_ds_read_tr16_b64_v4i16((LAS s16x4*)va), vhi = __builtin_amdgcn_ds_read_tr16_b64_v4i16((LAS s16x4*)(va + 4 * LV));
                const bf16x8 vf = {vlo[0], vlo[1], vlo[2], vlo[3], vhi[0], vhi[1], vhi[2], vhi[3]};
#pragma unroll
                for (int dkt = 0; dkt < 4; ++dkt) {
                    LAS bf16_t* ka = K2l + (32 * s2 + 8 * g4 + ((F.lane >> 2) & 3)) * LQ + 16 * dkt + 4 * (F.lane & 3);
                    const s16x4 klo = __builtin_amdgcn_ds_read_tr16_b64_v4i16((LAS s16x4*)ka), khi = __builtin_amdgcn_ds_read_tr16_b64_v4i16((LAS s16x4*)(ka + 4 * LQ));
                    const bf16x8 kf = {klo[0], klo[1], klo[2], klo[3], khi[0], khi[1], khi[2], khi[3]};
                    nu[dkt] = __builtin_amdgcn_mfma_f32_16x16x32_bf16(vf, kf, nu[dkt], 0, 0, 0);
                }
            }
#pragma unroll
            for (int dkt = 0; dkt < 4; ++dkt) st[dkt] = st[dkt] * cdec + nu[dkt];
            __syncthreads();
#pragma unroll
            for (int dkt = 0; dkt < 4; ++dkt)
#pragma unroll
                for (int rg = 0; rg < 4; ++rg) Stl[(16 * w + 4 * g4 + rg) * LQ + 16 * dkt + l15] = (bf16_t)f2bf(st[dkt][rg]);
        }
        __syncthreads();
    }
}
__device__ __forceinline__ void phase_ret_final(Frame& F0, int layer) {
    Frame F = mkframe(F0.lds);
    const bf16_t* YF = (const bf16_t*)(WSP() + WS_YRF); const bf16_t* YBk = (const bf16_t*)(WSP() + WS_YRB); const bf16_t* PL = (const bf16_t*)(WSP() + WS_PLAIN);
    bf16_t* Y = (bf16_t*)(WSP() + WS_YRET); const float* rn = GP(const float, ret_norm) + layer * DM;
    for (int t = F.gw; t < T; t += F.ngw) {
        float v[16];
#pragma unroll
        for (int h2 = 0; h2 < 2; ++h2) { const u32x4 a = *((const u32x4*)(YF + (size_t)t * DM) + F.lane * 2 + h2), c = *((const u32x4*)(YBk + (size_t)t * DM) + F.lane * 2 + h2);
            const unsigned aw[4] = {a.x, a.y, a.z, a.w}, cw[4] = {c.x, c.y, c.z, c.w};
#pragma unroll
            for (int j = 0; j < 4; ++j) { v[h2 * 8 + 2 * j] = bf2f(aw[j] & 0xffffu) + bf2f(cw[j] & 0xffffu); v[h2 * 8 + 2 * j + 1] = bf2f(aw[j] >> 16) + bf2f(cw[j] >> 16); } }
        float s = 0.f;
#pragma unroll
        for (int j = 0; j < 16; ++j) s += v[j];
        s += __shfl_xor(s, 1); s += __shfl_xor(s, 2); s += __shfl_xor(s, 4);
        const float mu = s * (1.0f / 128.0f); float q = 0.f;
#pragma unroll
        for (int j = 0; j < 16; ++j) { v[j] -= mu; q += v[j] * v[j]; }
        q += __shfl_xor(q, 1); q += __shfl_xor(q, 2); q += __shfl_xor(q, 4);
        const float rstd = 1.0f / sqrtf(q * (1.0f / 128.0f) + EPS);
        u32x4 o[2];
#pragma unroll
        for (int h2 = 0; h2 < 2; ++h2) { const u32x4 gw = *((const u32x4*)(PL + (size_t)t * PLAIN_W + PC_RG) + F.lane * 2 + h2);
            const unsigned gq[4] = {gw.x, gw.y, gw.z, gw.w}; unsigned ow[4];
#pragma unroll
            for (int j = 0; j < 4; ++j) { const int c = F.lane * 16 + h2 * 8 + 2 * j;
                ow[j] = pk2(v[h2 * 8 + 2 * j] * rstd * rn[c] * bf2f(gq[j] & 0xffffu), v[h2 * 8 + 2 * j + 1] * rstd * rn[c + 1] * bf2f(gq[j] >> 16)); }
            o[h2] = (u32x4){ow[0], ow[1], ow[2], ow[3]}; }
        *((u32x4*)(Y + (size_t)t * DM) + F.lane * 2) = o[0]; *((u32x4*)(Y + (size_t)t * DM) + F.lane * 2 + 1) = o[1];
    }
}

__global__ void __launch_bounds__(512, 2) fwd_kernel(Params P) {
    extern __shared__ __attribute__((aligned(16))) unsigned char lds_raw[];
    Frame F = mkframe((LAS unsigned char*)lds_raw);
    {
        volatile LAS unsigned* misc = (volatile LAS unsigned*)(F.lds + LDS_MISC);
        if (F.tid < 64) misc[F.tid] = 0u;
        if (F.tid < (int)(sizeof(Params) / 4)) ((volatile LAS unsigned*)(F.lds + LDS_PTRS))[F.tid] = ((const unsigned*)&P)[F.tid];
        __syncthreads();
        (void)xcd_barrier_post((unsigned*)(WSP() + WS_CTL) + 4096, misc + 8);
    }
#define GRID_BAR() do { XcdBarrier b_; b_.bar = (unsigned*)(WSP() + WS_CTL) + 4096; b_.x = (unsigned)__builtin_amdgcn_readfirstlane(opaque((int)xb_xcc_id())); \
        b_.st = (volatile LAS unsigned*)(F.lds + LDS_MISC) + 8; xcd_barrier(b_); if (DUPN == 100) xcd_barrier(b_); } while (0)
#define WSB(off) (WSP() + (off))
#define MODL (((const float*)WSB(WS_MOD)) + (size_t)layer * 8 * 6144)
#define XOUT GP(float, out)
    const int bx = blockIdx.x;

    PH(0) p0_convert(F, false, 0);
    PH(1) p0_tables(F);
    GRID_BAR();
    PH(1) p0_modreduce(F);
    GRID_BAR();

    for (int layer = 0; layer < DEPTH; ++layer) {
        PH(2) {
            const float* xin = layer == 0 ? GP(const float, x) : (const float*)XOUT;
            if (layer > 0 && ((layer - 1) & 1)) {
                const float* modp = ((const float*)WSB(WS_MOD)) + (size_t)(layer - 1) * 8 * 6144;
                phase_norm<true, false, false>(F, xin, XOUT, GP(const float, norm_mix) + layer * DM, MODL + 1024, MODL, modp + 5 * 1024, nullptr);
            } else {
                phase_norm<false, false, false>(F, xin, XOUT, GP(const float, norm_mix) + layer * DM, MODL + 1024, MODL, nullptr, nullptr);
            }
        }
        PH(0) if (layer == 2) p0_convert(F, true, 1);
        GRID_BAR();
        PH(3) {
            pg8::Gemm g{(const bf16_t*)WSB(WS_H), (const bf16_t*)WSB(WS_WIN) + (size_t)layer * NIN * DM, DM, DM, DM};
            pg8::StaticOrder S; S.init(T / 256, NIN / 256, F.G, bx);
            EpiIn E{(bf16_t*)WSB(WS_PLAIN), (bf16_t*)WSB(WS_ROPE), (float*)WSB(WS_SSQ), (const float*)WSB(WS_COS), (const float*)WSB(WS_SIN)};
            pg8::gemm_phase(F.lds, g, S, E);
        }
        GRID_BAR();
        PH(4) {
            pg8::Gemm g{(const bf16_t*)WSB(WS_PLAIN) + PC_CQ, (const bf16_t*)WSB(WS_WUQ) + (size_t)layer * QW * 768, PLAIN_W, 768, 768};
            pg8::StaticOrder S; S.init(T / 256, QW / 256, F.G, bx);
            EpiQ E{(bf16_t*)WSB(WS_Q), (const float*)WSB(WS_SSQ), (const float*)WSB(WS_COS), (const float*)WSB(WS_SIN), 0.07216878364870322f * 1.4426950408889634f};
            pg8::gemm_phase(F.lds, g, S, E);
        }
        PH(5) {
            pg8::Gemm g{(const bf16_t*)WSB(WS_PLAIN) + PC_CKV, (const bf16_t*)WSB(WS_WUKV) + (size_t)layer * KVW * 512, PLAIN_W, 512, 512};
            pg8::StaticOrder S; S.init(T / 256, KVW / 256, F.G, bx);
            EpiKV E{(bf16_t*)WSB(WS_KV), (const float*)WSB(WS_SSQ)};
            pg8::gemm_phase(F.lds, g, S, E);
        }
        PH(6) phase_retention(F, layer);
        PH(7) phase_dilated(F);
        GRID_BAR();
        PH(8) phase_mla(F);
        PH(9) phase_dil_merge(F);
        PH(9) phase_ret_final(F, layer);
        GRID_BAR();
        PH(10) {
            pg8::StaticOrder S; S.init(T / 256, DM / 256, F.G, bx);
            { pg8::Gemm g{(const bf16_t*)WSB(WS_YMLA), (const bf16_t*)WSB(WS_WBM) + (size_t)layer * DM * DM, DM, DM, DM};
              EpiBr E{(float*)WSB(WS_MF), (bf16_t*)WSB(WS_MB), (const bf16_t*)WSB(WS_PLAIN) + PC_GA, 0}; pg8::gemm_phase(F.lds, g, S, E); }
            { pg8::Gemm g{(const bf16_t*)WSB(WS_YDIL), (const bf16_t*)WSB(WS_WBD) + (size_t)layer * DM * 512, 512, 512, 512};
              EpiBr E{(float*)WSB(WS_MF), (bf16_t*)WSB(WS_MB), (const bf16_t*)WSB(WS_PLAIN) + PC_GB, 1}; pg8::gemm_phase(F.lds, g, S, E); }
            { pg8::Gemm g{(const bf16_t*)WSB(WS_YRET), (const bf16_t*)WSB(WS_WBR) + (size_t)layer * DM * DM, DM, DM, DM};
              EpiBr E{(float*)WSB(WS_MF), (bf16_t*)WSB(WS_MB), (const bf16_t*)WSB(WS_PLAIN) + PC_GC, 2}; pg8::gemm_phase(F.lds, g, S, E); }
        }
        GRID_BAR();
        PH(11) {
            pg8::Gemm g{(const bf16_t*)WSB(WS_MB), (const bf16_t*)WSB(WS_WO) + (size_t)layer * DM * DM, DM, DM, DM};
            pg8::StaticOrder S; S.init(T / 256, DM / 256, F.G, bx);
            EpiRes E{layer == 0 ? GP(const float, x) : (const float*)XOUT, XOUT, MODL + 2 * 1024};
            pg8::gemm_phase(F.lds, g, S, E);
        }
        GRID_BAR();
        PH(12) {
            if (layer & 1) phase_norm<false, true, false>(F, XOUT, XOUT, GP(const float, norm_ffn) + layer * DM, MODL + 4 * 1024, MODL + 3 * 1024, nullptr, GP(const float, moe_router) + (size_t)(layer >> 1) * DM * 8);
            else phase_norm<false, false, false>(F, XOUT, XOUT, GP(const float, norm_ffn) + layer * DM, MODL + 4 * 1024, MODL + 3 * 1024, nullptr, nullptr);
        }
        GRID_BAR();
        if (!(layer & 1)) {
            const int fi = layer >> 1;
            PH(13) { pg8::Gemm g{(const bf16_t*)WSB(WS_H), (const bf16_t*)WSB(WS_W13) + (size_t)fi * 5632 * DM, DM, DM, DM};
              pg8::StaticOrder S; S.init(T / 256, 5632 / 256, F.G, bx);
              EpiSwi E{(bf16_t*)WSB(WS_HID), DFF}; pg8::gemm_phase(F.lds, g, S, E); }
            GRID_BAR();
            PH(14) { pg8::Gemm g{(const bf16_t*)WSB(WS_HID), (const bf16_t*)WSB(WS_W2) + (size_t)fi * DM * DFF, DFF, DFF, DFF};
              pg8::StaticOrder S; S.init(T / 256, DM / 256, F.G, bx);
              EpiRes E{XOUT, XOUT, MODL + 5 * 1024}; pg8::gemm_phase(F.lds, g, S, E); }
            GRID_BAR();
        } else {
            PH(15) phase_moe_gather(F);
            GRID_BAR();
            PH(16) { const int* moei = (const int*)WSB(WS_MOEI); const int nblk = __builtin_amdgcn_readfirstlane(__hip_atomic_load(moei + MI_BLK, __ATOMIC_RELAXED, __HIP_MEMORY_SCOPE_AGENT));
              pg8::Gemm g{(const bf16_t*)WSB(WS_XG), (const bf16_t*)WSB(WS_W13E), DM, DM, DM};
              pg8::StaticOrder S; S.init(nblk, 7168 / 256, F.G, bx); S.blk_exp = moei + MI_BLK + 1; S.estride = (size_t)7168 * DM;
              EpiSwi E{(bf16_t*)WSB(WS_HID), DFE}; pg8::gemm_phase(F.lds, g, S, E); }
            GRID_BAR();
            PH(17) { const int* moei = (const int*)WSB(WS_MOEI); const int nblk = __builtin_amdgcn_readfirstlane(__hip_atomic_load(moei + MI_BLK, __ATOMIC_RELAXED, __HIP_MEMORY_SCOPE_AGENT));
              pg8::Gemm g{(const bf16_t*)WSB(WS_HID), (const bf16_t*)WSB(WS_W2E), DFE, DFE, DFE};
              pg8::StaticOrder S; S.init(nblk, DM / 256, F.G, bx); S.blk_exp = moei + MI_BLK + 1; S.estride = (size_t)DM * DFE;
              EpiPlain E{(bf16_t*)WSB(WS_YB), DM}; pg8::gemm_phase(F.lds, g, S, E); }
            GRID_BAR();
        }
    }
    PH(18) {
        const float* modp = ((const float*)WSB(WS_MOD)) + (size_t)3 * 8 * 6144;
        phase_norm<true, false, true>(F, XOUT, XOUT, GP(const float, final_norm), nullptr, nullptr, modp + 5 * 1024, nullptr);
    }
}

extern "C" void kernel_launch(void* const* d_in, const int* in_sizes, int n_in, void* d_out, int out_size, void* d_ws, size_t ws_size, hipStream_t stream) {
    static int grid = 0;
    if (grid == 0) {
        if (n_in != 26 || in_sizes[0] != T * DM || out_size != T * DM || ws_size < WS_END) {
            fprintf(stderr, "kernel_launch: unexpected shapes / workspace: n_in %d in0 %d out %d ws %zu (need %zu)\n", n_in, n_in > 0 ? in_sizes[0] : -1, out_size, ws_size, (size_t)WS_END);
            grid = -1; return; }
        int dev = 0, cus = 0, per_cu = 0;
        if (hipGetDevice(&dev) != hipSuccess || hipDeviceGetAttribute(&cus, hipDeviceAttributeMultiprocessorCount, dev) != hipSuccess) { grid = -1; return; }
        if (hipFuncSetAttribute((const void*)fwd_kernel, hipFuncAttributeMaxDynamicSharedMemorySize, LDS_BYTES) != hipSuccess) { fprintf(stderr, "kernel_launch: hipFuncSetAttribute failed\n"); grid = -1; return; }
        if (hipOccupancyMaxActiveBlocksPerMultiprocessor(&per_cu, (const void*)fwd_kernel, 512, LDS_BYTES) != hipSuccess || per_cu < 1) {
            fprintf(stderr, "kernel_launch: occupancy query reports %d blocks per CU\n", per_cu); (void)hipGetLastError(); grid = -1; return; }
        grid = cus;
    }
    if (grid < 0) return;
    (void)hipMemsetAsync((char*)d_ws + WS_CTL, 0, CTL_BYTES, stream);
    Params p{};
    const float* const* fin = (const float* const*)d_in;
    p.x = fin[0]; p.c = fin[1]; p.positions = (const int*)d_in[2]; p.ada_w = fin[3]; p.ada_b = fin[4]; p.norm_mix = fin[5]; p.norm_ffn = fin[6]; p.w_in = fin[7];
    p.q_norm = fin[8]; p.w_uq = fin[9]; p.kv_norm = fin[10]; p.w_ukv = fin[11]; p.ret_ld = fin[12]; p.ret_norm = fin[13];
    p.w_br_mla = fin[14]; p.w_br_dil = fin[15]; p.w_br_ret = fin[16]; p.w_out = fin[17]; p.ffn_w1 = fin[18]; p.ffn_w3 = fin[19]; p.ffn_w2 = fin[20];
    p.moe_router = fin[21]; p.moe_w1 = fin[22]; p.moe_w3 = fin[23]; p.moe_w2 = fin[24]; p.final_norm = fin[25];
    p.out = (float*)d_out; p.ws = (unsigned char*)d_ws;
    for (int i = 0; i < 32; ++i) p.inv_freq[i] = std::pow(10000.0, -(double)i / 32.0);
    hipLaunchKernelGGL(fwd_kernel, dim3(grid), dim3(512), LDS_BYTES, stream, p);
    const hipError_t le = hipPeekAtLastError();
    if (le != hipSuccess) fprintf(stderr, "kernel_launch: launch failed: %s\n", hipGetErrorName(le));
}
```

```cpp
#include <hip/hip_runtime.h>
#include <cstdio>
#include <cstdint>
#include <cmath>

#define LAS __attribute__((address_space(3)))
typedef unsigned short bf16_t;
typedef short bf16x8 __attribute__((ext_vector_type(8)));
typedef short s16x4 __attribute__((ext_vector_type(4)));
typedef float f32x4 __attribute__((ext_vector_type(4)));
typedef float f32x16 __attribute__((ext_vector_type(16)));
typedef unsigned u32x4 __attribute__((ext_vector_type(4)));
typedef unsigned u32x2 __attribute__((ext_vector_type(2)));
typedef int i32x4 __attribute__((ext_vector_type(4)));
typedef int i32x8 __attribute__((ext_vector_type(8)));

constexpr int T = 16384, DM = 1024, SEQ = 2048, NB_ = 8, DEPTH = 4;
constexpr int IN_COLS = 12096, NIN = 12288;
constexpr int PLAIN_W = 7936, ROPE_W = 4352;
constexpr int QW = 1536, KVW = 2048;
constexpr int DFF = 2816, DFE = 3584, NEXP = 8;
constexpr int MOE_ROWS = (T * 2 / 256 + NEXP) * 256;
constexpr int MOE_NB = MOE_ROWS / 256;
constexpr float EPS = 1e-6f;
constexpr int PC_CQ = 0, PC_CKV = 768, PC_DV = 1280, PC_RV = 2816, PC_RG = 3840, PC_GA = 4864, PC_GB = 5888, PC_GC = 6912;
constexpr int RS_KR = 0, RS_DQ = 1, RS_DK = 25, RS_RQ = 49, RS_RK = 57;

constexpr size_t MiB = 1ull << 20;
constexpr size_t WS_CTL = 0;                       constexpr size_t CTL_BYTES = 1 * MiB;
constexpr size_t WS_MODP = 1 * MiB;
constexpr size_t WS_MOD = 14 * MiB;
constexpr size_t WS_COS = 15 * MiB, WS_SIN = 17 * MiB;
constexpr size_t WS_SSQ = 19 * MiB;
constexpr size_t WS_MOEI = 21 * MiB;
constexpr size_t WS_LSE = 22 * MiB;
constexpr size_t WS_WIN = 24 * MiB;
constexpr size_t WS_WUQ = WS_WIN + 96 * MiB;
constexpr size_t WS_WUKV = WS_WUQ + 9 * MiB;
constexpr size_t WS_WBM = WS_WUKV + 8 * MiB;
constexpr size_t WS_WBD = WS_WBM + 8 * MiB;
constexpr size_t WS_WBR = WS_WBD + 4 * MiB;
constexpr size_t WS_WO = WS_WBR + 8 * MiB;
constexpr size_t WS_W13 = WS_WO + 8 * MiB;
constexpr size_t WS_W2 = WS_W13 + 22 * MiB;
constexpr size_t WS_W13E = WS_W2 + 11 * MiB;
constexpr size_t WS_W2E = WS_W13E + 112 * MiB;
constexpr size_t WS_H = WS_W2E + 56 * MiB;
constexpr size_t WS_PLAIN = WS_H + 32 * MiB;
constexpr size_t WS_ROPE = WS_PLAIN + 248 * MiB;
constexpr size_t WS_Q = WS_ROPE + 136 * MiB;
constexpr size_t WS_KV = WS_Q + 48 * MiB;
constexpr size_t WS_YMLA = WS_KV + 64 * MiB;
constexpr size_t WS_YDIL = WS_YMLA + 32 * MiB;
constexpr size_t WS_YRET = WS_YDIL + 16 * MiB;
constexpr size_t WS_DILO = WS_YRET + 32 * MiB;
constexpr size_t WS_YRF = WS_DILO + 48 * MiB;
constexpr size_t WS_YRB = WS_YRF + 32 * MiB;
constexpr size_t WS_MB = WS_YRB + 32 * MiB;
constexpr size_t WS_X = WS_MB + 32 * MiB;
constexpr size_t WS_END = WS_X + 32 * MiB;
constexpr size_t WS_MF = WS_KV;
constexpr size_t WS_HID = WS_PLAIN;
constexpr size_t WS_XG = WS_ROPE;
constexpr size_t WS_YB = WS_ROPE + 68 * MiB;
static_assert((size_t)MOE_ROWS * DFE * 2 <= 248 * MiB, "hid");
static_assert((size_t)MOE_ROWS * DM * 2 <= 68 * MiB, "xg");
constexpr int MI_TOKE = 0;
constexpr int MI_TOKW = 2 * T;
constexpr int MI_TOKP = 4 * T;
constexpr int MI_CNT = 6 * T;
constexpr int MI_BLK = 6 * T + 2048 * 8;
static_assert((MI_BLK + 256) * 4 <= (int)MiB, "moei");

constexpr int LDS_RING = 131072;
constexpr int LDS_MISC = LDS_RING;
constexpr int LDS_BYTES = 147456;

__device__ __forceinline__ float bf2f(unsigned b) { return __uint_as_float(b << 16); }
__device__ __forceinline__ unsigned f2bf(float f) { unsigned u = __float_as_uint(f); return (u + 0x7fffu + ((u >> 16) & 1u)) >> 16; }
typedef __bf16 bf16x2_t __attribute__((ext_vector_type(2)));
typedef float f32x2_t __attribute__((ext_vector_type(2)));
__device__ __forceinline__ unsigned pk2(float lo, float hi) { const f32x2_t f = {lo, hi}; const bf16x2_t b = __builtin_convertvector(f, bf16x2_t); return __builtin_bit_cast(unsigned, b); }
__device__ __forceinline__ float fsigmoid(float x) { return __builtin_amdgcn_rcpf(1.0f + __builtin_amdgcn_exp2f(-1.4426950408889634f * x)); }
__device__ __forceinline__ float fsilu(float x) { return x * fsigmoid(x); }
__device__ __forceinline__ int opaque(int x) { asm volatile("" : "+v"(x)); return x; }
__device__ __forceinline__ int opaque_s(int x) { asm volatile("" : "+s"(x)); return x; }
__device__ __forceinline__ int lane_now() { int l; asm volatile("v_mbcnt_lo_u32_b32 %0, -1, 0\n\tv_mbcnt_hi_u32_b32 %0, -1, %0" : "=v"(l)); return l; }
template <int CTRL> __device__ __forceinline__ float dppf(float v) { return __uint_as_float((unsigned)__builtin_amdgcn_update_dpp(0, (int)__float_as_uint(v), CTRL, 0xf, 0xf, false)); }
__device__ __forceinline__ float sum_x16(float v) { const auto r = __builtin_amdgcn_permlane16_swap(__float_as_uint(v), __float_as_uint(v), false, false); return __uint_as_float(r[0]) + __uint_as_float(r[1]); }
__device__ __forceinline__ float sum_x32(float v) { const auto r = __builtin_amdgcn_permlane32_swap(__float_as_uint(v), __float_as_uint(v), false, false); return __uint_as_float(r[0]) + __uint_as_float(r[1]); }
__device__ __forceinline__ float max_x16(float v) { const auto r = __builtin_amdgcn_permlane16_swap(__float_as_uint(v), __float_as_uint(v), false, false); return fmaxf(__uint_as_float(r[0]), __uint_as_float(r[1])); }
__device__ __forceinline__ float max_x32(float v) { const auto r = __builtin_amdgcn_permlane32_swap(__float_as_uint(v), __float_as_uint(v), false, false); return fmaxf(__uint_as_float(r[0]), __uint_as_float(r[1])); }
__device__ __forceinline__ float sum8(float v) { v += dppf<0xB1>(v); v += dppf<0x4E>(v); v += dppf<0x141>(v); return v; }
__device__ __forceinline__ float wave_sum(float v) { v = sum8(v); v += dppf<0x140>(v); v = sum_x16(v); return sum_x32(v); }

#define XB_TMO      128
#define XB_XCNT(j)  (256  + 64 * (j))
#define XB_XSUB(j)  (1280 + 64 * (j))
#define XB_XGEN(j)  (2304 + 64 * (j))
#define XB_TOP      3328
#define XB_TOPGEN   3392
#define XCD_BAR_WORDS 3456
#define XB_SPIN_CAP (1u << 24)
__device__ __forceinline__ unsigned xb_ld(unsigned* p)              { return __hip_atomic_load(p, __ATOMIC_RELAXED, __HIP_MEMORY_SCOPE_AGENT); }
__device__ __forceinline__ unsigned xb_add(unsigned* p, unsigned v) { return __hip_atomic_fetch_add(p, v, __ATOMIC_RELAXED, __HIP_MEMORY_SCOPE_AGENT); }
__device__ __forceinline__ unsigned xb_xcc_id() { return (unsigned)__builtin_amdgcn_s_getreg((3 << 11) | 20) & 0xFu; }
#define XB_SPIN(cond, bar) do { unsigned _sp = 0; while (cond) { __builtin_amdgcn_s_sleep(1); \
    if ((++_sp & 255u) == 0u) { if (xb_ld(&(bar)[XB_TMO])) break; if (_sp > XB_SPIN_CAP) { atomicAdd(&(bar)[XB_TMO], 1u); break; } } } } while (0)
struct XcdBarrier { unsigned* bar; unsigned x; volatile LAS unsigned* st; int w; };
__device__ __forceinline__ XcdBarrier xcd_barrier_post(unsigned* bar, volatile LAS unsigned* st, int w) {
    XcdBarrier b; b.bar = bar; b.x = xb_xcc_id(); b.st = st; b.w = w;
    if (w == 0 && lane_now() == 0) (void)xb_add(&bar[XB_XCNT(b.x)], 1u);
    return b;
}
__device__ __forceinline__ void xcd_barrier_complete(unsigned* bar, unsigned x, unsigned& nloc, unsigned& nx) {
    const unsigned G = gridDim.x * gridDim.y * gridDim.z;
    unsigned sum, cnt, mine, sp = 0u;
    for (;;) {
        sum = 0u; cnt = 0u; mine = 0u;
#pragma unroll
        for (unsigned j = 0; j < 16; ++j) { const unsigned c = xb_ld(&bar[XB_XCNT(j)]); sum += c; cnt += (c > 0u) ? 1u : 0u; mine = (j == x) ? c : mine; }
        if (sum == G) break;
        __builtin_amdgcn_s_sleep(1);
        if ((++sp & 255u) == 0u) { if (xb_ld(&bar[XB_TMO])) break; if (sp > XB_SPIN_CAP) { atomicAdd(&bar[XB_TMO], 1u); break; } }
    }
    nloc = mine > 0u ? mine : 1u; nx = cnt > 0u ? cnt : 1u;
}
__device__ __forceinline__ void xcd_barrier(const XcdBarrier& b) {
    asm volatile("s_waitcnt vmcnt(0)" ::: "memory");
    __syncthreads();
    if (b.w == 0 && lane_now() == 0) {
        unsigned* bar = b.bar;
        __builtin_amdgcn_s_waitcnt(0);
        unsigned nloc = b.st[0], nx = b.st[1];
        if (nloc == 0u) { xcd_barrier_complete(bar, b.x, nloc, nx); b.st[0] = nloc; b.st[1] = nx; }
        const unsigned old = xb_add(&bar[XB_XSUB(b.x)], 1u);
        const unsigned gen = old / nloc;
        if (old + 1u == (gen + 1u) * nloc) {
            __builtin_amdgcn_fence(__ATOMIC_RELEASE, "agent");
            asm volatile("s_waitcnt vmcnt(0)" ::: "memory");
            const unsigned og = xb_add(&bar[XB_TOP], 1u);
            const unsigned tg = og / nx;
            if (og + 1u == (tg + 1u) * nx) xb_add(&bar[XB_TOPGEN], 1u);
            else XB_SPIN(xb_ld(&bar[XB_TOPGEN]) == tg, bar);
            __builtin_amdgcn_fence(__ATOMIC_ACQUIRE, "agent");
            xb_add(&bar[XB_XGEN(b.x)], 1u);
            asm volatile("s_waitcnt vmcnt(0)" ::: "memory");
        } else {
            XB_SPIN(xb_ld(&bar[XB_XGEN(b.x)]) == gen, bar);
            __builtin_amdgcn_fence(__ATOMIC_ACQUIRE, "agent");
            asm volatile("s_waitcnt vmcnt(0)" ::: "memory");
        }
    }
    __syncthreads();
}

#ifndef ONLY
#define ONLY -1
#endif
#define RUN(n) (ONLY < 0 || ONLY == (n))
#ifndef DUPN
#define DUPN -1
#endif
#define PH(n) for (int rp_ = 0; rp_ < (RUN(n) ? ((DUPN == (n)) ? 2 : 1) : 0); ++rp_)
struct Params {
    const float* x; const float* c; const int* positions; const float* ada_w; const float* ada_b;
    const float* norm_mix; const float* norm_ffn; const float* w_in; const float* q_norm; const float* w_uq;
    const float* kv_norm; const float* w_ukv; const float* ret_ld; const float* ret_norm;
    const float* w_br_mla; const float* w_br_dil; const float* w_br_ret; const float* w_out;
    const float* ffn_w1; const float* ffn_w3; const float* ffn_w2;
    const float* moe_router; const float* moe_w1; const float* moe_w3; const float* moe_w2; const float* final_norm;
    float* out; unsigned char* ws;
    double inv_freq[32];
};

constexpr int LDS_PTRS = LDS_MISC + 256;
template <class T, int OFF> __device__ __forceinline__ T* gp(LAS unsigned char* lds) {
    unsigned a; asm volatile("v_mov_b32 %0, %1" : "=v"(a) : "i"(LDS_PTRS + OFF));
    const volatile LAS unsigned* t = (const volatile LAS unsigned*)(lds + a);
    unsigned lo = t[0], hi = t[1]; lo = __builtin_amdgcn_readfirstlane(lo); hi = __builtin_amdgcn_readfirstlane(hi);
    return (T*)(((unsigned long long)hi << 32) | lo); }
#define GP(T, name) gp<T, (int)__builtin_offsetof(Params, name)>(F.lds)
#define WSP() gp<unsigned char, (int)__builtin_offsetof(Params, ws)>(F.lds)
namespace pg8 {
constexpr int BM = 256, BK = 64, HALF = 128, HTB = HALF * BK * 2, STAGE_BYTES = 8 * HTB, NXCD = 8, WGM = 8, KT_SPLIT = 7;
__device__ __forceinline__ int lds_byte(int r, int c) { const int st = (r >> 4) * 2 + (c >> 5), rr = r & 15, cc = c & 31, ob = rr * 64 + cc * 2; return st * 1024 + (ob ^ (((ob >> 9) & 1) << 5)); }
__device__ __forceinline__ void stage_rc(int b, int& R, int& C) { const int st = b / 1024, sb = b % 1024, swz = sb ^ (((sb >> 9) & 1) << 5); R = (st >> 1) * 16 + swz / 64; C = (st & 1) * 32 + (swz % 64) / 2; }
__device__ __forceinline__ int perm32(int rho) { const int n = rho >> 4, i = rho & 15; return 8 * (i >> 2) + 4 * n + (i & 3); }
struct Unit { int pm, pn; };
struct Gemm { const bf16_t* A; const bf16_t* Bt; int lda, ldb, K; };
struct StaticOrder {
    int nM, nN, nwg, G, c;
    const int* blk_exp; size_t estride;
    int nNr, ksub;
    __device__ void init(int nM_, int nN_, int G_, int c_) { nM = nM_; nN = nN_; nwg = nM * nN; G = G_; c = opaque_s(c_); blk_exp = nullptr; estride = 0; nNr = 0; ksub = 0; }
    __device__ bool next(int i, Unit& u) const {
        const int L = i * G + c; if (L >= nwg) return false;
        int wgid = L; { const int q = nwg / NXCD, r = nwg % NXCD, xcd = wgid % NXCD, off = wgid / NXCD; wgid = (xcd < r ? xcd * (q + 1) : r * (q + 1) + (xcd - r) * q) + off; }
        const int nig = WGM * nN, gid = wgid / nig, fm = gid * WGM, gsz = (nM - fm) < WGM ? (nM - fm) : WGM;
        u.pm = fm + ((wgid % nig) % gsz); u.pn = (wgid % nig) / gsz; return true;
    }
    __device__ __forceinline__ const char* a_ptr(const Gemm& g, const Unit& u) const { size_t ko = 0; if (nNr) ko = (size_t)(u.pn / nNr) * ksub; return (const char*)(g.A + (size_t)u.pm * 256 * g.lda + ko); }
    __device__ __forceinline__ const char* b_ptr(const Gemm& g, const Unit& u) const {
        size_t e = 0; if (blk_exp) e = (size_t)__builtin_amdgcn_readfirstlane(__hip_atomic_load(blk_exp + u.pm, __ATOMIC_RELAXED, __HIP_MEMORY_SCOPE_AGENT)) * estride;
        int pn = u.pn; size_t ko = 0; if (nNr) { ko = (size_t)(pn / nNr) * ksub; pn = pn % nNr; }
        return (const char*)(g.Bt + e + (size_t)pn * 256 * g.ldb + ko); }
};
struct TailOrder {
    int nM, nN, nwg, G, c;
    const int* blk_exp; size_t estride;
    int nNr, ksub, ntail;
    __device__ void init(int nM_, int nN_, int G_, int c_) { nM = nM_; nN = nN_; nwg = nM * nN; G = G_; c = opaque_s(c_); blk_exp = nullptr; estride = 0; nNr = 0; ksub = 0; ntail = 0; }
    __device__ bool next(int i, Unit& u) const {
        const int L = i * G + c; if (L >= nwg + ntail) return false;
        if (L >= nwg) { const int t = L - nwg, per = nNr * (KT_SPLIT); u.pm = nM + t / per; u.pn = nNr + t % per; return true; }
        int wgid = L; { const int q = nwg / NXCD, r = nwg % NXCD, xcd = wgid % NXCD, off = wgid / NXCD; wgid = (xcd < r ? xcd * (q + 1) : r * (q + 1) + (xcd - r) * q) + off; }
        const int nig = WGM * nN, gid = wgid / nig, fm = gid * WGM, gsz = (nM - fm) < WGM ? (nM - fm) : WGM;
        u.pm = fm + ((wgid % nig) % gsz); u.pn = (wgid % nig) / gsz; return true;
    }
    __device__ __forceinline__ int ntiles(const Unit& u, int nt) const { return (nNr && u.pn >= nNr) ? ksub / BK : nt; }
    __device__ __forceinline__ const char* a_ptr(const Gemm& g, const Unit& u) const { size_t ko = 0; if (nNr && u.pn >= nNr) ko = (size_t)(u.pn / nNr - 1) * ksub; return (const char*)(g.A + (size_t)u.pm * 256 * g.lda + ko); }
    __device__ __forceinline__ const char* b_ptr(const Gemm& g, const Unit& u) const {
        size_t e = 0; if (blk_exp) e = (size_t)__builtin_amdgcn_readfirstlane(__hip_atomic_load(blk_exp + u.pm, __ATOMIC_RELAXED, __HIP_MEMORY_SCOPE_AGENT)) * estride;
        int pn = u.pn; size_t ko = 0; if (nNr && pn >= nNr) { ko = (size_t)(pn / nNr - 1) * ksub; pn = pn % nNr; }
        return (const char*)(g.Bt + e + (size_t)pn * 256 * g.ldb + ko); }
};

__device__ __forceinline__ i32x8 cat8(bf16x8 a, bf16x8 b) { const i32x4 x = __builtin_bit_cast(i32x4, a), y = __builtin_bit_cast(i32x4, b); return __builtin_shufflevector(x, y, 0, 1, 2, 3, 4, 5, 6, 7); }
template <bool F8, class Epi, class Sched>
__device__ __forceinline__ void gemm_phase_t(LAS unsigned char* lds, int wave_in, const Gemm g, const Sched& S, const Epi& E) {
    const int wid = opaque_s(wave_in), lane = lane_now(), tid = wid * 64 + lane, wr = wid >> 2, wc = wid & 3, fr = lane & 15, fq = lane >> 4;
    const int K = g.K, nt = K / BK;
    unsigned voffA[2], voffB[2];
#pragma unroll
    for (int i = 0; i < 2; ++i) { int R, C; stage_rc(tid * 16 + i * 8192, R, C); const int Rb = (R & ~31) + perm32(R & 31);
        voffA[i] = (unsigned)(R * g.lda + C) * 2u; voffB[i] = (unsigned)(Rb * g.ldb + C) * 2u; }
    const size_t kstep = (size_t)(BK * 2);
    const size_t hstepA = (size_t)HALF * g.lda * 2, hstepB = (size_t)HALF * g.ldb * 2;
    const unsigned ldsw = (unsigned)wid * 1024u, ldsb = (unsigned)(__SIZE_TYPE__)lds;
    const int aoff = lds_byte(wr * 64 + fr, fq * 8), boff = lds_byte(wc * 32 + fr, fq * 8);
#define PG8_SA(b, h) (((b) * 2 + (h)) * HTB)
#define PG8_SB(b, h) ((4 + (b) * 2 + (h)) * HTB)
#define PG8_STAGE(bufoff, gbase, voff) do { const char* gb_ = (const char*)(gbase); const unsigned l0_ = ldsb + (unsigned)(bufoff) + ldsw; \
        asm volatile("s_mov_b32 m0, %0\n\ts_nop 0\n\tglobal_load_lds_dwordx4 %1, %2" :: "s"(l0_), "v"((voff)[0]), "s"(gb_) : "memory", "m0"); \
        asm volatile("s_mov_b32 m0, %0\n\ts_nop 0\n\tglobal_load_lds_dwordx4 %1, %2" :: "s"(l0_ + 8192u), "v"((voff)[1]), "s"(gb_) : "memory", "m0"); } while (0)
#define PG8_LDA(dst, b, h) do { _Pragma("unroll") for (int m = 0; m < 4; ++m) _Pragma("unroll") for (int k = 0; k < 2; ++k) dst[m][k] = *(const LAS bf16x8*)(lds + PG8_SA(b, h) + aoff + m * 2048 + k * 1024); } while (0)
#define PG8_LDB(dst, b, h) do { _Pragma("unroll") for (int n = 0; n < 2; ++n) _Pragma("unroll") for (int k = 0; k < 2; ++k) dst[n][k] = *(const LAS bf16x8*)(lds + PG8_SB(b, h) + boff + n * 2048 + k * 1024); } while (0)
#define PG8_MMA(ai, bj, At, Bt) do { __builtin_amdgcn_s_setprio(1); _Pragma("unroll") for (int m = 0; m < 4; ++m) _Pragma("unroll") for (int n = 0; n < 2; ++n) { \
        if constexpr (F8) acc[ai][bj][m][n] = __builtin_amdgcn_mfma_scale_f32_16x16x128_f8f6f4(cat8(Bt[n][0], Bt[n][1]), cat8(At[m][0], At[m][1]), acc[ai][bj][m][n], 0, 0, 0, 0, 0, 0); \
        else { _Pragma("unroll") for (int k = 0; k < 2; ++k) acc[ai][bj][m][n] = __builtin_amdgcn_mfma_f32_16x16x32_bf16(Bt[n][k], At[m][k], acc[ai][bj][m][n], 0, 0, 0); } } __builtin_amdgcn_s_setprio(0); } while (0)
#define PG8_WAIT_V(n) asm volatile("s_waitcnt vmcnt(%0)" :: "n"(n) : "memory")
#define PG8_WAIT_L(n) asm volatile("s_waitcnt lgkmcnt(" #n ")" ::: "memory")
#define PG8_BAR __builtin_amdgcn_s_barrier()
#define PG8_SCHED __builtin_amdgcn_sched_barrier(0)
    Unit cur, nxt; int ui = 0;
    if (!S.next(0, cur)) return;
    f32x4 acc[2][2][4][2];
#pragma unroll
    for (int a = 0; a < 2; ++a)
#pragma unroll
        for (int b = 0; b < 2; ++b)
#pragma unroll
            for (int m = 0; m < 4; ++m)
#pragma unroll
                for (int n = 0; n < 2; ++n) acc[a][b][m][n] = (f32x4){0.f, 0.f, 0.f, 0.f};
    bf16x8 At[4][2], B0[2][2], B1[2][2];
    const char* cA = S.a_ptr(g, cur); const char* cB = S.b_ptr(g, cur);
    PG8_STAGE(PG8_SB(0, 0), cB, voffB); PG8_STAGE(PG8_SB(0, 1), cB + hstepB, voffB); PG8_STAGE(PG8_SA(0, 0), cA, voffA); PG8_STAGE(PG8_SA(0, 1), cA + hstepA, voffA);
    if (wr == 1) PG8_BAR;
    PG8_WAIT_V(2); PG8_BAR;
    PG8_STAGE(PG8_SB(1, 0), cB + kstep, voffB); PG8_STAGE(PG8_SA(1, 0), cA + kstep, voffA); PG8_STAGE(PG8_SB(1, 1), cB + hstepB + kstep, voffB);
    PG8_WAIT_V(6); PG8_BAR;
    if constexpr (Epi::kRelax) {
    PG8_STAGE(PG8_SA(1, 1), cA + kstep + hstepA, voffA);
    { const unsigned char* db = gp<unsigned char, (int)__builtin_offsetof(Params, ws)>(lds) + WS_CTL + 262144 + (size_t)blockIdx.x * 2048; const unsigned doff = (unsigned)tid * 4u, dz = 0u;
#pragma unroll
      for (int i = 0; i < Epi::kSt; ++i) asm volatile("global_store_dword %0, %1, %2" :: "v"(doff), "v"(dz), "s"(db) : "memory"); }
    }
    constexpr int VS = Epi::kSt;
    for (;;) {
        const bool has_next = S.next(ui + 1, nxt);
        const char* nA = has_next ? S.a_ptr(g, nxt) : cA; const char* nB = has_next ? S.b_ptr(g, nxt) : cB;
        if constexpr (Epi::kRelax) {
            const char* a2 = cA + (size_t)2 * kstep; const char* b2 = cB + (size_t)2 * kstep;
            const char* a3 = a2 + kstep; const char* b3 = b2 + kstep;
            PG8_LDB(B0, 0, 0); PG8_LDB(B1, 0, 1); PG8_SCHED; PG8_LDA(At, 0, 0);
            PG8_WAIT_V(10 + VS); PG8_WAIT_L(0); PG8_BAR; PG8_MMA(0, 0, At, B0); PG8_MMA(0, 1, At, B1); PG8_BAR; PG8_SCHED;
            PG8_LDA(At, 0, 1); PG8_STAGE(PG8_SB(0, 0), b2, voffB); PG8_STAGE(PG8_SB(0, 1), b2 + hstepB, voffB); PG8_STAGE(PG8_SA(0, 0), a2, voffA);
            PG8_WAIT_V(14 + VS); PG8_WAIT_L(0); PG8_BAR; PG8_MMA(1, 0, At, B0); PG8_MMA(1, 1, At, B1); PG8_BAR; PG8_SCHED;
            PG8_LDB(B0, 1, 0); PG8_LDB(B1, 1, 1); PG8_SCHED; PG8_LDA(At, 1, 0); PG8_STAGE(PG8_SA(0, 1), a2 + hstepA, voffA);
            PG8_WAIT_V(10 + VS); PG8_WAIT_L(0); PG8_BAR; PG8_MMA(0, 0, At, B0); PG8_MMA(0, 1, At, B1); PG8_BAR; PG8_SCHED;
            PG8_LDA(At, 1, 1); PG8_STAGE(PG8_SB(1, 0), b3, voffB); PG8_STAGE(PG8_SB(1, 1), b3 + hstepB, voffB); PG8_STAGE(PG8_SA(1, 0), a3, voffA);
            PG8_WAIT_V(14 + VS); PG8_WAIT_L(0); PG8_BAR; PG8_MMA(1, 0, At, B0); PG8_MMA(1, 1, At, B1); PG8_BAR; PG8_SCHED;
        }
        int ntc = nt; if constexpr (Epi::kTail) ntc = S.ntiles(cur, nt);
#pragma unroll 1
        for (int t = Epi::kRelax ? 2 : 0; t < ntc; t += 2) {
            asm volatile(".p2align 6" ::: "memory");
            const bool last = (t == ntc - 2);
            const char* a1 = cA + (size_t)(t + 1) * kstep;
            const char* a2 = last ? nA : cA + (size_t)(t + 2) * kstep; const char* b2 = last ? nB : cB + (size_t)(t + 2) * kstep;
            const char* a3 = a2 + kstep; const char* b3 = b2 + kstep;
            PG8_LDB(B0, 0, 0); PG8_LDB(B1, 0, 1); PG8_SCHED; PG8_LDA(At, 0, 0); PG8_STAGE(PG8_SA(1, 1), a1 + hstepA, voffA);
            PG8_WAIT_V(8); PG8_WAIT_L(0); PG8_BAR; PG8_MMA(0, 0, At, B0); PG8_MMA(0, 1, At, B1); PG8_BAR; PG8_SCHED;
            PG8_LDA(At, 0, 1); PG8_STAGE(PG8_SB(0, 0), b2, voffB); PG8_STAGE(PG8_SB(0, 1), b2 + hstepB, voffB); PG8_STAGE(PG8_SA(0, 0), a2, voffA);
            PG8_WAIT_V(8); PG8_WAIT_L(0); PG8_BAR; PG8_MMA(1, 0, At, B0); PG8_MMA(1, 1, At, B1); PG8_BAR; PG8_SCHED;
            PG8_LDB(B0, 1, 0); PG8_LDB(B1, 1, 1); PG8_SCHED; PG8_LDA(At, 1, 0); PG8_STAGE(PG8_SA(0, 1), a2 + hstepA, voffA);
            PG8_WAIT_V(8); PG8_WAIT_L(0); PG8_BAR; PG8_MMA(0, 0, At, B0); PG8_MMA(0, 1, At, B1); PG8_BAR; PG8_SCHED;
            PG8_LDA(At, 1, 1); PG8_STAGE(PG8_SB(1, 0), b3, voffB); PG8_STAGE(PG8_SB(1, 1), b3 + hstepB, voffB); PG8_STAGE(PG8_SA(1, 0), a3, voffA);
            PG8_WAIT_V(8); PG8_WAIT_L(0); PG8_BAR; PG8_MMA(1, 0, At, B0); PG8_MMA(1, 1, At, B1); PG8_BAR; PG8_SCHED;
        }
        if constexpr (Epi::kRelax) if (has_next) PG8_STAGE(PG8_SA(1, 1), nA + kstep + hstepA, voffA);
        if (wr == 0) PG8_BAR;
        { const int l2_ = lane_now(); E(acc, cur, wr, wc, l2_ & 15, l2_ >> 4); }
        if (!has_next) break;
#pragma unroll
        for (int a = 0; a < 2; ++a)
#pragma unroll
            for (int b = 0; b < 2; ++b)
#pragma unroll
                for (int m = 0; m < 4; ++m)
#pragma unroll
                    for (int n = 0; n < 2; ++n) acc[a][b][m][n] = (f32x4){0.f, 0.f, 0.f, 0.f};
        cur = nxt; cA = nA; cB = nB; ++ui;
        if (wr == 1) PG8_BAR;
    }
    PG8_WAIT_V(0);
    PG8_BAR;
#undef PG8_SA
#undef PG8_SB
#undef PG8_STAGE
#undef PG8_LDA
#undef PG8_LDB
#undef PG8_MMA
#undef PG8_WAIT_V
#undef PG8_WAIT_L
#undef PG8_BAR
#undef PG8_SCHED
}
template <class Epi, class Sched> __device__ __forceinline__ void gemm_phase(LAS unsigned char* lds, int wave_in, const Gemm g, const Sched& S, const Epi& E) { gemm_phase_t<false>(lds, wave_in, g, S, E); }
template <class Epi, class Sched> __device__ __forceinline__ void gemm_phase8(LAS unsigned char* lds, int wave_in, const Gemm g, const Sched& S, const Epi& E) { gemm_phase_t<true>(lds, wave_in, g, S, E); }
}
using pg8::Unit;
typedef f32x4 (&AccRef)[2][2][4][2];

__device__ __forceinline__ float clamp448(float x) { float y = __builtin_fmaxf(x, -448.f); asm volatile("" : "+v"(y)); return __builtin_fminf(y, 448.f); }
__device__ __forceinline__ unsigned pk4_fp8(float a, float b, float c, float d) {
    int r = 0;
    r = __builtin_amdgcn_cvt_pk_fp8_f32(clamp448(a), clamp448(b), r, false);
    r = __builtin_amdgcn_cvt_pk_fp8_f32(clamp448(c), clamp448(d), r, true);
    return (unsigned)r;
}
__device__ __forceinline__ void unpk8(const u32x4 w, f32x4& a, f32x4& b) {
    a = (f32x4){bf2f(w.x & 0xffffu), bf2f(w.x >> 16), bf2f(w.y & 0xffffu), bf2f(w.y >> 16)}; b = (f32x4){bf2f(w.z & 0xffffu), bf2f(w.z >> 16), bf2f(w.w & 0xffffu), bf2f(w.w >> 16)}; }
__device__ __forceinline__ u32x4 pack8(f32x4 v0, f32x4 v1) { u32x4 w; w.x = pk2(v0[0], v0[1]); w.y = pk2(v0[2], v0[3]); w.z = pk2(v1[0], v1[1]); w.w = pk2(v1[2], v1[3]); return w; }

#define GAS __attribute__((address_space(1)))
__device__ __forceinline__ u32x4 gld16(const void* base, unsigned off) { return *(const GAS u32x4*)((const GAS unsigned char*)base + off); }
__device__ __forceinline__ f32x4 gldf4(const void* base, unsigned off) { return *(const GAS f32x4*)((const GAS unsigned char*)base + off); }
__device__ __forceinline__ void gst16(void* base, unsigned off, u32x4 v) { *(GAS u32x4*)((GAS unsigned char*)base + off) = v; }
__device__ __forceinline__ void gstf(void* base, unsigned off, float v) { *(GAS float*)((GAS unsigned char*)base + off) = v; }

__device__ __forceinline__ void store_lines(unsigned char* rowp0, unsigned voff, unsigned pitch8, bool lo, u32x4 p0, u32x4 p1) {
    u32x4 x = lo ? p1 : p0, r;
    r.x = (unsigned)__builtin_amdgcn_update_dpp(0, (int)x.x, 0x128, 0xf, 0xf, false); r.y = (unsigned)__builtin_amdgcn_update_dpp(0, (int)x.y, 0x128, 0xf, 0xf, false);
    r.z = (unsigned)__builtin_amdgcn_update_dpp(0, (int)x.z, 0x128, 0xf, 0xf, false); r.w = (unsigned)__builtin_amdgcn_update_dpp(0, (int)x.w, 0x128, 0xf, 0xf, false);
    gst16(rowp0, voff, lo ? p0 : r);
    gst16(rowp0 + pitch8, voff, lo ? r : p1);
}
__device__ __forceinline__ void split_cs(const u32x4 a, const u32x4 b, f32x4& c0, f32x4& c1, f32x4& s0, f32x4& s1) {
    c0 = (f32x4){bf2f(a.x & 0xffffu), bf2f(a.y & 0xffffu), bf2f(a.z & 0xffffu), bf2f(a.w & 0xffffu)}; s0 = (f32x4){bf2f(a.x >> 16), bf2f(a.y >> 16), bf2f(a.z >> 16), bf2f(a.w >> 16)};
    c1 = (f32x4){bf2f(b.x & 0xffffu), bf2f(b.y & 0xffffu), bf2f(b.z & 0xffffu), bf2f(b.w & 0xffffu)}; s1 = (f32x4){bf2f(b.x >> 16), bf2f(b.y >> 16), bf2f(b.z >> 16), bf2f(b.w >> 16)};
}
#define EPI_FOR_AM _Pragma("unroll") for (int ai = 0; ai < 2; ++ai) _Pragma("unroll") for (int m = 0; m < 4; ++m)
struct EpiIn {
    static constexpr bool kTail = false;
    static constexpr bool kRelax = true;
    static constexpr int kSt = 16;
    bf16_t* plain; bf16_t* rope; float* ssq; const unsigned* csT; float sc;
    __device__ __forceinline__ void operator()(AccRef acc, const Unit& u, int wr, int wc, int fr, int fq) const {
        const int rowb = u.pm * 256 + wr * 64;
        const bool lo = fr < 8;
        if (u.pn < 31) {
            const int act = u.pn >= 19 ? 1 : (u.pn >= 15 ? 2 : 0);
            const unsigned vl = (unsigned)((fr & 7) * (PLAIN_W * 2) + (lo ? 0 : 64) + 16 * fq), vs = (unsigned)(fr * 80);
            unsigned char* pb = (unsigned char*)(plain + (size_t)rowb * PLAIN_W + u.pn * 256 + wc * 64);
            float* sb = ssq + (size_t)rowb * 20 + u.pn * 4 + wc;
            EPI_FOR_AM {
                float ss = 0.f; u32x4 pk[2];
#pragma unroll
                for (int bj = 0; bj < 2; ++bj) {
                    f32x4 v0 = acc[ai][bj][m][0] * sc, v1 = acc[ai][bj][m][1] * sc;
                    if (u.pn < 5) {
#pragma unroll
                        for (int j = 0; j < 4; ++j) ss += v0[j] * v0[j] + v1[j] * v1[j];
                    }
                    if (act == 1) {
#pragma unroll
                        for (int j = 0; j < 4; ++j) { v0[j] = fsigmoid(v0[j]); v1[j] = fsigmoid(v1[j]); }
                    } else if (act == 2) {
#pragma unroll
                        for (int j = 0; j < 4; ++j) { v0[j] = fsilu(v0[j]); v1[j] = fsilu(v1[j]); }
                    }
                    pk[bj] = pack8(v0, v1);
                }
                store_lines(pb + (size_t)(ai * 128 + m * 16) * (PLAIN_W * 2), vl, 8 * PLAIN_W * 2, lo, pk[0], pk[1]);
                if (u.pn < 5) {
                    ss = sum_x32(sum_x16(ss));
                    if (fq == 0) gstf(sb + (size_t)(ai * 128 + m * 16) * 20, vs, ss);
                }
            }
        } else {
            const int slot = (u.pn - 31) * 4 + wc;
            const unsigned vl = (unsigned)((fr & 7) * (ROPE_W * 2) + (lo ? 0 : 64) + 16 * fq), vc = (unsigned)(fr * 128 + fq * 32);
            const unsigned* cb = csT + (size_t)rowb * 32;
            unsigned char* rb = (unsigned char*)(rope + (size_t)rowb * ROPE_W + slot * 64);
            u32x4 csa[2][4], csb[2][4];
            EPI_FOR_AM { csa[ai][m] = gld16(cb + (ai * 128 + m * 16) * 32, vc); csb[ai][m] = gld16(cb + (ai * 128 + m * 16) * 32 + 4, vc); }
            EPI_FOR_AM {
                f32x4 c0, c1, s0, s1; split_cs(csa[ai][m], csb[ai][m], c0, c1, s0, s1);
                const f32x4 a0 = acc[ai][0][m][0] * sc, a1 = acc[ai][0][m][1] * sc, b0 = acc[ai][1][m][0] * sc, b1 = acc[ai][1][m][1] * sc;
                const f32x4 o10 = a0 * c0 - b0 * s0, o11 = a1 * c1 - b1 * s1, o20 = b0 * c0 + a0 * s0, o21 = b1 * c1 + a1 * s1;
                store_lines(rb + (size_t)(ai * 128 + m * 16) * (ROPE_W * 2), vl, 8 * ROPE_W * 2, lo, pack8(o10, o11), pack8(o20, o21));
            }
        }
    }
};
struct EpiQ {
    static constexpr bool kTail = false;
    static constexpr bool kRelax = true;
    static constexpr int kSt = 16;
    bf16_t* q; const float* ssq; const unsigned* csT; float c2;
    __device__ __forceinline__ void operator()(AccRef acc, const Unit& u, int wr, int wc, int fr, int fq) const {
        const int rowb = u.pm * 256 + wr * 64;
        const unsigned vs = (unsigned)(fr * 80), vq = (unsigned)(fr * (QW * 2) + fq * 16);
        const float* sb = ssq + (size_t)rowb * 20;
        float rs[2][4];
#pragma unroll
        for (int ai = 0; ai < 2; ++ai) {
            f32x4 p[4][3];
#pragma unroll
            for (int m = 0; m < 4; ++m) { const float* sp = sb + (ai * 128 + m * 16) * 20; p[m][0] = gldf4(sp, vs); p[m][1] = gldf4(sp + 4, vs); p[m][2] = gldf4(sp + 8, vs); }
#pragma unroll
            for (int m = 0; m < 4; ++m) {
                const float tot = ((p[m][0][0] + p[m][0][1]) + (p[m][0][2] + p[m][0][3])) + ((p[m][1][0] + p[m][1][1]) + (p[m][1][2] + p[m][1][3])) + ((p[m][2][0] + p[m][2][1]) + (p[m][2][2] + p[m][2][3]));
                rs[ai][m] = c2 * __builtin_amdgcn_rsqf(tot * (1.0f / 768.0f) + EPS); }
        }
        if (u.pn < 4) {
            bf16_t* qb = q + (size_t)rowb * QW + 2 * u.pn * 192 + wc * 32;
            EPI_FOR_AM {
                const float r = rs[ai][m];
#pragma unroll
                for (int bj = 0; bj < 2; ++bj) gst16(qb + (size_t)(ai * 128 + m * 16) * QW + bj * 192, vq, pack8(acc[ai][bj][m][0] * r, acc[ai][bj][m][1] * r));
            }
        } else {
            const int head = (u.pn - 4) * 4 + wc;
            const unsigned vc = (unsigned)(fr * 128 + fq * 32);
            const unsigned* cb = csT + (size_t)rowb * 32;
            bf16_t* qb = q + (size_t)rowb * QW + head * 192 + 128;
            u32x4 csa[2][4], csb[2][4];
            EPI_FOR_AM { csa[ai][m] = gld16(cb + (ai * 128 + m * 16) * 32, vc); csb[ai][m] = gld16(cb + (ai * 128 + m * 16) * 32 + 4, vc); }
            EPI_FOR_AM {
                const float r = rs[ai][m];
                f32x4 c0, c1, s0, s1; split_cs(csa[ai][m], csb[ai][m], c0, c1, s0, s1);
                const f32x4 a0 = acc[ai][0][m][0] * r, a1 = acc[ai][0][m][1] * r, b0 = acc[ai][1][m][0] * r, b1 = acc[ai][1][m][1] * r;
                bf16_t* dst = qb + (size_t)(ai * 128 + m * 16) * QW;
                gst16(dst, vq, pack8(a0 * c0 - b0 * s0, a1 * c1 - b1 * s1));
                gst16(dst + 32, vq, pack8(b0 * c0 + a0 * s0, b1 * c1 + a1 * s1));
            }
        }
    }
};
struct EpiKV {
    static constexpr bool kTail = false;
    static constexpr bool kRelax = true;
    static constexpr int kSt = 16;
    bf16_t* kv; const float* ssq;
    __device__ __forceinline__ void operator()(AccRef acc, const Unit& u, int wr, int wc, int fr, int fq) const {
        const int rowb = u.pm * 256 + wr * 64;
        const unsigned vs = (unsigned)(fr * 80), vk = (unsigned)(fr * (KVW * 2) + fq * 16);
        const float* sb = ssq + (size_t)rowb * 20 + 12;
        bf16_t* kb = kv + (size_t)rowb * KVW + u.pn * 256 + wc * 32;
        f32x4 p[2][4][2];
        EPI_FOR_AM { const float* sp = sb + (ai * 128 + m * 16) * 20; p[ai][m][0] = gldf4(sp, vs); p[ai][m][1] = gldf4(sp + 4, vs); }
        EPI_FOR_AM {
            const f32x4 p0 = p[ai][m][0], p1 = p[ai][m][1];
            const float tot = ((p0[0] + p0[1]) + (p0[2] + p0[3])) + ((p1[0] + p1[1]) + (p1[2] + p1[3]));
            const float rs = __builtin_amdgcn_rsqf(tot * (1.0f / 512.0f) + EPS);
#pragma unroll
            for (int bj = 0; bj < 2; ++bj) gst16(kb + (size_t)(ai * 128 + m * 16) * KVW + bj * 128, vk, pack8(acc[ai][bj][m][0] * rs, acc[ai][bj][m][1] * rs));
        }
    }
};
struct EpiBr {
    static constexpr bool kTail = false;
    static constexpr bool kRelax = true;
    static constexpr int kSt = 16;
    bf16_t* mf; bf16_t* mb; const bf16_t* gate; int mode;
    __device__ __forceinline__ void operator()(AccRef acc, const Unit& u, int wr, int wc, int fr, int fq) const {
        const int rowb = u.pm * 256 + wr * 64, colb = u.pn * 256 + wc * 32;
        const unsigned vg = (unsigned)(fr * (PLAIN_W * 2) + fq * 16), vm = (unsigned)(fr * (DM * 2) + fq * 16);
        const bf16_t* gb = gate + (size_t)rowb * PLAIN_W + colb;
        {
            u32x4 gw[2][4][2];
            EPI_FOR_AM {
#pragma unroll
                for (int bj = 0; bj < 2; ++bj) gw[ai][m][bj] = gld16(gb + (size_t)(ai * 128 + m * 16) * PLAIN_W + bj * 128, vg); }
            EPI_FOR_AM {
#pragma unroll
                for (int bj = 0; bj < 2; ++bj) { f32x4 g0, g1; unpk8(gw[ai][m][bj], g0, g1); acc[ai][bj][m][0] *= g0; acc[ai][bj][m][1] *= g1; } }
        }
        const bf16_t* fb = mf + (size_t)rowb * DM + colb;
        if (mode != 0) {
            u32x4 pw[2][4][2];
            EPI_FOR_AM {
#pragma unroll
                for (int bj = 0; bj < 2; ++bj) pw[ai][m][bj] = gld16(fb + (size_t)(ai * 128 + m * 16) * DM + bj * 128, vm); }
            EPI_FOR_AM {
#pragma unroll
                for (int bj = 0; bj < 2; ++bj) { f32x4 v0, v1; unpk8(pw[ai][m][bj], v0, v1); acc[ai][bj][m][0] += v0; acc[ai][bj][m][1] += v1; } }
        }
        bf16_t* ob = ((mode != 2) ? mf : mb) + (size_t)rowb * DM + colb;
        EPI_FOR_AM {
#pragma unroll
            for (int bj = 0; bj < 2; ++bj) gst16(ob + (size_t)(ai * 128 + m * 16) * DM + bj * 128, vm, pack8(acc[ai][bj][m][0], acc[ai][bj][m][1])); }
    }
};
struct EpiRes {
    static constexpr bool kTail = false;
    static constexpr bool kRelax = true;
    static constexpr int kSt = 16;
    bf16_t* x; const float* gate; float sc;
    __device__ __forceinline__ void operator()(AccRef acc, const Unit& u, int wr, int wc, int fr, int fq) const {
        const int rowb = u.pm * 256 + wr * 64, colb = u.pn * 256 + wc * 32;
        const unsigned vm = (unsigned)(fr * (DM * 2) + fq * 16), vg = (unsigned)(fq * 32);
        const float* gp = gate + (size_t)(u.pm >> 3) * 6144 + colb;
        bf16_t* xb = x + (size_t)rowb * DM + colb;
        f32x4 g[2][2];
#pragma unroll
        for (int bj = 0; bj < 2; ++bj) { g[bj][0] = gldf4(gp + bj * 128, vg) * sc; g[bj][1] = gldf4(gp + bj * 128 + 4, vg) * sc; }
        u32x4 bw[2][4][2];
        EPI_FOR_AM {
#pragma unroll
            for (int bj = 0; bj < 2; ++bj) bw[ai][m][bj] = gld16(xb + (size_t)(ai * 128 + m * 16) * DM + bj * 128, vm); }
        EPI_FOR_AM {
#pragma unroll
            for (int bj = 0; bj < 2; ++bj) {
                f32x4 b0, b1; unpk8(bw[ai][m][bj], b0, b1);
                gst16(xb + (size_t)(ai * 128 + m * 16) * DM + bj * 128, vm, pack8(b0 + g[bj][0] * acc[ai][bj][m][0], b1 + g[bj][1] * acc[ai][bj][m][1]));
            } }
    }
};
__device__ __forceinline__ void gst8p(void* base, unsigned off, u32x2 v) { *(GAS u32x2*)((GAS unsigned char*)base + off) = v; }
struct EpiResNorm {
    static constexpr bool kTail = false;
    static constexpr bool kRelax = true;
    static constexpr int kSt = 16;
    bf16_t* x; const float* gate; float sc;
    unsigned char* h; int h8;
    const float* gain; const float* scale; const float* shift;
    float* slots; unsigned* cnt; LAS unsigned char* lds;
    __device__ __forceinline__ void operator()(AccRef acc, const Unit& u, int wr, int wc, int fr, int fq) const {
        LAS float* P = (LAS float*)(lds + 135168);
        LAS float* S = (LAS float*)(lds + 139264);
        LAS unsigned* flag = (LAS unsigned*)(lds + 140288);
        const int wid = wr * 4 + wc, lane = fq * 16 + fr;
        const int rowb = u.pm * 256 + wr * 64, colb = u.pn * 256 + wc * 32;
        const unsigned vm = (unsigned)(fr * (DM * 2) + fq * 16), vg = (unsigned)(fq * 32);
        const float* gp = gate + (size_t)(u.pm >> 3) * 6144 + colb;
        bf16_t* xb = x + (size_t)rowb * DM + colb;
        f32x4 g[2][2];
#pragma unroll
        for (int bj = 0; bj < 2; ++bj) { g[bj][0] = gldf4(gp + bj * 128, vg) * sc; g[bj][1] = gldf4(gp + bj * 128 + 4, vg) * sc; }
        {
            u32x4 bw[2][4][2];
            EPI_FOR_AM {
#pragma unroll
                for (int bj = 0; bj < 2; ++bj) bw[ai][m][bj] = gld16(xb + (size_t)(ai * 128 + m * 16) * DM + bj * 128, vm); }
            EPI_FOR_AM {
                float ss = 0.f;
#pragma unroll
                for (int bj = 0; bj < 2; ++bj) {
                    f32x4 b0, b1; unpk8(bw[ai][m][bj], b0, b1);
                    const f32x4 x0 = b0 + g[bj][0] * acc[ai][bj][m][0], x1 = b1 + g[bj][1] * acc[ai][bj][m][1];
                    acc[ai][bj][m][0] = x0; acc[ai][bj][m][1] = x1;
                    ss += (x0[0] * x0[0] + x0[1] * x0[1]) + (x0[2] * x0[2] + x0[3] * x0[3]) + (x1[0] * x1[0] + x1[1] * x1[1]) + (x1[2] * x1[2] + x1[3] * x1[3]);
                    gst16(xb + (size_t)(ai * 128 + m * 16) * DM + bj * 128, vm, pack8(x0, x1));
                }
                ss = sum_x32(sum_x16(ss));
                if (fq == 0) P[(ai * 128 + wr * 64 + m * 16 + fr) * 4 + wc] = ss;
            }
        }
        const int b = u.pm >> 3;
        f32x4 gs[2][2], sh[2][2];
#pragma unroll
        for (int bj = 0; bj < 2; ++bj)
#pragma unroll
            for (int n = 0; n < 2; ++n) {
                const f32x4 gn = gldf4(gain + colb + bj * 128 + 4 * n, vg), sc2 = gldf4(scale + (size_t)b * 6144 + colb + bj * 128 + 4 * n, vg);
                sh[bj][n] = gldf4(shift + (size_t)b * 6144 + colb + bj * 128 + 4 * n, vg); gs[bj][n] = gn * (1.0f + sc2); }
        asm volatile("s_waitcnt lgkmcnt(0)" ::: "memory"); __builtin_amdgcn_s_barrier(); asm volatile("" ::: "memory");
        const int row = wid * 32 + (lane & 31);
        if (lane < 32) {
            const float t = (P[row * 4 + 0] + P[row * 4 + 1]) + (P[row * 4 + 2] + P[row * 4 + 3]);
            __hip_atomic_store(slots + ((size_t)(u.pm * 256 + row) * 4 + u.pn), t, __ATOMIC_RELAXED, __HIP_MEMORY_SCOPE_AGENT);
        }
        asm volatile("s_waitcnt vmcnt(0)" ::: "memory");
        if (lane == 0) __hip_atomic_fetch_add(cnt + 64 * u.pm, 1u, __ATOMIC_RELAXED, __HIP_MEMORY_SCOPE_AGENT);
        if (wid == 0) {
            bool dead = false; unsigned spins = 0;
            for (;;) {
                if ((unsigned)__builtin_amdgcn_readfirstlane(__hip_atomic_load(cnt + 64 * u.pm, __ATOMIC_RELAXED, __HIP_MEMORY_SCOPE_AGENT)) >= 32u) break;
                if (++spins > (1u << 22)) { dead = true; break; }
                __builtin_amdgcn_s_sleep(2);
            }
            __builtin_amdgcn_fence(__ATOMIC_ACQUIRE, "agent");
            if (lane == 0) flag[0] = dead ? 1u : 0u;
        }
        asm volatile("s_waitcnt vmcnt(0) lgkmcnt(0)" ::: "memory"); __builtin_amdgcn_s_barrier(); asm volatile("" ::: "memory");
        const bool bad = flag[0] != 0u;
        if (lane < 32) {
            const float* sl = slots + (size_t)(u.pm * 256 + row) * 4; float tot = 0.f;
#pragma unroll
            for (int t = 0; t < 4; ++t) tot += __hip_atomic_load(sl + t, __ATOMIC_RELAXED, __HIP_MEMORY_SCOPE_AGENT);
            S[row] = bad ? __builtin_nanf("") : __builtin_amdgcn_rsqf(tot * (1.0f / DM) + EPS);
        }
        asm volatile("s_waitcnt vmcnt(0) lgkmcnt(0)" ::: "memory"); __builtin_amdgcn_s_barrier(); asm volatile("" ::: "memory");
        unsigned char* hb = h + ((size_t)rowb * DM + colb) * (h8 ? 1 : 2);
        const unsigned vh8 = (unsigned)(fr * DM + fq * 8);
        EPI_FOR_AM {
            const float rs = S[ai * 128 + wr * 64 + m * 16 + fr];
#pragma unroll
            for (int bj = 0; bj < 2; ++bj) {
                const f32x4 h0 = acc[ai][bj][m][0] * rs * gs[bj][0] + sh[bj][0], h1 = acc[ai][bj][m][1] * rs * gs[bj][1] + sh[bj][1];
                if (h8) { u32x2 w; w.x = pk4_fp8(h0[0], h0[1], h0[2], h0[3]); w.y = pk4_fp8(h1[0], h1[1], h1[2], h1[3]); gst8p(hb + (size_t)(ai * 128 + m * 16) * DM + bj * 128, vh8, w); }
                else gst16(hb + ((size_t)(ai * 128 + m * 16) * DM + bj * 128) * 2, vm, pack8(h0, h1));
            }
        }
    }
};
struct EpiSwi {
    static constexpr bool kTail = false;
    static constexpr bool kRelax = true;
    static constexpr int kSt = 8;
    bf16_t* hid; int ld;
    __device__ __forceinline__ void operator()(AccRef acc, const Unit& u, int wr, int wc, int fr, int fq) const {
        const int rowb = u.pm * 256 + wr * 64;
        const unsigned vh = (unsigned)(fr * ld * 2 + fq * 16);
        bf16_t* hb = hid + (size_t)rowb * ld + u.pn * 128 + wc * 32;
        EPI_FOR_AM {
            f32x4 v0, v1;
#pragma unroll
            for (int j = 0; j < 4; ++j) { v0[j] = fsilu(acc[ai][0][m][0][j]) * acc[ai][1][m][0][j]; v1[j] = fsilu(acc[ai][0][m][1][j]) * acc[ai][1][m][1][j]; }
            gst16(hb + (size_t)(ai * 128 + m * 16) * ld, vh, pack8(v0, v1));
        }
    }
};
struct EpiSwi8 {
    static constexpr bool kTail = false;
    static constexpr bool kRelax = false;
    static constexpr int kSt = 4;
    unsigned char* hid; int ld; float si, so;
    __device__ __forceinline__ void operator()(AccRef acc, const Unit& u, int wr, int wc, int fr, int fq) const {
        const int rowb = u.pm * 256 + wr * 64;
        const unsigned vh = (unsigned)((fr + 16 * (fq & 1)) * ld + 16 * (fq >> 1));
        unsigned char* hb = hid + (size_t)rowb * ld + u.pn * 128 + wc * 32;
        const float s2 = si * so;
#pragma unroll
        for (int ai = 0; ai < 2; ++ai)
#pragma unroll
            for (int mp = 0; mp < 4; mp += 2) {
                unsigned w[2][2];
#pragma unroll
                for (int mm = 0; mm < 2; ++mm)
#pragma unroll
                    for (int n = 0; n < 2; ++n) {
                        float v[4];
#pragma unroll
                        for (int j = 0; j < 4; ++j) v[j] = fsilu(acc[ai][0][mp + mm][n][j] * si) * (acc[ai][1][mp + mm][n][j] * s2);
                        w[mm][n] = pk4_fp8(v[0], v[1], v[2], v[3]);
                    }
                const auto r0 = __builtin_amdgcn_permlane16_swap(w[0][0], w[1][0], false, false);
                const auto r1 = __builtin_amdgcn_permlane16_swap(w[0][1], w[1][1], false, false);
                u32x4 o; o.x = r0[0]; o.y = r1[0]; o.z = r0[1]; o.w = r1[1];
                gst16(hb + (size_t)(ai * 128 + mp * 16) * ld, vh, o);
                __builtin_amdgcn_sched_barrier(0);
            }
    }
};
struct EpiPlain {
    static constexpr bool kTail = true;
    static constexpr bool kRelax = true;
    static constexpr int kSt = 16;
    bf16_t* o; int ld; int nNr; bf16_t* o2; float sc; int nM; size_t pstride;
    __device__ __forceinline__ void operator()(AccRef acc, const Unit& u, int wr, int wc, int fr, int fq) const {
        const bool tail = u.pn >= nNr;
        const int rowb = (tail ? u.pm - nM : u.pm) * 256 + wr * 64;
        const unsigned vo = (unsigned)(fr * ld * 2 + fq * 16);
        bf16_t* ob = (tail ? o2 + (size_t)(u.pn / nNr - 1) * pstride : this->o) + (size_t)rowb * ld + (u.pn % nNr) * 256 + wc * 32;
        EPI_FOR_AM {
#pragma unroll
            for (int bj = 0; bj < 2; ++bj) gst16(ob + (size_t)(ai * 128 + m * 16) * ld + bj * 128, vo, pack8(acc[ai][bj][m][0] * sc, acc[ai][bj][m][1] * sc)); }
    }
};
#undef EPI_FOR_AM

struct Frame {
    LAS unsigned char* lds; int tid, lane, wave, G, gw, ngw;
};
__device__ __forceinline__ Frame mkframe0(LAS unsigned char* lds) { Frame F; F.lds = lds; F.tid = opaque(threadIdx.x); F.lane = F.tid & 63; F.wave = __builtin_amdgcn_readfirstlane(F.tid >> 6);
    F.G = gridDim.x; F.gw = blockIdx.x * 8 + F.wave; F.ngw = F.G * 8; return F; }
__device__ __forceinline__ Frame mkframe(const Frame& F0) { Frame F; F.lds = F0.lds; F.wave = opaque_s(F0.wave); F.lane = lane_now(); F.tid = F.wave * 64 + F.lane;
    F.G = gridDim.x; F.gw = blockIdx.x * 8 + F.wave; F.ngw = F.G * 8; return F; }

constexpr int MOE_MAIN_BLK = 128, MOE_TAIL_ROWS = 8 * 256;
constexpr float W13E_SC = 32.f, W2E_SC = 64.f, HID8_SC = 4.f, WIN_SC = 32.f;
struct CvtDesc { const float* src; const float* gain; unsigned char* dst; int ld, Kd, n0, k0; float sn; int valid, f8; };
__device__ __forceinline__ void cvt_load(const CvtDesc& d, float (&v)[32], int lane) {
    if (d.valid) {
#pragma unroll
        for (int i = 0; i < 32; ++i) v[i] = __builtin_nontemporal_load(d.src + (size_t)(d.k0 + 2 * i + (lane >> 5)) * d.ld + (lane & 31));
    } else {
#pragma unroll
        for (int i = 0; i < 32; ++i) v[i] = 0.f;
    }
}
__device__ __forceinline__ void cvt_store(const CvtDesc& d, float (&v)[32], LAS float* scr, int lane) {
    if (d.gain) {
#pragma unroll
        for (int i = 0; i < 32; ++i) v[i] *= d.gain[d.k0 + 2 * i + (lane >> 5)];
    }
#pragma unroll
    for (int i = 0; i < 32; ++i) scr[(2 * i + (lane >> 5)) * 33 + (lane & 31)] = v[i] * d.sn;
    asm volatile("s_waitcnt lgkmcnt(0)" ::: "memory");
    const int c = lane & 7;
    if (d.f8) {
#pragma unroll
        for (int j = 0; j < 4; ++j) { const int n = (lane >> 3) + 8 * j; const LAS float* s = scr + (8 * c) * 33 + n;
            u32x2 o; o.x = pk4_fp8(s[0 * 33], s[1 * 33], s[2 * 33], s[3 * 33]); o.y = pk4_fp8(s[4 * 33], s[5 * 33], s[6 * 33], s[7 * 33]);
            *(u32x2*)(d.dst + (size_t)(d.n0 + n) * d.Kd + d.k0 + 8 * c) = o; }
    } else {
#pragma unroll
        for (int j = 0; j < 4; ++j) { const int n = (lane >> 3) + 8 * j; const LAS float* s = scr + (8 * c) * 33 + n;
            u32x4 o; o.x = pk2(s[0 * 33], s[1 * 33]); o.y = pk2(s[2 * 33], s[3 * 33]); o.z = pk2(s[4 * 33], s[5 * 33]); o.w = pk2(s[6 * 33], s[7 * 33]);
            *(u32x4*)(d.dst + ((size_t)(d.n0 + n) * d.Kd + d.k0 + 8 * c) * 2) = o; }
    }
    asm volatile("s_waitcnt lgkmcnt(0)" ::: "memory");
}
__device__ __forceinline__ void win_map(int nb, int& c0, float& sn) {
    int n0 = nb * 32; sn = 1.f;
    if (n0 < PLAIN_W) {
        { const int p = n0 & 255, bj = p >> 7, wc_ = (p >> 5) & 3; n0 = (n0 & ~255) + 64 * wc_ + 32 * bj; }
        if (n0 < PC_DV) { c0 = n0; return; }
        if (n0 < PC_RV) { c0 = 4416 + (n0 - PC_DV); return; }
        if (n0 < PC_RG) { c0 = 6976 + (n0 - PC_RV); return; }
        c0 = 8000 + (n0 - PC_RG); return;
    }
    const int r = n0 - PLAIN_W, tile = r >> 8, p = r & 255, bj = p >> 7, hh = (p & 127) >> 5;
    const int slot = tile * 4 + hh;
    int base;
    if (slot == 0) base = 1280;
    else if (slot < RS_DK) { base = 1344 + (slot - RS_DQ) * 64; sn = 0.125f; }
    else if (slot < RS_RQ) base = 2880 + (slot - RS_DK) * 64;
    else if (slot < RS_RK) base = 5952 + (slot - RS_RQ) * 64;
    else if (slot < 65) { base = 6464 + (slot - RS_RK) * 64; sn = 0.125f; }
    else { c0 = -1; return; }
    c0 = base + bj * 32;
}
__device__ __forceinline__ void cvt_decode(Frame& F, unsigned char* ws, int r, bool moe_only, int moe_layer, CvtDesc& d) {
    constexpr int I_WIN = 4 * 16 * 384, I_UQ = 4 * 12 * 48, I_UKV = 4 * 8 * 64, I_BM = 4 * 16 * 32, I_BD = 4 * 8 * 32, I_BR = 4 * 16 * 32, I_WO = 4 * 16 * 32;
    constexpr int I_F13 = 2 * 16 * 176, I_F2 = 2 * 44 * 32, I_M13 = 8 * 16 * 224;
    d.gain = nullptr; d.sn = 1.f; d.valid = 1; d.f8 = 0;
#define CVT_SET(SRC, LD, DST, KD, N0, K0) do { d.src = (SRC); d.ld = (LD); d.dst = (unsigned char*)(DST); d.Kd = (KD); d.n0 = (N0); d.k0 = (K0); } while (0)
    if (!moe_only) {
        if (r < I_WIN) { const int l = r / (16 * 384), q = r % (16 * 384), kb = q / 384, nb = q % 384; int c0; float sn; win_map(nb, c0, sn);
            CVT_SET(GP(const float, w_in) + (size_t)l * DM * IN_COLS + (c0 < 0 ? 0 : c0), IN_COLS, ws + WS_WIN + (size_t)l * NIN * DM, DM, nb * 32, kb * 64); d.valid = c0 >= 0; d.sn = sn * WIN_SC; d.f8 = 1; return; } r -= I_WIN;
        if (r < I_UQ) { const int l = r / (12 * 48), q = r % (12 * 48), kb = q / 48, nb = q % 48; const int n0 = nb * 32; int c0;
            if (n0 < 1024) { const int head = n0 >> 7; c0 = head * 192 + (n0 & 127); }
            else { const int rr = n0 - 1024, tile = rr >> 8, p = rr & 255, bj = p >> 7, hh = (p & 127) >> 5; c0 = (tile * 4 + hh) * 192 + 128 + bj * 32; }
            CVT_SET(GP(const float, w_uq) + (size_t)l * 768 * QW + c0, QW, (bf16_t*)(ws + WS_WUQ) + (size_t)l * QW * 768, 768, n0, kb * 64); d.gain = GP(const float, q_norm) + l * 768; return; } r -= I_UQ;
        if (r < I_UKV) { const int l = r / (8 * 64), q = r % (8 * 64), kb = q / 64, nb = q % 64;
            CVT_SET(GP(const float, w_ukv) + (size_t)l * 512 * KVW + nb * 32, KVW, (bf16_t*)(ws + WS_WUKV) + (size_t)l * KVW * 512, 512, nb * 32, kb * 64); d.gain = GP(const float, kv_norm) + l * 512; return; } r -= I_UKV;
        if (r < I_BM) { const int l = r / (16 * 32), q = r % (16 * 32), kb = q / 32, nb = q % 32;
            CVT_SET(GP(const float, w_br_mla) + (size_t)l * DM * DM + nb * 32, DM, (bf16_t*)(ws + WS_WBM) + (size_t)l * DM * DM, DM, nb * 32, kb * 64); return; } r -= I_BM;
        if (r < I_BD) { const int l = r / (8 * 32), q = r % (8 * 32), kb = q / 32, nb = q % 32;
            CVT_SET(GP(const float, w_br_dil) + (size_t)l * 512 * DM + nb * 32, DM, (bf16_t*)(ws + WS_WBD) + (size_t)l * DM * 512, 512, nb * 32, kb * 64); return; } r -= I_BD;
        if (r < I_BR) { const int l = r / (16 * 32), q = r % (16 * 32), kb = q / 32, nb = q % 32;
            CVT_SET(GP(const float, w_br_ret) + (size_t)l * DM * DM + nb * 32, DM, (bf16_t*)(ws + WS_WBR) + (size_t)l * DM * DM, DM, nb * 32, kb * 64); return; } r -= I_BR;
        if (r < I_WO) { const int l = r / (16 * 32), q = r % (16 * 32), kb = q / 32, nb = q % 32;
            CVT_SET(GP(const float, w_out) + (size_t)l * DM * DM + nb * 32, DM, (bf16_t*)(ws + WS_WO) + (size_t)l * DM * DM, DM, nb * 32, kb * 64); return; } r -= I_WO;
        if (r < I_F13) { const int i = r / (16 * 176), q = r % (16 * 176), kb = q / 176, nb = q % 176; const int n0 = nb * 32, tile = n0 >> 8, p = n0 & 255;
            const float* src = (p < 128 ? GP(const float, ffn_w1) : GP(const float, ffn_w3)) + (size_t)i * DM * DFF;
            CVT_SET(src + tile * 128 + (p & 127), DFF, (bf16_t*)(ws + WS_W13) + (size_t)i * 5632 * DM, DM, n0, kb * 64); return; } r -= I_F13;
        if (r < I_F2) { const int i = r / (44 * 32), q = r % (44 * 32), kb = q / 32, nb = q % 32;
            CVT_SET(GP(const float, ffn_w2) + (size_t)i * DFF * DM + nb * 32, DM, (bf16_t*)(ws + WS_W2) + (size_t)i * DM * DFF, DFF, nb * 32, kb * 64); return; } r -= I_F2;
    }
    if (r < I_M13) { const int e = r / (16 * 224), q = r % (16 * 224), kb = q / 224, nb = q % 224; const int n0 = nb * 32, tile = n0 >> 8, p = n0 & 255;
        const float* src = (p < 128 ? GP(const float, moe_w1) : GP(const float, moe_w3)) + ((size_t)moe_layer * NEXP + e) * DM * DFE;
        CVT_SET(src + tile * 128 + (p & 127), DFE, ws + WS_W13E + (size_t)e * 7168 * DM, DM, n0, kb * 64); d.sn = W13E_SC; d.f8 = 1; return; } r -= I_M13;
    { const int e = r / (56 * 32), q = r % (56 * 32), kb = q / 32, nb = q % 32;
        CVT_SET(GP(const float, moe_w2) + ((size_t)moe_layer * NEXP + e) * DFE * DM + nb * 32, DM, ws + WS_W2E + (size_t)e * DM * DFE, DFE, nb * 32, kb * 64); d.sn = W2E_SC; d.f8 = 1; }
#undef CVT_SET
}
__device__ __forceinline__ void p0_convert(Frame& F0, bool moe_only, int moe_layer) {
    Frame F = mkframe(F0);
    LAS float* scr = (LAS float*)(F.lds + F.wave * 16384);
    unsigned char* ws = WSP();
    constexpr int I_WIN = 4 * 16 * 384, I_UQ = 4 * 12 * 48, I_UKV = 4 * 8 * 64, I_BM = 4 * 16 * 32, I_BD = 4 * 8 * 32, I_BR = 4 * 16 * 32, I_WO = 4 * 16 * 32;
    constexpr int I_F13 = 2 * 16 * 176, I_F2 = 2 * 44 * 32, I_M13 = 8 * 16 * 224, I_M2 = 8 * 56 * 32;
    constexpr int I_ALL = I_WIN + I_UQ + I_UKV + I_BM + I_BD + I_BR + I_WO + I_F13 + I_F2;
    const int total = moe_only ? (I_M13 + I_M2) : (I_ALL + I_M13 + I_M2);
    int it = F.gw;
    if (it < total) {
        CvtDesc dc; float v[32];
        cvt_decode(F, ws, it, moe_only, moe_layer, dc); cvt_load(dc, v, F.lane);
#pragma unroll 1
        for (;;) {
            const int itn = it + F.ngw; const bool hn = itn < total;
            CvtDesc dn; float vn[32];
            if (hn) { cvt_decode(F, ws, itn, moe_only, moe_layer, dn); cvt_load(dn, vn, F.lane); }
            cvt_store(dc, v, scr, F.lane);
            if (!hn) break;
            dc = dn; it = itn;
#pragma unroll
            for (int i = 0; i < 32; ++i) v[i] = vn[i];
        }
    }
    __syncthreads();
}
__device__ __forceinline__ void p0_tables(Frame& F0) {
    Frame F = mkframe(F0);
    unsigned* csT = (unsigned*)(WSP() + WS_COS);
    { const float* xf = GP(const float, x); bf16_t* xb = (bf16_t*)(WSP() + WS_X);
      for (size_t i = (size_t)blockIdx.x * 512 + F.tid; i < (size_t)T * DM / 8; i += (size_t)F.G * 512) {
          const f32x4 a = *((const f32x4*)xf + 2 * i), b = *((const f32x4*)xf + 2 * i + 1); *((u32x4*)xb + i) = pack8(a, b); } }
    const int* pos = GP(const int, positions);
    for (int i = blockIdx.x * 512 + F.tid; i < T * 32; i += F.G * 512) {
        const int t = i >> 5, f = i & 31;
        const double rev = (double)pos[t] * ((const volatile LAS double*)(F.lds + LDS_PTRS + (int)__builtin_offsetof(Params, inv_freq)))[f] * 0.15915494309189533577;
        const double fr = rev - __builtin_rint(rev);
        csT[i] = pk2(__builtin_amdgcn_cosf((float)fr), __builtin_amdgcn_sinf((float)fr));
    }
    float* modp = (float*)(WSP() + WS_MODP);
    LAS float* cact = (LAS float*)F.lds;
    { const float* cp = GP(const float, c); for (int i = F.tid; i < 8 * DM; i += 512) cact[i] = fsilu(cp[i]); }
    __syncthreads();
    for (int it = F.gw; it < 4 * 96 * 16; it += F.ngw) {
        const int sl = it & 15, cg = (it >> 4) % 96, l = it / (16 * 96);
        const int n = cg * 64 + F.lane;
        float acc[8];
#pragma unroll
        for (int b = 0; b < 8; ++b) acc[b] = 0.f;
        const float* w = GP(const float, ada_w) + (size_t)l * DM * 6144 + n + (size_t)sl * 64 * 6144;
#pragma unroll 1
        for (int k8 = 0; k8 < 8; ++k8) {
            float wv[8];
#pragma unroll
            for (int q = 0; q < 8; ++q) wv[q] = __builtin_nontemporal_load(w + (size_t)(k8 * 8 + q) * 6144);
#pragma unroll
            for (int q = 0; q < 8; ++q)
#pragma unroll
                for (int b = 0; b < 8; ++b) acc[b] += cact[b * DM + sl * 64 + k8 * 8 + q] * wv[q];
        }
#pragma unroll
        for (int b = 0; b < 8; ++b) modp[(((size_t)sl * 4 + l) * 8 + b) * 6144 + n] = acc[b];
    }
    __syncthreads();
}
__device__ __forceinline__ void p0_modreduce(Frame& F0) {
    Frame F = mkframe(F0);
    const float* modp = (const float*)(WSP() + WS_MODP); float* mod = (float*)(WSP() + WS_MOD);
    for (int i = blockIdx.x * 512 + F.tid; i < 4 * 8 * 6144; i += F.G * 512) {
        const int n = i % 6144, l = i / (8 * 6144);
        float s = GP(const float, ada_b)[l * 6144 + n];
        for (int sl = 0; sl < 16; ++sl) s += modp[(size_t)sl * 4 * 8 * 6144 + i];
        mod[i] = s;
    }
}

__device__ __forceinline__ void unpack8(const u32x4 w, f32x4& a, f32x4& b) {
    a = (f32x4){bf2f(w.x & 0xffffu), bf2f(w.x >> 16), bf2f(w.y & 0xffffu), bf2f(w.y >> 16)}; b = (f32x4){bf2f(w.z & 0xffffu), bf2f(w.z >> 16), bf2f(w.w & 0xffffu), bf2f(w.w >> 16)}; }
template <bool COMBINE, bool ROUTER, bool FINAL, bool H8>
__device__ __forceinline__ void phase_norm(Frame& F0, float* fout, const float* gvec, const float* scale, const float* shift, const float* gate2,
                                           const float* wr) {
    Frame F = mkframe(F0);
    bf16_t* H = (bf16_t*)(WSP() + WS_H); bf16_t* X = (bf16_t*)(WSP() + WS_X);
    int* moei = (int*)(WSP() + WS_MOEI);
    const bf16_t* YB = (const bf16_t*)(WSP() + WS_YB); const bf16_t* YB2 = (const bf16_t*)(WSP() + WS_XG); float* ssq2 = (float*)(WSP() + WS_SSQ);
    (void)ssq2;
#define NIDX(j) (2 * F.lane + 128 * ((j) >> 1) + ((j) & 1))
    for (int ch = F.gw; ch < T / 8; ch += F.ngw) {
        const int b = (ch * 8) >> 11;
        int cnt[8];
#pragma unroll
        for (int e = 0; e < 8; ++e) cnt[e] = 0;
        f32x4 gs[4], sh[4], g2[4];
#pragma unroll
        for (int j = 0; j < 4; ++j) {
            const f32x4 g = *((const f32x4*)gvec + NIDX(j));
            if (FINAL) { gs[j] = g; sh[j] = (f32x4){0.f, 0.f, 0.f, 0.f}; }
            else { const f32x4 sc = *((const f32x4*)(scale + (size_t)b * 6144) + NIDX(j)); sh[j] = *((const f32x4*)(shift + (size_t)b * 6144) + NIDX(j)); gs[j] = g * (1.0f + sc); }
            if (COMBINE) g2[j] = *((const f32x4*)(gate2 + (size_t)b * 6144) + NIDX(j));
        }
        constexpr int RF = COMBINE ? 4 : 8;
        for (int half = 0; half < 8 / RF; ++half) {
            const int row0 = ch * 8 + half * RF;
            f32x4 v[RF][4];
#pragma unroll
            for (int r = 0; r < RF; ++r)
#pragma unroll
                for (int c = 0; c < 2; ++c) unpack8(*((const u32x4*)(X + (size_t)(row0 + r) * DM) + F.lane + 64 * c), v[r][2 * c], v[r][2 * c + 1]);
            if (COMBINE) {
                u32x4 ya[RF][2], yc[RF][2]; float w0[RF], w1[RF]; int pp[RF][2];
#pragma unroll
                for (int r = 0; r < RF; ++r) {
                    pp[r][0] = moei[MI_TOKP + 2 * (row0 + r)]; pp[r][1] = moei[MI_TOKP + 2 * (row0 + r) + 1];
                    w0[r] = __int_as_float(moei[MI_TOKW + 2 * (row0 + r)]); w1[r] = __int_as_float(moei[MI_TOKW + 2 * (row0 + r) + 1]); }
#pragma unroll
                for (int r = 0; r < RF; ++r)
#pragma unroll
                    for (int c = 0; c < 2; ++c) { ya[r][c] = *((const u32x4*)(YB + (size_t)pp[r][0] * DM) + F.lane + 64 * c); yc[r][c] = *((const u32x4*)(YB + (size_t)pp[r][1] * DM) + F.lane + 64 * c); }
                bool anyt = false;
#pragma unroll
                for (int r = 0; r < RF; ++r) anyt = anyt || (pp[r][0] >= MOE_MAIN_BLK * 256) || (pp[r][1] >= MOE_MAIN_BLK * 256);
                if (anyt) {
#pragma unroll
                    for (int r = 0; r < RF; ++r)
#pragma unroll
                        for (int q = 0; q < 2; ++q) {
                            if (pp[r][q] >= MOE_MAIN_BLK * 256) {
#pragma unroll
                                for (int c = 0; c < 2; ++c) { f32x4 s0 = {0.f, 0.f, 0.f, 0.f}, s1 = s0;
#pragma unroll
                                    for (int k = 0; k < pg8::KT_SPLIT; ++k) { f32x4 a0, a1; unpack8(*((const u32x4*)(YB2 + ((size_t)k * MOE_TAIL_ROWS + (pp[r][q] - MOE_MAIN_BLK * 256)) * DM) + F.lane + 64 * c), a0, a1); s0 += a0; s1 += a1; }
                                    if (q == 0) ya[r][c] = pack8(s0, s1); else yc[r][c] = pack8(s0, s1); } } }
                }
#pragma unroll
                for (int r = 0; r < RF; ++r)
#pragma unroll
                    for (int c = 0; c < 2; ++c) {
                        f32x4 a0, a1, c0, c1; unpack8(ya[r][c], a0, a1); unpack8(yc[r][c], c0, c1);
                        v[r][2 * c] = v[r][2 * c] + g2[2 * c] * (w0[r] * a0 + w1[r] * c0);
                        v[r][2 * c + 1] = v[r][2 * c + 1] + g2[2 * c + 1] * (w0[r] * a1 + w1[r] * c1);
                        if (!FINAL) *((u32x4*)(X + (size_t)(row0 + r) * DM) + F.lane + 64 * c) = pack8(v[r][2 * c], v[r][2 * c + 1]);
                    }
            }
#pragma unroll
            for (int r = 0; r < RF; ++r) {
                const int row = row0 + r;
                float s = 0.f;
#pragma unroll
                for (int j = 0; j < 4; ++j) s += (v[r][j][0] * v[r][j][0] + v[r][j][1] * v[r][j][1]) + (v[r][j][2] * v[r][j][2] + v[r][j][3] * v[r][j][3]);
                const float rs = __builtin_amdgcn_rsqf(wave_sum(s) * (1.0f / DM) + EPS);
                if (FINAL) {
#pragma unroll
                    for (int j = 0; j < 4; ++j) *((f32x4*)(fout + (size_t)row * DM) + NIDX(j)) = v[r][j] * rs * gs[j];
                    continue;
                }
                f32x4 h[4];
#pragma unroll
                for (int j = 0; j < 4; ++j) h[j] = v[r][j] * rs * gs[j] + sh[j];
#pragma unroll
                for (int c = 0; c < 2; ++c) {
                    if (H8) { u32x2 o; o.x = pk4_fp8(h[2 * c][0], h[2 * c][1], h[2 * c][2], h[2 * c][3]); o.y = pk4_fp8(h[2 * c + 1][0], h[2 * c + 1][1], h[2 * c + 1][2], h[2 * c + 1][3]);
                        *((u32x2*)((unsigned char*)H + (size_t)row * DM) + F.lane + 64 * c) = o; }
                    else *((u32x4*)(H + (size_t)row * DM) + F.lane + 64 * c) = pack8(h[2 * c], h[2 * c + 1]);
                }
                if (ROUTER) {
                    float lg[8];
#pragma unroll
                    for (int e = 0; e < 8; ++e) lg[e] = 0.f;
#pragma unroll
                    for (int j = 0; j < 4; ++j)
#pragma unroll
                        for (int q = 0; q < 4; ++q) {
                            const int k = 8 * F.lane + 512 * (j >> 1) + 4 * (j & 1) + q;
                            const f32x4 wa = *(const f32x4*)(wr + (size_t)k * 8), wb = *(const f32x4*)(wr + (size_t)k * 8 + 4);
                            const float hv = h[j][q];
                            lg[0] += hv * wa[0]; lg[1] += hv * wa[1]; lg[2] += hv * wa[2]; lg[3] += hv * wa[3];
                            lg[4] += hv * wb[0]; lg[5] += hv * wb[1]; lg[6] += hv * wb[2]; lg[7] += hv * wb[3];
                        }
#pragma unroll
                    for (int e = 0; e < 8; ++e) lg[e] = wave_sum(lg[e]);
                    int e0 = 0; float v0 = lg[0];
#pragma unroll
                    for (int e = 1; e < 8; ++e) if (lg[e] > v0) { v0 = lg[e]; e0 = e; }
                    int e1 = -1; float v1 = -3.0e38f;
#pragma unroll
                    for (int e = 0; e < 8; ++e) if (e != e0 && lg[e] > v1) { v1 = lg[e]; e1 = e; }
                    const float ex = __expf(v1 - v0), w0 = 1.0f / (1.0f + ex), w1 = ex / (1.0f + ex);
                    if (F.lane == 0) { moei[MI_TOKE + 2 * row] = e0; moei[MI_TOKE + 2 * row + 1] = e1; moei[MI_TOKW + 2 * row] = __float_as_int(w0); moei[MI_TOKW + 2 * row + 1] = __float_as_int(w1); }
#pragma unroll
                    for (int e = 0; e < 8; ++e) cnt[e] += (e == e0) + (e == e1);
                }
            }
        }
        if (ROUTER && F.lane == 0) {
#pragma unroll
            for (int e = 0; e < 8; ++e) moei[MI_CNT + ch * 8 + e] = cnt[e];
        }
    }
#undef NIDX
}

__device__ __forceinline__ void phase_moe_gather(Frame& F0) {
    Frame F = mkframe(F0);
    int* moei = (int*)(WSP() + WS_MOEI);
    LAS int* pre = (LAS int*)F.lds;
    LAS int* seg = (LAS int*)(F.lds + 65536);
    LAS int* pst = (LAS int*)(F.lds + 65536 + 4096);
    const int e = F.tid & 7, sg = F.tid >> 3;
    {
        int run = 0;
        for (int i = 0; i < 32; ++i) { const int ch = sg * 32 + i; const int c = moei[MI_CNT + ch * 8 + e]; pre[ch * 8 + e] = run; run += c; }
        seg[sg * 8 + e] = run;
    }
    __syncthreads();
    if (F.tid < 8) {
        int run = 0;
        for (int s = 0; s < 64; ++s) { const int c = seg[s * 8 + F.tid]; seg[s * 8 + F.tid] = run; run += c; }
        seg[64 * 8 + F.tid] = run;
    }
    __syncthreads();
    if (F.tid < 8) {
        const int tot = seg[64 * 8 + F.tid]; const int padded = (tot + 255) & ~255;
        int ps = 0;
        for (int q = 0; q < 8; ++q) { const int pq = __builtin_amdgcn_readlane(padded, q); if (q < F.tid) ps += pq; }
        pst[F.tid] = ps;
        if (blockIdx.x == 0) {
            for (int q = 0; q < (padded >> 8); ++q) moei[MI_BLK + 1 + (ps >> 8) + q] = F.tid;
            if (F.tid == 7) moei[MI_BLK] = (ps + padded) >> 8;
        }
    }
    __syncthreads();
    const unsigned char* H = WSP() + WS_H; unsigned char* XG = WSP() + WS_XG;
    for (int ch = F.gw; ch < T / 8; ch += F.ngw) {
        const int a = F.lane & 15; const int row = ch * 8 + (a >> 1);
        const int ea = moei[MI_TOKE + 2 * row + (a & 1)];
        int rank = 0;
        for (int q = 0; q < 16; ++q) { const int eq = __builtin_amdgcn_readlane(ea, q); if (q < a && eq == ea) ++rank; }
        const int dest = pst[ea] + seg[(ch >> 5) * 8 + ea] + pre[ch * 8 + ea] + rank;
        if (F.lane < 16) moei[MI_TOKP + 2 * row + (a & 1)] = dest;
        for (int q = 0; q < 16; ++q) {
            const int dq = __builtin_amdgcn_readlane(dest, q); const int rq = ch * 8 + (q >> 1);
            *(u32x4*)(XG + (size_t)dq * DM + 16 * F.lane) = *(const u32x4*)(H + (size_t)rq * DM + 16 * F.lane);
        }
    }
    __syncthreads();
}

namespace mla {
constexpr int KROW = 400;
constexpr int SHM_K = 64 * KROW, SHM_V = 64 * 128 * 2;
constexpr int OFF_V = 0, OFF_K = 2 * SHM_V, OFF_WS = 2 * SHM_V + 2 * SHM_K;
__device__ __forceinline__ int crow(int r, int hi) { return (r & 3) + 8 * (r >> 2) + 4 * hi; }
__device__ __forceinline__ int v_st(int k, int c) { const int kk = (k & ~0xC) | ((k & 4) << 1) | ((k & 8) >> 1); return ((kk >> 3) * 4 + (c >> 5)) * 512 + ((kk & 7) * 32 + (c & 31)) * 2; }
__device__ __forceinline__ int v_rd_base(int lane) { return ((lane & 3) << 3) | (((lane >> 2) & 3) << 6) | (((lane >> 4) & 1) << 5) | (((lane >> 5) & 1) << 8); }
constexpr int v_rd_off(int d0, int ks, int half) { return d0 * 512 + ks * 4096 + half * 2048; }
template <int OFF> __device__ __forceinline__ s16x4 tr_read(LAS unsigned char* vb) { return __builtin_amdgcn_ds_read_tr16_b64_v4i16((LAS s16x4*)(vb + OFF)); }
template <int D0> __device__ __forceinline__ void pv_one(f32x16& od, LAS unsigned char* vb, bf16x8 pa0, bf16x8 pa1, bf16x8 pa2, bf16x8 pa3) {
    const s16x4 l0 = tr_read<v_rd_off(D0, 0, 0)>(vb), h0 = tr_read<v_rd_off(D0, 0, 1)>(vb), l1 = tr_read<v_rd_off(D0, 1, 0)>(vb), h1 = tr_read<v_rd_off(D0, 1, 1)>(vb);
    const s16x4 l2 = tr_read<v_rd_off(D0, 2, 0)>(vb), h2 = tr_read<v_rd_off(D0, 2, 1)>(vb), l3 = tr_read<v_rd_off(D0, 3, 0)>(vb), h3 = tr_read<v_rd_off(D0, 3, 1)>(vb);
#define PK(L, H) (bf16x8){L[0], L[1], L[2], L[3], H[0], H[1], H[2], H[3]}
    od = __builtin_amdgcn_mfma_f32_32x32x16_bf16(pa0, PK(l0, h0), od, 0, 0, 0);
    od = __builtin_amdgcn_mfma_f32_32x32x16_bf16(pa1, PK(l1, h1), od, 0, 0, 0);
    od = __builtin_amdgcn_mfma_f32_32x32x16_bf16(pa2, PK(l2, h2), od, 0, 0, 0);
    od = __builtin_amdgcn_mfma_f32_32x32x16_bf16(pa3, PK(l3, h3), od, 0, 0, 0);
#undef PK
}
template <int D0> __device__ __forceinline__ void pv_load(s16x4 (&v)[8], LAS unsigned char* vb) {
    v[0] = tr_read<v_rd_off(D0, 0, 0)>(vb); v[1] = tr_read<v_rd_off(D0, 0, 1)>(vb); v[2] = tr_read<v_rd_off(D0, 1, 0)>(vb); v[3] = tr_read<v_rd_off(D0, 1, 1)>(vb);
    v[4] = tr_read<v_rd_off(D0, 2, 0)>(vb); v[5] = tr_read<v_rd_off(D0, 2, 1)>(vb); v[6] = tr_read<v_rd_off(D0, 3, 0)>(vb); v[7] = tr_read<v_rd_off(D0, 3, 1)>(vb); }
__device__ __forceinline__ void pv_mma(f32x16& od, const s16x4 (&v)[8], bf16x8 pa0, bf16x8 pa1, bf16x8 pa2, bf16x8 pa3) {
#define PK(L, H) (bf16x8){L[0], L[1], L[2], L[3], H[0], H[1], H[2], H[3]}
    od = __builtin_amdgcn_mfma_f32_32x32x16_bf16(pa0, PK(v[0], v[1]), od, 0, 0, 0);
    od = __builtin_amdgcn_mfma_f32_32x32x16_bf16(pa1, PK(v[2], v[3]), od, 0, 0, 0);
    od = __builtin_amdgcn_mfma_f32_32x32x16_bf16(pa2, PK(v[4], v[5]), od, 0, 0, 0);
    od = __builtin_amdgcn_mfma_f32_32x32x16_bf16(pa3, PK(v[6], v[7]), od, 0, 0, 0);
#undef PK
}
constexpr int G_V = 0, G_KN = 16384, G_KR = 32768, G_SLOT = 40960, G_WS = 2 * G_SLOT;
__device__ __forceinline__ void unit(const bf16_t* Qb, const bf16_t* Kn, const bf16_t* Kr, const bf16_t* Vh, bf16_t* Ob, LAS unsigned char* lds, int tid) {
    const int wid = __builtin_amdgcn_readfirstlane(tid >> 6), lane = tid & 63, r32 = lane & 31, hi = lane >> 5;
    LAS float* wsf = (LAS float*)(lds + G_WS) + wid * 64; LAS float* li_l = wsf; LAS float* al_l = wsf + 32;
    float m_reg = -1e30f, l_reg = 0.f; f32x16 o[4];
#pragma unroll
    for (int d = 0; d < 4; ++d)
#pragma unroll
        for (int r = 0; r < 16; ++r) o[d][r] = 0.f;
    bf16x8 qr[12];
    const bf16_t* Qw = Qb + (size_t)(wid * 32 + r32) * QW + hi * 8;
#pragma unroll
    for (int d0 = 0; d0 < 12; ++d0) qr[d0] = *(const bf16x8*)(Qw + d0 * 16);
    unsigned okn[2], ov[2], okr;
#pragma unroll
    for (int i = 0; i < 2; ++i) { const int p = wid + 8 * i;
        { const int row = 4 * p + (lane >> 4), c = (lane & 15) ^ (row & 15); okn[i] = (unsigned)(row * KVW * 2 + c * 16); }
        { const int d = p * 1024 + lane * 16, sub = d >> 9, within = d & 511, kk = (sub >> 2) * 8 + (within >> 6), col = (sub & 3) * 32 + ((within & 63) >> 4) * 8;
          const int k = (kk & ~0xC) | ((kk & 4) << 1) | ((kk & 8) >> 1); ov[i] = (unsigned)(k * KVW * 2 + col * 2); } }
    { const int row = 8 * wid + (lane >> 3), c = (lane & 7) ^ ((row >> 1) & 7); okr = (unsigned)(row * ROPE_W * 2 + c * 16); }
#define MLA_DMA(gp, off, ldsoff) asm volatile("s_mov_b32 m0, %0\n\ts_nop 0\n\tglobal_load_lds_dwordx4 %1, %2" :: "s"(ldsb + (unsigned)(ldsoff)), "v"(off), "s"(gp) : "memory", "m0")
#define MLA_GLDS(k0, s) do { const char* kn_ = (const char*)Kn + (size_t)(k0) * KVW * 2; const char* v_ = (const char*)Vh + (size_t)(k0) * KVW * 2; const char* kr_ = (const char*)Kr + (size_t)(k0) * ROPE_W * 2; \
        const unsigned sb_ = (unsigned)((s) * G_SLOT) + (unsigned)wid * 1024u; \
        MLA_DMA(kn_, okn[0], sb_ + G_KN); MLA_DMA(kn_, okn[1], sb_ + G_KN + 8192); MLA_DMA(kr_, okr, sb_ + G_KR); MLA_DMA(v_, ov[0], sb_ + G_V); MLA_DMA(v_, ov[1], sb_ + G_V + 8192); } while (0)
    const unsigned ldsb = (unsigned)(__SIZE_TYPE__)lds;
    const int vrb = v_rd_base(lane);
    const int knx = (r32 & 15) << 4, krx = ((r32 >> 1) & 7) << 4;
    constexpr int NT = SEQ / 64;
    MLA_GLDS(0, 0);
    asm volatile("s_waitcnt vmcnt(0)" ::: "memory"); __syncthreads();
    for (int j = 0; j < NT; ++j) {
        const int bsel = j & 1;
        if (j + 1 < NT) MLA_GLDS((j + 1) * 64, bsel ^ 1);
        LAS unsigned char* sb = lds + bsel * G_SLOT;
        f32x16 p0, p1;
#pragma unroll
        for (int r = 0; r < 16; ++r) { p0[r] = 0.f; p1[r] = 0.f; }
        bf16x8 kb0[2], kb1[2];
#define MLA_KLD(d0_, s_) do { if ((d0_) < 8) { const int cb = (((d0_) * 2 + hi) << 4) ^ knx; kb0[s_] = *(const LAS bf16x8*)(sb + G_KN + r32 * 256 + cb); kb1[s_] = *(const LAS bf16x8*)(sb + G_KN + (32 + r32) * 256 + cb); } \
            else { const int cb = ((((d0_) - 8) * 2 + hi) << 4) ^ krx; kb0[s_] = *(const LAS bf16x8*)(sb + G_KR + r32 * 128 + cb); kb1[s_] = *(const LAS bf16x8*)(sb + G_KR + (32 + r32) * 128 + cb); } } while (0)
        MLA_KLD(0, 0);
#pragma unroll
        for (int d0 = 0; d0 < 12; ++d0) {
            if (d0 + 1 < 12) MLA_KLD(d0 + 1, (d0 + 1) & 1);
            __builtin_amdgcn_sched_barrier(0);
            p0 = __builtin_amdgcn_mfma_f32_32x32x16_bf16(kb0[d0 & 1], qr[d0], p0, 0, 0, 0);
            p1 = __builtin_amdgcn_mfma_f32_32x32x16_bf16(kb1[d0 & 1], qr[d0], p1, 0, 0, 0);
            __builtin_amdgcn_sched_barrier(0);
        }
#undef MLA_KLD
        float pmax = p0[0];
#pragma unroll
        for (int r = 1; r < 16; ++r) pmax = fmaxf(pmax, p0[r]);
#pragma unroll
        for (int r = 0; r < 16; ++r) pmax = fmaxf(pmax, p1[r]);
        { auto sw = __builtin_amdgcn_permlane32_swap(__float_as_uint(pmax), __float_as_uint(pmax), false, false); pmax = fmaxf(__uint_as_float(sw[0]), __uint_as_float(sw[1])); }
        float alpha = 1.f;
        if (!__all(pmax - m_reg <= 11.0f)) { const float mn = fmaxf(m_reg, pmax); alpha = __builtin_amdgcn_exp2f(m_reg - mn); m_reg = mn; }
#pragma unroll
        for (int r = 0; r < 16; ++r) { p0[r] = __builtin_amdgcn_exp2f(p0[r] - m_reg); p1[r] = __builtin_amdgcn_exp2f(p1[r] - m_reg); }
        float ps = 0.f;
#pragma unroll
        for (int r = 0; r < 16; ++r) ps += p0[r];
#pragma unroll
        for (int r = 0; r < 16; ++r) ps += p1[r];
        { auto sw = __builtin_amdgcn_permlane32_swap(__float_as_uint(ps), __float_as_uint(ps), false, false); ps = __uint_as_float(sw[0]) + __uint_as_float(sw[1]); }
        l_reg = l_reg * alpha + ps;
        if (__any(alpha < 1.f)) {
            if (hi == 0) al_l[r32] = alpha;
            asm volatile("s_waitcnt lgkmcnt(0)" ::: "memory");
#pragma unroll
            for (int r = 0; r < 16; ++r) { const float al = al_l[crow(r, hi)];
#pragma unroll
                for (int d = 0; d < 4; ++d) o[d][r] *= al; }
        }
        bf16x8 pa0, pa1, pa2, pa3;
#define PK4(P_, BASE, OUT) do { unsigned a0 = pk2(P_[BASE + 0], P_[BASE + 1]), a1 = pk2(P_[BASE + 2], P_[BASE + 3]); \
    unsigned b0 = pk2(P_[BASE + 4], P_[BASE + 5]), b1 = pk2(P_[BASE + 6], P_[BASE + 7]); \
    auto r0 = __builtin_amdgcn_permlane32_swap(a0, b0, false, false); auto r1 = __builtin_amdgcn_permlane32_swap(a1, b1, false, false); \
    u32x4 w = {r0[0], r1[0], r0[1], r1[1]}; OUT = *reinterpret_cast<bf16x8*>(&w); } while (0)
        PK4(p0, 0, pa0); PK4(p0, 8, pa1); PK4(p1, 0, pa2); PK4(p1, 8, pa3);
#undef PK4
        LAS unsigned char* vb = sb + G_V + vrb;
        {
            s16x4 vf[2][8];
            pv_load<0>(vf[0], vb);
            __builtin_amdgcn_sched_barrier(0);
            pv_load<1>(vf[1], vb); __builtin_amdgcn_sched_barrier(0); pv_mma(o[0], vf[0], pa0, pa1, pa2, pa3); __builtin_amdgcn_sched_barrier(0);
            pv_load<2>(vf[0], vb); __builtin_amdgcn_sched_barrier(0); pv_mma(o[1], vf[1], pa0, pa1, pa2, pa3); __builtin_amdgcn_sched_barrier(0);
            pv_load<3>(vf[1], vb); __builtin_amdgcn_sched_barrier(0); pv_mma(o[2], vf[0], pa0, pa1, pa2, pa3); __builtin_amdgcn_sched_barrier(0);
            pv_mma(o[3], vf[1], pa0, pa1, pa2, pa3);
        }
        asm volatile("s_waitcnt vmcnt(0)" ::: "memory");
        __syncthreads();
    }
    if (hi == 0) li_l[r32] = l_reg;
    asm volatile("s_waitcnt lgkmcnt(0)" ::: "memory");
    bf16_t* Ow = Ob + (size_t)(wid * 32) * DM;
#pragma unroll
    for (int r = 0; r < 16; ++r) { const int orow = crow(r, hi); const float rl = 1.0f / li_l[orow];
#pragma unroll
        for (int d0 = 0; d0 < 4; ++d0) Ow[(size_t)orow * DM + d0 * 32 + r32] = (bf16_t)f2bf(o[d0][r] * rl); }
    __syncthreads();
#undef MLA_GLDS
#undef MLA_DMA
}
}
__device__ __forceinline__ void phase_mla(Frame& F0) {
    Frame F = mkframe(F0);
    const bf16_t* Q = (const bf16_t*)(WSP() + WS_Q); const bf16_t* KV = (const bf16_t*)(WSP() + WS_KV); const bf16_t* RP = (const bf16_t*)(WSP() + WS_ROPE);
    bf16_t* Y = (bf16_t*)(WSP() + WS_YMLA);
    for (int u = blockIdx.x; u < 512; u += F.G) {
        const int qb = u & 7, h = (u >> 3) & 7, b = u >> 6;
        const size_t t0 = (size_t)b * SEQ;
        mla::unit(Q + (t0 + qb * 256) * QW + h * 192, KV + t0 * KVW + h * 256, RP + t0 * ROPE_W + RS_KR * 64, KV + t0 * KVW + h * 256 + 128,
                  Y + (t0 + qb * 256) * DM + h * 128, F.lds, F.tid);
    }
}

__device__ __forceinline__ void phase_dilated(Frame& F0) {
    Frame F = mkframe(F0);
    const bf16_t* RP = (const bf16_t*)(WSP() + WS_ROPE); const bf16_t* PL = (const bf16_t*)(WSP() + WS_PLAIN);
    bf16_t* DO = (bf16_t*)(WSP() + WS_DILO); float* LSE = (float*)(WSP() + WS_LSE);
    constexpr int LD = 72;
    const int slot = F.wave >> 2, qt = F.wave & 3, tt = F.tid & 255, g4 = F.lane >> 4, l15 = F.lane & 15;
    LAS bf16_t* Kl = (LAS bf16_t*)(F.lds + slot * 55296); LAS bf16_t* Vl = Kl + 192 * LD;
    int p_lo, p_hi, p_st;
    if (F.G == 256) { const int c = blockIdx.x; constexpr int PA = 20, PB = 24 - PA; if (c < 128) { p_lo = c * PA; p_hi = p_lo + PA; } else { p_lo = 128 * PA + (c - 128) * PB; p_hi = p_lo + PB; } p_st = 1; }
    else { p_lo = blockIdx.x; p_hi = 3072; p_st = F.G; }
    bf16x8 kreg[6], vreg[6];
#define DIL_DECODE(pair_) const int it = (pair_) * 2 + slot; const int b = it / 768, rem = it % 768, g = rem >> 8, hh = (rem >> 5) & 7, blk = rem & 31; \
        const int sh = 2 * g, nbk = 32 >> sh, L = SEQ >> sh; const int r = blk / nbk, n = blk % nbk;
#define DIL_LOAD(pair_) do { DIL_DECODE(pair_) \
        _Pragma("unroll") for (int q = 0; q < 6; ++q) { const int ci = tt + 256 * q, c = ci >> 3, col8 = (ci & 7) * 8; \
            const int jk = (n - 1) * 64 + c; const bool ok = (jk >= 0) && (jk < L); \
            kreg[q] = (bf16x8){0, 0, 0, 0, 0, 0, 0, 0}; vreg[q] = (bf16x8){0, 0, 0, 0, 0, 0, 0, 0}; \
            if (ok) { const size_t tok = (size_t)b * SEQ + ((size_t)jk << sh) + r; \
                kreg[q] = *(const bf16x8*)(RP + tok * ROPE_W + (RS_DK + g * 8 + hh) * 64 + col8); \
                vreg[q] = *(const bf16x8*)(PL + tok * PLAIN_W + PC_DV + (g * 8 + hh) * 64 + col8); } } } while (0)
    if (p_lo < p_hi) DIL_LOAD(p_lo);
    for (int pair = p_lo; pair < p_hi; pair += p_st) {
        DIL_DECODE(pair)
#pragma unroll
        for (int q = 0; q < 6; ++q) { const int ci = tt + 256 * q, c = ci >> 3, col8 = (ci & 7) * 8;
            *(LAS bf16x8*)(Kl + c * LD + col8) = kreg[q]; *(LAS bf16x8*)(Vl + c * LD + col8) = vreg[q]; }
        __syncthreads();
        if (pair + p_st < p_hi) DIL_LOAD(pair + p_st);
        const int iq = qt * 16 + l15;
        const size_t tokq = (size_t)b * SEQ + ((size_t)(n * 64 + iq) << sh) + r;
        bf16x8 qf[2];
#pragma unroll
        for (int ks = 0; ks < 2; ++ks) qf[ks] = *(const bf16x8*)(RP + tokq * ROPE_W + (RS_DQ + g * 8 + hh) * 64 + ks * 32 + 8 * g4);
        f32x4 s[9];
        const float NEG = __int_as_float(opaque((int)0xf149f2ca));
        LAS bf16_t* Kq = Kl + (16 * qt) * LD; LAS bf16_t* Vq = Vl + (16 * qt) * LD;
        {
            bf16x8 kfa[9][2];
#pragma unroll
            for (int ct = 0; ct < 9; ++ct)
#pragma unroll
                for (int ks = 0; ks < 2; ++ks) kfa[ct][ks] = *(const LAS bf16x8*)(Kq + (16 * ct + l15) * LD + ks * 32 + 8 * g4);
            __builtin_amdgcn_sched_barrier(0);
#pragma unroll
            for (int ct = 0; ct < 9; ++ct) { s[ct] = (f32x4){0.f, 0.f, 0.f, 0.f};
#pragma unroll
                for (int ks = 0; ks < 2; ++ks) s[ct] = __builtin_amdgcn_mfma_f32_16x16x32_bf16(kfa[ct][ks], qf[ks], s[ct], 0, 0, 0); }
            __builtin_amdgcn_sched_barrier(0);
        }
#pragma unroll
        for (int rg = 0; rg < 4; ++rg) { const int e = 4 * g4 + rg; s[0][rg] = (e >= l15) ? s[0][rg] : NEG; s[8][rg] = (e <= l15) ? s[8][rg] : NEG; }
        if (n == 0) {
#pragma unroll
            for (int ct = 0; ct < 9; ++ct)
#pragma unroll
                for (int rg = 0; rg < 4; ++rg) { const int c = 16 * (qt + ct) + 4 * g4 + rg; s[ct][rg] = (c >= 64) ? s[ct][rg] : NEG; }
        }
        if (n == nbk - 1) {
#pragma unroll
            for (int ct = 0; ct < 9; ++ct)
#pragma unroll
                for (int rg = 0; rg < 4; ++rg) { const int c = 16 * (qt + ct) + 4 * g4 + rg; s[ct][rg] = (c < 128) ? s[ct][rg] : NEG; }
        }
        float mx = NEG;
#pragma unroll
        for (int ct = 0; ct < 9; ++ct)
#pragma unroll
            for (int rg = 0; rg < 4; ++rg) mx = fmaxf(mx, s[ct][rg]);
        mx = max_x32(max_x16(mx));
        float sum = 0.f;
#pragma unroll
        for (int ct = 0; ct < 9; ++ct)
#pragma unroll
            for (int rg = 0; rg < 4; ++rg) { const float pv = __builtin_amdgcn_exp2f((s[ct][rg] - mx) * 1.4426950408889634f); s[ct][rg] = pv; sum += pv; }
        sum = sum_x32(sum_x16(sum));
        const float inv = __builtin_amdgcn_rcpf(sum);
        f32x4 o[4];
#pragma unroll
        for (int dt = 0; dt < 4; ++dt) o[dt] = (f32x4){0.f, 0.f, 0.f, 0.f};
        bf16x8 pfa[5];
#pragma unroll
        for (int s2 = 0; s2 < 5; ++s2) {
            const int ta = (s2 < 4) ? 2 * s2 : 7, tb = ta + 1;
            u32x4 pw; pw.x = (s2 < 4) ? pk2(s[ta][0], s[ta][1]) : 0u; pw.y = (s2 < 4) ? pk2(s[ta][2], s[ta][3]) : 0u; pw.z = pk2(s[tb][0], s[tb][1]); pw.w = pk2(s[tb][2], s[tb][3]);
            pfa[s2] = *reinterpret_cast<bf16x8*>(&pw); }
#pragma unroll
        for (int dh = 0; dh < 2; ++dh) {
            s16x4 vlo[5][2], vhi[5][2];
#pragma unroll
            for (int s2 = 0; s2 < 5; ++s2)
#pragma unroll
                for (int d2 = 0; d2 < 2; ++d2) { const int ta = (s2 < 4) ? 2 * s2 : 7, dt = 2 * dh + d2;
                    LAS bf16_t* va = Vq + (16 * ta + 4 * g4 + ((F.lane >> 2) & 3)) * LD + 16 * dt + 4 * (F.lane & 3);
                    vlo[s2][d2] = __builtin_amdgcn_ds_read_tr16_b64_v4i16((LAS s16x4*)va); vhi[s2][d2] = __builtin_amdgcn_ds_read_tr16_b64_v4i16((LAS s16x4*)(va + 16 * LD)); }
            __builtin_amdgcn_sched_barrier(0);
#pragma unroll
            for (int s2 = 0; s2 < 5; ++s2)
#pragma unroll
                for (int d2 = 0; d2 < 2; ++d2) { const s16x4 lo = vlo[s2][d2], hi = vhi[s2][d2];
                    const bf16x8 vf = {lo[0], lo[1], lo[2], lo[3], hi[0], hi[1], hi[2], hi[3]};
                    o[2 * dh + d2] = __builtin_amdgcn_mfma_f32_16x16x32_bf16(vf, pfa[s2], o[2 * dh + d2], 0, 0, 0); }
            __builtin_amdgcn_sched_barrier(0);
        }
        bf16_t* dst = DO + ((size_t)g * T + tokq) * 512 + hh * 64 + 4 * g4;
#pragma unroll
        for (int dt = 0; dt < 4; ++dt) { u32x2 w; w.x = pk2(o[dt][0] * inv, o[dt][1] * inv); w.y = pk2(o[dt][2] * inv, o[dt][3] * inv); *(u32x2*)(dst + 16 * dt) = w; }
        if (g4 == 0) LSE[((size_t)g * T + tokq) * 8 + hh] = mx + __logf(sum);
        __syncthreads();
    }
#undef DIL_DECODE
#undef DIL_LOAD
}
__device__ __forceinline__ void phase_dil_merge(Frame& F0) {
    Frame F = mkframe(F0);
    const bf16_t* DO = (const bf16_t*)(WSP() + WS_DILO); const float* LSE = (const float*)(WSP() + WS_LSE); bf16_t* Y = (bf16_t*)(WSP() + WS_YDIL);
    const int hh = F.lane >> 3;
    for (int t0 = F.gw; t0 < T; t0 += 4 * F.ngw) {
        float l[4][3]; u32x4 v[4][3];
#pragma unroll
        for (int k = 0; k < 4; ++k) { const int t = t0 + k * F.ngw;
#pragma unroll
            for (int g = 0; g < 3; ++g) { l[k][g] = 0.f; v[k][g] = (u32x4){0u, 0u, 0u, 0u};
                if (t < T) { l[k][g] = LSE[((size_t)g * T + t) * 8 + hh]; v[k][g] = *((const u32x4*)(DO + ((size_t)g * T + t) * 512) + F.lane); } } }
#pragma unroll
        for (int k = 0; k < 4; ++k) { const int t = t0 + k * F.ngw; if (t >= T) continue;
            const float m = fmaxf(l[k][0], fmaxf(l[k][1], l[k][2])); const float e0 = __expf(l[k][0] - m), e1 = __expf(l[k][1] - m), e2 = __expf(l[k][2] - m); const float is = __builtin_amdgcn_rcpf(e0 + e1 + e2);
            const float w[3] = {e0 * is, e1 * is, e2 * is};
            float acc[8];
#pragma unroll
            for (int j = 0; j < 8; ++j) acc[j] = 0.f;
#pragma unroll
            for (int g = 0; g < 3; ++g) { const u32x4 q = v[k][g];
                acc[0] += w[g] * bf2f(q.x & 0xffffu); acc[1] += w[g] * bf2f(q.x >> 16); acc[2] += w[g] * bf2f(q.y & 0xffffu); acc[3] += w[g] * bf2f(q.y >> 16);
                acc[4] += w[g] * bf2f(q.z & 0xffffu); acc[5] += w[g] * bf2f(q.z >> 16); acc[6] += w[g] * bf2f(q.w & 0xffffu); acc[7] += w[g] * bf2f(q.w >> 16); }
            u32x4 o; o.x = pk2(acc[0], acc[1]); o.y = pk2(acc[2], acc[3]); o.z = pk2(acc[4], acc[5]); o.w = pk2(acc[6], acc[7]);
            *((u32x4*)(Y + (size_t)t * 512) + F.lane) = o; }
    }
}

__device__ __forceinline__ void phase_retention(Frame& F0, int layer) {
    Frame F = mkframe(F0);
    const bf16_t* RP = (const bf16_t*)(WSP() + WS_ROPE); const bf16_t* PL = (const bf16_t*)(WSP() + WS_PLAIN);
    constexpr int LQ = 72, LV = 136;
    LAS bf16_t* Ql = (LAS bf16_t*)F.lds; LAS bf16_t* Kl = Ql + 128 * LQ; LAS bf16_t* Stl = Kl + 128 * LQ; LAS bf16_t* Vl = Stl + 128 * LQ;
    LAS float* Stf = (LAS float*)(F.lds + 90112);
    const int w = F.wave, g4 = F.lane >> 4, l15 = F.lane & 15;
    const int u0 = (F.G == 256) ? ((int)blockIdx.x - 128) : (int)blockIdx.x;
    for (int u = u0; u >= 0 && u < 128; u += F.G) {
        const int b = u >> 4, hh = (u >> 1) & 7, dir = u & 1;
        const float lg = GP(const float, ret_ld)[(layer * 2 + dir) * 8 + hh];
        bf16_t* YR = (bf16_t*)(WSP() + (dir ? WS_YRB : WS_YRF));
        for (int i = F.tid; i < 128 * LQ / 2; i += 512) ((LAS unsigned*)Stl)[i] = 0u;
        for (int i = F.tid; i < 128 * 64; i += 512) Stf[i] = 0.f;
        const float cdec = __expf(lg * 128.0f), ginv = __expf(-lg);
        bf16x8 rq[2], rk[2], rv[4];
#define RET_LOAD(c_) do { _Pragma("unroll") for (int q = 0; q < 2; ++q) { const int ci = F.tid + 512 * q, i = ci >> 3, col8 = (ci & 7) * 8; \
                const size_t tok = (size_t)b * SEQ + (dir ? (SEQ - 1 - (128 * (c_) + i)) : (128 * (c_) + i)); \
                rq[q] = *(const bf16x8*)(RP + tok * ROPE_W + (RS_RQ + hh) * 64 + col8); rk[q] = *(const bf16x8*)(RP + tok * ROPE_W + (RS_RK + hh) * 64 + col8); } \
            _Pragma("unroll") for (int q = 0; q < 4; ++q) { const int ci = F.tid + 512 * q, i = ci >> 4, col8 = (ci & 15) * 8; \
                const size_t tok = (size_t)b * SEQ + (dir ? (SEQ - 1 - (128 * (c_) + i)) : (128 * (c_) + i)); \
                rv[q] = *(const bf16x8*)(PL + tok * PLAIN_W + PC_RV + hh * 128 + col8); } } while (0)
        RET_LOAD(0);
        for (int c = 0; c < 16; ++c) {
#pragma unroll
            for (int q = 0; q < 2; ++q) { const int ci = F.tid + 512 * q, i = ci >> 3, col8 = (ci & 7) * 8;
                *(LAS bf16x8*)(Ql + i * LQ + col8) = rq[q]; *(LAS bf16x8*)(Kl + i * LQ + col8) = rk[q]; }
#pragma unroll
            for (int q = 0; q < 4; ++q) { const int ci = F.tid + 512 * q, i = ci >> 4, col8 = (ci & 15) * 8;
                *(LAS bf16x8*)(Vl + i * LV + col8) = rv[q]; }
            __syncthreads();
            if (c + 1 < 16) RET_LOAD(c + 1);
            const int iq = 16 * w + l15;
            bf16x8 qf[2];
#pragma unroll
            for (int ks = 0; ks < 2; ++ks) qf[ks] = *(const LAS bf16x8*)(Ql + iq * LQ + ks * 32 + 8 * g4);
            bf16x8 pf[4];
#pragma unroll
            for (int s2 = 0; s2 < 4; ++s2) {
                f32x4 sa[2];
#pragma unroll
                for (int h2 = 0; h2 < 2; ++h2) { const int jt = 2 * s2 + h2; sa[h2] = (f32x4){0.f, 0.f, 0.f, 0.f};
                    if (jt <= w) {
#pragma unroll
                        for (int ks = 0; ks < 2; ++ks) { const bf16x8 kf = *(const LAS bf16x8*)(Kl + (16 * jt + l15) * LQ + ks * 32 + 8 * g4);
                            sa[h2] = __builtin_amdgcn_mfma_f32_16x16x32_bf16(kf, qf[ks], sa[h2], 0, 0, 0); }
#pragma unroll
                        for (int rg = 0; rg < 4; ++rg) { const int j = 16 * jt + 4 * g4 + rg; const int df = iq - j; const bool ok = dir ? (df > 0) : (df >= 0);
                            sa[h2][rg] = ok ? sa[h2][rg] * __expf(lg * (float)df) : 0.f; } } }
                u32x4 pw; pw.x = pk2(sa[0][0], sa[0][1]); pw.y = pk2(sa[0][2], sa[0][3]); pw.z = pk2(sa[1][0], sa[1][1]); pw.w = pk2(sa[1][2], sa[1][3]);
                pf[s2] = *reinterpret_cast<bf16x8*>(&pw);
            }
            const float qd = __expf(lg * (float)(iq + 1));
            const size_t tokq = (size_t)b * SEQ + (dir ? (SEQ - 1 - (128 * c + iq)) : (128 * c + iq));
#pragma unroll 1
            for (int hf = 0; hf < 2; ++hf) {
                f32x4 y[4];
#pragma unroll
                for (int d4 = 0; d4 < 4; ++d4) { const int dvt = hf * 4 + d4; y[d4] = (f32x4){0.f, 0.f, 0.f, 0.f};
#pragma unroll
                    for (int ks = 0; ks < 2; ++ks) { const bf16x8 sf = *(const LAS bf16x8*)(Stl + (16 * dvt + l15) * LQ + ks * 32 + 8 * g4);
                        y[d4] = __builtin_amdgcn_mfma_f32_16x16x32_bf16(sf, qf[ks], y[d4], 0, 0, 0); }
                    y[d4] = y[d4] * qd; }
#pragma unroll
                for (int s2 = 0; s2 < 4; ++s2) {
                    if (2 * s2 <= w) {
#pragma unroll
                        for (int d4 = 0; d4 < 4; ++d4) { const int dvt = hf * 4 + d4;
                            LAS bf16_t* va = Vl + (32 * s2 + 4 * g4 + ((F.lane >> 2) & 3)) * LV + 16 * dvt + 4 * (F.lane & 3);
                            const s16x4 lo = __builtin_amdgcn_ds_read_tr16_b64_v4i16((LAS s16x4*)va), hi = __builtin_amdgcn_ds_read_tr16_b64_v4i16((LAS s16x4*)(va + 16 * LV));
                            const bf16x8 vf = {lo[0], lo[1], lo[2], lo[3], hi[0], hi[1], hi[2], hi[3]};
                            y[d4] = __builtin_amdgcn_mfma_f32_16x16x32_bf16(vf, pf[s2], y[d4], 0, 0, 0);
                        }
                    }
                }
                bf16_t* dst = YR + tokq * DM + hh * 128 + hf * 64 + 4 * g4;
#pragma unroll
                for (int d4 = 0; d4 < 4; ++d4) { u32x2 wv; wv.x = pk2(y[d4][0], y[d4][1]); wv.y = pk2(y[d4][2], y[d4][3]); *(u32x2*)(dst + 16 * d4) = wv; }
            }
            f32x4 nu[4];
#pragma unroll
            for (int dkt = 0; dkt < 4; ++dkt) nu[dkt] = (f32x4){0.f, 0.f, 0.f, 0.f};
#pragma unroll 1
            for (int s2 = 0; s2 < 4; ++s2) {
                LAS bf16_t* va = Vl + (32 * s2 + 8 * g4 + ((F.lane >> 2) & 3)) * LV + 16 * w + 4 * (F.lane & 3);
                const s16x4 vlo = __builtin_amdgcn_ds_read_tr16_b64_v4i16((LAS s16x4*)va), vhi = __builtin_amdgcn_ds_read_tr16_b64_v4i16((LAS s16x4*)(va + 4 * LV));
                float kd[8]; kd[0] = __expf(lg * (float)(127 - (32 * s2 + 8 * g4)));
#pragma unroll
                for (int e = 1; e < 8; ++e) kd[e] = kd[e - 1] * ginv;
                u32x4 vw;
                vw.x = pk2(bf2f((unsigned short)vlo[0]) * kd[0], bf2f((unsigned short)vlo[1]) * kd[1]); vw.y = pk2(bf2f((unsigned short)vlo[2]) * kd[2], bf2f((unsigned short)vlo[3]) * kd[3]);
                vw.z = pk2(bf2f((unsigned short)vhi[0]) * kd[4], bf2f((unsigned short)vhi[1]) * kd[5]); vw.w = pk2(bf2f((unsigned short)vhi[2]) * kd[6], bf2f((unsigned short)vhi[3]) * kd[7]);
                const bf16x8 vf = *reinterpret_cast<bf16x8*>(&vw);
#pragma unroll
                for (int dkt = 0; dkt < 4; ++dkt) {
                    LAS bf16_t* ka = Kl + (32 * s2 + 8 * g4 + ((F.lane >> 2) & 3)) * LQ + 16 * dkt + 4 * (F.lane & 3);
                    const s16x4 klo = __builtin_amdgcn_ds_read_tr16_b64_v4i16((LAS s16x4*)ka), khi = __builtin_amdgcn_ds_read_tr16_b64_v4i16((LAS s16x4*)(ka + 4 * LQ));
                    const bf16x8 kf = {klo[0], klo[1], klo[2], klo[3], khi[0], khi[1], khi[2], khi[3]};
                    nu[dkt] = __builtin_amdgcn_mfma_f32_16x16x32_bf16(vf, kf, nu[dkt], 0, 0, 0);
                }
            }
            __syncthreads();
#pragma unroll
            for (int dkt = 0; dkt < 4; ++dkt)
#pragma unroll
                for (int rg = 0; rg < 4; ++rg) { LAS float* sp = Stf + (16 * w + 4 * g4 + rg) * 64 + 16 * dkt + l15; const float sv = *sp * cdec + nu[dkt][rg]; *sp = sv;
                    Stl[(16 * w + 4 * g4 + rg) * LQ + 16 * dkt + l15] = (bf16_t)f2bf(sv); }
        }
        __syncthreads();
#undef RET_LOAD
    }
}
__device__ __forceinline__ void phase_ret_final(Frame& F0, int layer) {
    Frame F = mkframe(F0);
    const bf16_t* YF = (const bf16_t*)(WSP() + WS_YRF); const bf16_t* YBk = (const bf16_t*)(WSP() + WS_YRB); const bf16_t* PL = (const bf16_t*)(WSP() + WS_PLAIN);
    bf16_t* Y = (bf16_t*)(WSP() + WS_YRET); const float* rn = GP(const float, ret_norm) + layer * DM;
    float rnv[16];
#pragma unroll
    for (int j = 0; j < 16; ++j) rnv[j] = rn[F.lane * 16 + j];
    for (int t0 = F.gw; t0 < T; t0 += 2 * F.ngw) {
        u32x4 ra[2][2], rc[2][2], rg[2][2];
#pragma unroll
        for (int k = 0; k < 2; ++k) { const int t = t0 + k * F.ngw;
#pragma unroll
            for (int h2 = 0; h2 < 2; ++h2) { ra[k][h2] = (u32x4){0u, 0u, 0u, 0u}; rc[k][h2] = ra[k][h2]; rg[k][h2] = ra[k][h2];
                if (t < T) { ra[k][h2] = *((const u32x4*)(YF + (size_t)t * DM) + F.lane * 2 + h2); rc[k][h2] = *((const u32x4*)(YBk + (size_t)t * DM) + F.lane * 2 + h2);
                    rg[k][h2] = *((const u32x4*)(PL + (size_t)t * PLAIN_W + PC_RG) + F.lane * 2 + h2); } } }
#pragma unroll
        for (int k = 0; k < 2; ++k) { const int t = t0 + k * F.ngw; if (t >= T) continue;
            float v[16];
#pragma unroll
            for (int h2 = 0; h2 < 2; ++h2) { const unsigned aw[4] = {ra[k][h2].x, ra[k][h2].y, ra[k][h2].z, ra[k][h2].w}, cw[4] = {rc[k][h2].x, rc[k][h2].y, rc[k][h2].z, rc[k][h2].w};
#pragma unroll
                for (int j = 0; j < 4; ++j) { v[h2 * 8 + 2 * j] = bf2f(aw[j] & 0xffffu) + bf2f(cw[j] & 0xffffu); v[h2 * 8 + 2 * j + 1] = bf2f(aw[j] >> 16) + bf2f(cw[j] >> 16); } }
            float s = 0.f;
#pragma unroll
            for (int j = 0; j < 16; ++j) s += v[j];
            s = sum8(s);
            const float mu = s * (1.0f / 128.0f); float q = 0.f;
#pragma unroll
            for (int j = 0; j < 16; ++j) { v[j] -= mu; q += v[j] * v[j]; }
            q = sum8(q);
            const float rstd = __builtin_amdgcn_rsqf(q * (1.0f / 128.0f) + EPS);
            u32x4 o[2];
#pragma unroll
            for (int h2 = 0; h2 < 2; ++h2) { const unsigned gq[4] = {rg[k][h2].x, rg[k][h2].y, rg[k][h2].z, rg[k][h2].w}; unsigned ow[4];
#pragma unroll
                for (int j = 0; j < 4; ++j)
                    ow[j] = pk2(v[h2 * 8 + 2 * j] * rstd * rnv[h2 * 8 + 2 * j] * bf2f(gq[j] & 0xffffu), v[h2 * 8 + 2 * j + 1] * rstd * rnv[h2 * 8 + 2 * j + 1] * bf2f(gq[j] >> 16));
                o[h2] = (u32x4){ow[0], ow[1], ow[2], ow[3]}; }
            *((u32x4*)(Y + (size_t)t * DM) + F.lane * 2) = o[0]; *((u32x4*)(Y + (size_t)t * DM) + F.lane * 2 + 1) = o[1]; }
    }
}

__global__ void __launch_bounds__(512, 2) fwd_kernel(Params P) {
    extern __shared__ __attribute__((aligned(16))) unsigned char lds_raw[];
    Frame F = mkframe0((LAS unsigned char*)lds_raw);
    {
        volatile LAS unsigned* misc = (volatile LAS unsigned*)(F.lds + LDS_MISC);
        if (F.tid < 64) misc[F.tid] = 0u;
        if (F.tid < (int)(sizeof(Params) / 4)) ((volatile LAS unsigned*)(F.lds + LDS_PTRS))[F.tid] = ((const unsigned*)&P)[F.tid];
        __syncthreads();
        (void)xcd_barrier_post((unsigned*)(WSP() + WS_CTL) + 4096, misc + 8, F.wave);
    }
#define GRID_BAR() do { XcdBarrier b_; b_.bar = (unsigned*)(WSP() + WS_CTL) + 4096; b_.x = (unsigned)__builtin_amdgcn_readfirstlane(opaque((int)xb_xcc_id())); \
        b_.st = (volatile LAS unsigned*)(F.lds + LDS_MISC) + 8; b_.w = F.wave; xcd_barrier(b_); if (DUPN == 100) xcd_barrier(b_); } while (0)
#define WSB(off) (WSP() + (off))
#define MODL (((const float*)WSB(WS_MOD)) + (size_t)layer * 8 * 6144)
#define XOUT GP(float, out)
    const int bx = blockIdx.x;

    PH(0) p0_convert(F, false, 0);
    PH(1) p0_tables(F);
    GRID_BAR();
    PH(1) p0_modreduce(F);
    GRID_BAR();

    for (int layer = 0; layer < DEPTH; ++layer) {
        if (!(layer & 1)) {
        PH(2) {
            if (layer > 0 && ((layer - 1) & 1)) {
                const float* modp = ((const float*)WSB(WS_MOD)) + (size_t)(layer - 1) * 8 * 6144;
                phase_norm<true, false, false, true>(F, nullptr, GP(const float, norm_mix) + layer * DM, MODL + 1024, MODL, modp + 5 * 1024, nullptr);
            } else {
                phase_norm<false, false, false, true>(F, nullptr, GP(const float, norm_mix) + layer * DM, MODL + 1024, MODL, nullptr, nullptr);
            }
        }
        PH(0) if (layer == 2) p0_convert(F, true, 1);
        GRID_BAR();
        }
        PH(3) {
            pg8::Gemm g{(const bf16_t*)WSB(WS_H), (const bf16_t*)(WSB(WS_WIN) + (size_t)layer * NIN * DM), DM / 2, DM / 2, DM / 2};
            pg8::StaticOrder S; S.init(T / 256, NIN / 256, F.G, bx);
            EpiIn E{(bf16_t*)WSB(WS_PLAIN), (bf16_t*)WSB(WS_ROPE), (float*)WSB(WS_SSQ), (const unsigned*)WSB(WS_COS), 1.f / WIN_SC};
            pg8::gemm_phase8(F.lds, F.wave, g, S, E);
        }
        GRID_BAR();
        PH(4) {
            pg8::Gemm g{(const bf16_t*)WSB(WS_PLAIN) + PC_CQ, (const bf16_t*)WSB(WS_WUQ) + (size_t)layer * QW * 768, PLAIN_W, 768, 768};
            pg8::StaticOrder S; S.init(T / 256, QW / 256, F.G, bx);
            EpiQ E{(bf16_t*)WSB(WS_Q), (const float*)WSB(WS_SSQ), (const unsigned*)WSB(WS_COS), 0.07216878364870322f * 1.4426950408889634f};
            pg8::gemm_phase(F.lds, F.wave, g, S, E);
        }
        PH(5) {
            pg8::Gemm g{(const bf16_t*)WSB(WS_PLAIN) + PC_CKV, (const bf16_t*)WSB(WS_WUKV) + (size_t)layer * KVW * 512, PLAIN_W, 512, 512};
            pg8::StaticOrder S; S.init(T / 256, KVW / 256, F.G, bx);
            EpiKV E{(bf16_t*)WSB(WS_KV), (const float*)WSB(WS_SSQ)};
            pg8::gemm_phase(F.lds, F.wave, g, S, E);
        }
        PH(6) phase_retention(F, layer);
        PH(7) phase_dilated(F);
        GRID_BAR();
        PH(8) phase_mla(F);
        PH(9) phase_dil_merge(F);
        PH(9) phase_ret_final(F, layer);
        GRID_BAR();
        PH(10) {
            pg8::StaticOrder S; S.init(T / 256, DM / 256, F.G, bx);
            { pg8::Gemm g{(const bf16_t*)WSB(WS_YMLA), (const bf16_t*)WSB(WS_WBM) + (size_t)layer * DM * DM, DM, DM, DM};
              EpiBr E{(bf16_t*)WSB(WS_MF), (bf16_t*)WSB(WS_MB), (const bf16_t*)WSB(WS_PLAIN) + PC_GA, 0}; pg8::gemm_phase(F.lds, F.wave, g, S, E); }
            { pg8::Gemm g{(const bf16_t*)WSB(WS_YDIL), (const bf16_t*)WSB(WS_WBD) + (size_t)layer * DM * 512, 512, 512, 512};
              EpiBr E{(bf16_t*)WSB(WS_MF), (bf16_t*)WSB(WS_MB), (const bf16_t*)WSB(WS_PLAIN) + PC_GB, 1}; pg8::gemm_phase(F.lds, F.wave, g, S, E); }
            { pg8::Gemm g{(const bf16_t*)WSB(WS_YRET), (const bf16_t*)WSB(WS_WBR) + (size_t)layer * DM * DM, DM, DM, DM};
              EpiBr E{(bf16_t*)WSB(WS_MF), (bf16_t*)WSB(WS_MB), (const bf16_t*)WSB(WS_PLAIN) + PC_GC, 2}; pg8::gemm_phase(F.lds, F.wave, g, S, E); }
        }
        GRID_BAR();
        PH(11) {
            pg8::Gemm g{(const bf16_t*)WSB(WS_MB), (const bf16_t*)WSB(WS_WO) + (size_t)layer * DM * DM, DM, DM, DM};
            pg8::StaticOrder S; S.init(T / 256, DM / 256, F.G, bx);
            if (layer & 1) { EpiRes E{(bf16_t*)WSB(WS_X), MODL + 2 * 1024, 1.f}; pg8::gemm_phase(F.lds, F.wave, g, S, E); }
            else {
                EpiResNorm E{(bf16_t*)WSB(WS_X), MODL + 2 * 1024, 1.f, WSB(WS_H), 0, GP(const float, norm_ffn) + layer * DM, MODL + 4 * 1024, MODL + 3 * 1024,
                             (float*)WSB(WS_SSQ) + (size_t)layer * 65536, (unsigned*)(WSB(WS_CTL) + 65536) + (size_t)layer * 4096, F.lds};
                pg8::gemm_phase(F.lds, F.wave, g, S, E); }
        }
        GRID_BAR();
        if (layer & 1) {
            PH(12) phase_norm<false, true, false, true>(F, nullptr, GP(const float, norm_ffn) + layer * DM, MODL + 4 * 1024, MODL + 3 * 1024, nullptr, GP(const float, moe_router) + (size_t)(layer >> 1) * DM * 8);
            GRID_BAR();
        }
        if (!(layer & 1)) {
            const int fi = layer >> 1;
            PH(13) { pg8::Gemm g{(const bf16_t*)WSB(WS_H), (const bf16_t*)WSB(WS_W13) + (size_t)fi * 5632 * DM, DM, DM, DM};
              pg8::StaticOrder S; S.init(T / 256, 5632 / 256, F.G, bx);
              EpiSwi E{(bf16_t*)WSB(WS_HID), DFF}; pg8::gemm_phase(F.lds, F.wave, g, S, E); }
            GRID_BAR();
            PH(14) { pg8::Gemm g{(const bf16_t*)WSB(WS_HID), (const bf16_t*)WSB(WS_W2) + (size_t)fi * DM * DFF, DFF, DFF, DFF};
              pg8::StaticOrder S; S.init(T / 256, DM / 256, F.G, bx);
              const float* modn = ((const float*)WSB(WS_MOD)) + (size_t)(layer + 1) * 8 * 6144;
              EpiResNorm E{(bf16_t*)WSB(WS_X), MODL + 5 * 1024, 1.f, WSB(WS_H), 1, GP(const float, norm_mix) + (layer + 1) * DM, modn + 1024, modn,
                           (float*)WSB(WS_SSQ) + (size_t)(layer + 1) * 65536, (unsigned*)(WSB(WS_CTL) + 65536) + (size_t)(layer + 1) * 4096, F.lds};
              pg8::gemm_phase(F.lds, F.wave, g, S, E); }
            GRID_BAR();
        } else {
            PH(15) phase_moe_gather(F);
            GRID_BAR();
            PH(16) { const int* moei = (const int*)WSB(WS_MOEI); const int nblk = __builtin_amdgcn_readfirstlane(__hip_atomic_load(moei + MI_BLK, __ATOMIC_RELAXED, __HIP_MEMORY_SCOPE_AGENT));
              pg8::Gemm g{(const bf16_t*)WSB(WS_XG), (const bf16_t*)WSB(WS_W13E), DM / 2, DM / 2, DM / 2};
              pg8::StaticOrder S; S.init(nblk, 7168 / 256, F.G, bx); S.blk_exp = moei + MI_BLK + 1; S.estride = (size_t)7168 * (DM / 2);
              EpiSwi8 E{WSB(WS_HID), DFE, 1.f / W13E_SC, HID8_SC}; pg8::gemm_phase8(F.lds, F.wave, g, S, E); }
            GRID_BAR();
            PH(17) { const int* moei = (const int*)WSB(WS_MOEI); const int nblk = __builtin_amdgcn_readfirstlane(__hip_atomic_load(moei + MI_BLK, __ATOMIC_RELAXED, __HIP_MEMORY_SCOPE_AGENT));
              pg8::Gemm g{(const bf16_t*)WSB(WS_HID), (const bf16_t*)WSB(WS_W2E), DFE / 2, DFE / 2, DFE / 2};
              pg8::TailOrder S; S.init(MOE_MAIN_BLK, DM / 256, F.G, bx); S.blk_exp = moei + MI_BLK + 1; S.estride = (size_t)DM * (DFE / 2);
              S.nNr = DM / 256; S.ksub = DFE / 2 / pg8::KT_SPLIT; S.ntail = (nblk - MOE_MAIN_BLK) * (DM / 256) * pg8::KT_SPLIT;
              EpiPlain E{(bf16_t*)WSB(WS_YB), DM, DM / 256, (bf16_t*)WSB(WS_XG), 1.f / (W2E_SC * HID8_SC), MOE_MAIN_BLK, (size_t)MOE_TAIL_ROWS * DM}; pg8::gemm_phase8(F.lds, F.wave, g, S, E); }
            GRID_BAR();
        }
    }
    PH(18) {
        const float* modp = ((const float*)WSB(WS_MOD)) + (size_t)3 * 8 * 6144;
        phase_norm<true, false, true, false>(F, XOUT, GP(const float, final_norm), nullptr, nullptr, modp + 5 * 1024, nullptr);
    }
}

extern "C" void kernel_launch(void* const* d_in, const int* in_sizes, int n_in, void* d_out, int out_size, void* d_ws, size_t ws_size, hipStream_t stream) {
    static int grid = 0;
    if (grid == 0) {
        if (n_in != 26 || in_sizes[0] != T * DM || out_size != T * DM || ws_size < WS_END) {
            fprintf(stderr, "kernel_launch: unexpected shapes / workspace: n_in %d in0 %d out %d ws %zu (need %zu)\n", n_in, n_in > 0 ? in_sizes[0] : -1, out_size, ws_size, (size_t)WS_END);
            grid = -1; return; }
        int dev = 0, cus = 0, per_cu = 0;
        if (hipGetDevice(&dev) != hipSuccess || hipDeviceGetAttribute(&cus, hipDeviceAttributeMultiprocessorCount, dev) != hipSuccess) { grid = -1; return; }
        if (hipFuncSetAttribute((const void*)fwd_kernel, hipFuncAttributeMaxDynamicSharedMemorySize, LDS_BYTES) != hipSuccess) { fprintf(stderr, "kernel_launch: hipFuncSetAttribute failed\n"); grid = -1; return; }
        if (hipOccupancyMaxActiveBlocksPerMultiprocessor(&per_cu, (const void*)fwd_kernel, 512, LDS_BYTES) != hipSuccess || per_cu < 1) {
            fprintf(stderr, "kernel_launch: occupancy query reports %d blocks per CU\n", per_cu); (void)hipGetLastError(); grid = -1; return; }
        grid = cus;
    }
    if (grid < 0) return;
    (void)hipMemsetAsync((char*)d_ws + WS_CTL, 0, CTL_BYTES, stream);
    Params p{};
    const float* const* fin = (const float* const*)d_in;
    p.x = fin[0]; p.c = fin[1]; p.positions = (const int*)d_in[2]; p.ada_w = fin[3]; p.ada_b = fin[4]; p.norm_mix = fin[5]; p.norm_ffn = fin[6]; p.w_in = fin[7];
    p.q_norm = fin[8]; p.w_uq = fin[9]; p.kv_norm = fin[10]; p.w_ukv = fin[11]; p.ret_ld = fin[12]; p.ret_norm = fin[13];
    p.w_br_mla = fin[14]; p.w_br_dil = fin[15]; p.w_br_ret = fin[16]; p.w_out = fin[17]; p.ffn_w1 = fin[18]; p.ffn_w3 = fin[19]; p.ffn_w2 = fin[20];
    p.moe_router = fin[21]; p.moe_w1 = fin[22]; p.moe_w3 = fin[23]; p.moe_w2 = fin[24]; p.final_norm = fin[25];
    p.out = (float*)d_out; p.ws = (unsigned char*)d_ws;
    for (int i = 0; i < 32; ++i) p.inv_freq[i] = std::pow(10000.0, -(double)i / 32.0);
    hipLaunchKernelGGL(fwd_kernel, dim3(grid), dim3(512), LDS_BYTES, stream, p);
    const hipError_t le = hipPeekAtLastError();
    if (le != hipSuccess) fprintf(stderr, "kernel_launch: launch failed: %s\n", hipGetErrorName(le));
}
```

```cpp
#include <hip/hip_runtime.h>
#include <cstdio>
#include <cstdint>
#include <cmath>

#define LAS __attribute__((address_space(3)))
typedef unsigned short bf16_t;
typedef short bf16x8 __attribute__((ext_vector_type(8)));
typedef short s16x4 __attribute__((ext_vector_type(4)));
typedef float f32x4 __attribute__((ext_vector_type(4)));
typedef float f32x16 __attribute__((ext_vector_type(16)));
typedef unsigned u32x4 __attribute__((ext_vector_type(4)));
typedef unsigned u32x2 __attribute__((ext_vector_type(2)));
typedef int i32x4 __attribute__((ext_vector_type(4)));
typedef int i32x8 __attribute__((ext_vector_type(8)));

constexpr int T = 16384, DM = 1024, SEQ = 2048, NB_ = 8, DEPTH = 4;
constexpr int IN_COLS = 12096, NIN = 12288;
constexpr int PLAIN_W = 7936, ROPE_W = 4352;
constexpr int QW = 1536, KVW = 2048;
constexpr int DFF = 2816, DFE = 3584, NEXP = 8;
constexpr int MOE_ROWS = (T * 2 / 256 + NEXP) * 256;
constexpr int MOE_NB = MOE_ROWS / 256;
constexpr float EPS_C = 1e-6f;
#define EPS eps_now()
constexpr int PC_CQ = 0, PC_CKV = 768, PC_DV = 1280, PC_RV = 2816, PC_RG = 3840, PC_GA = 4864, PC_GB = 5888, PC_GC = 6912;
constexpr int RS_KR = 0, RS_DQ = 1, RS_DK = 25, RS_RQ = 49, RS_RK = 57;

constexpr size_t MiB = 1ull << 20;
constexpr size_t WS_CTL = 0;                       constexpr size_t CTL_BYTES = 1 * MiB;
constexpr size_t WS_MODP = 1 * MiB;
constexpr size_t WS_MOD = 14 * MiB;
constexpr size_t WS_COS = 15 * MiB, WS_SIN = 17 * MiB;
constexpr size_t WS_SSQ = 19 * MiB;
constexpr size_t WS_MOEI = 21 * MiB;
constexpr size_t WS_LSE = 22 * MiB;
constexpr size_t WS_WIN = 24 * MiB;
constexpr size_t WS_WUQ = WS_WIN + 96 * MiB;
constexpr size_t WS_WUKV = WS_WUQ + 9 * MiB;
constexpr size_t WS_WBM = WS_WUKV + 12 * MiB;
constexpr size_t WS_WBD = WS_WBM + 8 * MiB;
constexpr size_t WS_WBR = WS_WBD + 8 * MiB;
constexpr size_t WS_WO = WS_WBR + 8 * MiB;
constexpr size_t WS_W13 = WS_WO + 8 * MiB;
constexpr size_t WS_W2 = WS_W13 + 22 * MiB;
constexpr size_t WS_W13E = WS_W2 + 11 * MiB;
constexpr size_t WS_W2E = WS_W13E + 112 * MiB;
constexpr size_t WS_H = WS_W2E + 56 * MiB;
constexpr size_t WS_PLAIN = WS_H + 32 * MiB;
constexpr size_t WS_ROPE = WS_PLAIN + 248 * MiB;
constexpr size_t WS_Q = WS_ROPE + 136 * MiB;
constexpr size_t WS_KV = WS_Q + 48 * MiB;
constexpr size_t WS_YMLA = WS_KV + 64 * MiB;
constexpr size_t WS_YDIL = WS_YMLA + 32 * MiB;
constexpr size_t WS_YRET = WS_YDIL + 32 * MiB;
constexpr size_t WS_DILO = WS_YRET + 32 * MiB;
constexpr size_t WS_YRF = WS_DILO + 48 * MiB;
constexpr size_t WS_YRB = WS_YRF + 32 * MiB;
constexpr size_t WS_MB = WS_YRB + 32 * MiB;
constexpr size_t WS_X = WS_MB + 32 * MiB;
constexpr size_t WS_END = WS_X + 32 * MiB;
constexpr size_t WS_MF = WS_KV;
constexpr size_t WS_HID = WS_PLAIN;
constexpr size_t WS_XG = WS_ROPE;
constexpr size_t WS_YB = WS_ROPE + 68 * MiB;
static_assert((size_t)MOE_ROWS * DFE * 2 <= 248 * MiB, "hid");
static_assert((size_t)MOE_ROWS * DM * 2 <= 68 * MiB, "xg");
constexpr int MI_TOKE = 0;
constexpr int MI_TOKW = 2 * T;
constexpr int MI_TOKP = 4 * T;
constexpr int MI_CNT = 6 * T;
constexpr int MI_BLK = 6 * T + 2048 * 8;
static_assert((MI_BLK + 256) * 4 <= (int)MiB, "moei");

constexpr int LDS_RING = 131072;
constexpr int LDS_MISC = LDS_RING;
constexpr int LDS_BYTES = 147456;

__device__ __forceinline__ float bf2f(unsigned b) { return __uint_as_float(b << 16); }
__device__ __forceinline__ unsigned f2bf(float f) { unsigned u = __float_as_uint(f); return (u + 0x7fffu + ((u >> 16) & 1u)) >> 16; }
typedef __bf16 bf16x2_t __attribute__((ext_vector_type(2)));
typedef float f32x2_t __attribute__((ext_vector_type(2)));
__device__ __forceinline__ unsigned pk2(float lo, float hi) { const f32x2_t f = {lo, hi}; const bf16x2_t b = __builtin_convertvector(f, bf16x2_t); return __builtin_bit_cast(unsigned, b); }
__device__ __forceinline__ float fsigmoid(float x) { return __builtin_amdgcn_rcpf(1.0f + __builtin_amdgcn_exp2f(-1.4426950408889634f * x)); }
__device__ __forceinline__ float fsilu(float x) { return x * fsigmoid(x); }
__device__ __forceinline__ int opaque(int x) { asm volatile("" : "+v"(x)); return x; }
__device__ __forceinline__ float eps_now() { int x = 0x358637bd; asm volatile("" : "+v"(x)); return __int_as_float(x); }
__device__ __forceinline__ int opaque_s(int x) { asm volatile("" : "+s"(x)); return x; }
__device__ __forceinline__ int lane_now() { int l; asm volatile("v_mbcnt_lo_u32_b32 %0, -1, 0\n\tv_mbcnt_hi_u32_b32 %0, -1, %0" : "=v"(l)); return l; }
template <int CTRL> __device__ __forceinline__ float dppf(float v) { return __uint_as_float((unsigned)__builtin_amdgcn_update_dpp(0, (int)__float_as_uint(v), CTRL, 0xf, 0xf, false)); }
__device__ __forceinline__ float sum_x16(float v) { const auto r = __builtin_amdgcn_permlane16_swap(__float_as_uint(v), __float_as_uint(v), false, false); return __uint_as_float(r[0]) + __uint_as_float(r[1]); }
__device__ __forceinline__ float sum_x32(float v) { const auto r = __builtin_amdgcn_permlane32_swap(__float_as_uint(v), __float_as_uint(v), false, false); return __uint_as_float(r[0]) + __uint_as_float(r[1]); }
__device__ __forceinline__ float max_x16(float v) { const auto r = __builtin_amdgcn_permlane16_swap(__float_as_uint(v), __float_as_uint(v), false, false); return fmaxf(__uint_as_float(r[0]), __uint_as_float(r[1])); }
__device__ __forceinline__ float max_x32(float v) { const auto r = __builtin_amdgcn_permlane32_swap(__float_as_uint(v), __float_as_uint(v), false, false); return fmaxf(__uint_as_float(r[0]), __uint_as_float(r[1])); }
__device__ __forceinline__ float sum8(float v) { v += dppf<0xB1>(v); v += dppf<0x4E>(v); v += dppf<0x141>(v); return v; }
__device__ __forceinline__ float wave_sum(float v) { v = sum8(v); v += dppf<0x140>(v); v = sum_x16(v); return sum_x32(v); }

#define XB_TMO      128
#define XB_XCNT(j)  (256  + 64 * (j))
#define XB_XSUB(j)  (1280 + 64 * (j))
#define XB_XGEN(j)  (2304 + 64 * (j))
#define XB_TOP      3328
#define XB_TOPGEN   3392
#define XCD_BAR_WORDS 3456
#define XB_SPIN_CAP (1u << 24)
__device__ __forceinline__ unsigned xb_ld(unsigned* p)              { return __hip_atomic_load(p, __ATOMIC_RELAXED, __HIP_MEMORY_SCOPE_AGENT); }
__device__ __forceinline__ unsigned xb_add(unsigned* p, unsigned v) { return __hip_atomic_fetch_add(p, v, __ATOMIC_RELAXED, __HIP_MEMORY_SCOPE_AGENT); }
__device__ __forceinline__ unsigned xb_xcc_id() { return (unsigned)__builtin_amdgcn_s_getreg((3 << 11) | 20) & 0xFu; }
#define XB_SPIN(cond, bar) do { unsigned _sp = 0; while (cond) { __builtin_amdgcn_s_sleep(1); \
    if ((++_sp & 255u) == 0u) { if (xb_ld(&(bar)[XB_TMO])) break; if (_sp > XB_SPIN_CAP) { atomicAdd(&(bar)[XB_TMO], 1u); break; } } } } while (0)
struct XcdBarrier { unsigned* bar; unsigned x; volatile LAS unsigned* st; int w; };
__device__ __forceinline__ XcdBarrier xcd_barrier_post(unsigned* bar, volatile LAS unsigned* st, int w) {
    XcdBarrier b; b.bar = bar; b.x = xb_xcc_id(); b.st = st; b.w = w;
    if (w == 0 && lane_now() == 0) (void)xb_add(&bar[XB_XCNT(b.x)], 1u);
    return b;
}
__device__ __forceinline__ void xcd_barrier_complete(unsigned* bar, unsigned x, unsigned& nloc, unsigned& nx) {
    const unsigned G = gridDim.x * gridDim.y * gridDim.z;
    unsigned sum, cnt, mine, sp = 0u;
    for (;;) {
        sum = 0u; cnt = 0u; mine = 0u;
#pragma unroll
        for (unsigned j = 0; j < 16; ++j) { const unsigned c = xb_ld(&bar[XB_XCNT(j)]); sum += c; cnt += (c > 0u) ? 1u : 0u; mine = (j == x) ? c : mine; }
        if (sum == G) break;
        __builtin_amdgcn_s_sleep(1);
        if ((++sp & 255u) == 0u) { if (xb_ld(&bar[XB_TMO])) break; if (sp > XB_SPIN_CAP) { atomicAdd(&bar[XB_TMO], 1u); break; } }
    }
    nloc = mine > 0u ? mine : 1u; nx = cnt > 0u ? cnt : 1u;
}
__device__ __forceinline__ void xcd_barrier(const XcdBarrier& b) {
    asm volatile("s_waitcnt vmcnt(0)" ::: "memory");
    __syncthreads();
    if (b.w == 0 && lane_now() == 0) {
        unsigned* bar = b.bar;
        __builtin_amdgcn_s_waitcnt(0);
        unsigned nloc = b.st[0], nx = b.st[1];
        if (nloc == 0u) { xcd_barrier_complete(bar, b.x, nloc, nx); b.st[0] = nloc; b.st[1] = nx; }
        const unsigned old = xb_add(&bar[XB_XSUB(b.x)], 1u);
        const unsigned gen = old / nloc;
        if (old + 1u == (gen + 1u) * nloc) {
            __builtin_amdgcn_fence(__ATOMIC_RELEASE, "agent");
            asm volatile("s_waitcnt vmcnt(0)" ::: "memory");
            const unsigned og = xb_add(&bar[XB_TOP], 1u);
            const unsigned tg = og / nx;
            if (og + 1u == (tg + 1u) * nx) xb_add(&bar[XB_TOPGEN], 1u);
            else XB_SPIN(xb_ld(&bar[XB_TOPGEN]) == tg, bar);
            __builtin_amdgcn_fence(__ATOMIC_ACQUIRE, "agent");
            xb_add(&bar[XB_XGEN(b.x)], 1u);
            asm volatile("s_waitcnt vmcnt(0)" ::: "memory");
        } else {
            XB_SPIN(xb_ld(&bar[XB_XGEN(b.x)]) == gen, bar);
            __builtin_amdgcn_fence(__ATOMIC_ACQUIRE, "agent");
            asm volatile("s_waitcnt vmcnt(0)" ::: "memory");
        }
    }
    __syncthreads();
}

#ifndef ONLY
#define ONLY -1
#endif
#define RUN(n) (ONLY < 0 || ONLY == (n))
#ifndef DUPN
#define DUPN -1
#endif
#define PH(n) for (int rp_ = 0; rp_ < (RUN(n) ? ((DUPN == (n)) ? 2 : 1) : 0); ++rp_)
struct Params {
    const float* x; const float* c; const int* positions; const float* ada_w; const float* ada_b;
    const float* norm_mix; const float* norm_ffn; const float* w_in; const float* q_norm; const float* w_uq;
    const float* kv_norm; const float* w_ukv; const float* ret_ld; const float* ret_norm;
    const float* w_br_mla; const float* w_br_dil; const float* w_br_ret; const float* w_out;
    const float* ffn_w1; const float* ffn_w3; const float* ffn_w2;
    const float* moe_router; const float* moe_w1; const float* moe_w3; const float* moe_w2; const float* final_norm;
    float* out; unsigned char* ws;
    double inv_freq[32];
};

constexpr int LDS_PTRS = LDS_MISC + 256;
template <class T, int OFF> __device__ __forceinline__ T* gp(LAS unsigned char* lds) {
    unsigned a; asm volatile("v_mov_b32 %0, %1" : "=v"(a) : "i"(LDS_PTRS + OFF));
    const volatile LAS unsigned* t = (const volatile LAS unsigned*)(lds + a);
    unsigned lo = t[0], hi = t[1]; lo = __builtin_amdgcn_readfirstlane(lo); hi = __builtin_amdgcn_readfirstlane(hi);
    return (T*)(((unsigned long long)hi << 32) | lo); }
#define GP(T, name) gp<T, (int)__builtin_offsetof(Params, name)>(F.lds)
#define WSP() gp<unsigned char, (int)__builtin_offsetof(Params, ws)>(F.lds)
namespace pg8 {
constexpr int BM = 256, BK = 64, HALF = 128, HTB = HALF * BK * 2, STAGE_BYTES = 8 * HTB, NXCD = 8, WGM = 8, KT_SPLIT = 7;
__device__ __forceinline__ int lds_byte(int r, int c) { const int st = (r >> 4) * 2 + (c >> 5), rr = r & 15, cc = c & 31, ob = rr * 64 + cc * 2; return st * 1024 + (ob ^ (((ob >> 9) & 1) << 5)); }
__device__ __forceinline__ void stage_rc(int b, int& R, int& C) { const int st = b / 1024, sb = b % 1024, swz = sb ^ (((sb >> 9) & 1) << 5); R = (st >> 1) * 16 + swz / 64; C = (st & 1) * 32 + (swz % 64) / 2; }
__device__ __forceinline__ int perm32(int rho) { const int n = rho >> 4, i = rho & 15; return 8 * (i >> 2) + 4 * n + (i & 3); }
struct Unit { int pm, pn; };
struct Gemm { const bf16_t* A; const bf16_t* Bt; int lda, ldb, K; };
struct StaticOrder {
    int nM, nN, nwg, G, c;
    const int* blk_exp; size_t estride;
    int nNr, ksub;
    __device__ void init(int nM_, int nN_, int G_, int c_) { nM = nM_; nN = nN_; nwg = nM * nN; G = G_; c = opaque_s(c_); blk_exp = nullptr; estride = 0; nNr = 0; ksub = 0; }
    __device__ bool next(int i, Unit& u) const {
        const int L = i * G + c; if (L >= nwg) return false;
        int wgid = L; { const int q = nwg / NXCD, r = nwg % NXCD, xcd = wgid % NXCD, off = wgid / NXCD; wgid = (xcd < r ? xcd * (q + 1) : r * (q + 1) + (xcd - r) * q) + off; }
        const int nig = WGM * nN, gid = wgid / nig, fm = gid * WGM, gsz = (nM - fm) < WGM ? (nM - fm) : WGM;
        u.pm = fm + ((wgid % nig) % gsz); u.pn = (wgid % nig) / gsz; return true;
    }
    __device__ __forceinline__ const char* a_ptr(const Gemm& g, const Unit& u) const { size_t ko = 0; if (nNr) ko = (size_t)(u.pn / nNr) * ksub; return (const char*)(g.A + (size_t)u.pm * 256 * g.lda + ko); }
    __device__ __forceinline__ const char* b_ptr(const Gemm& g, const Unit& u) const {
        size_t e = 0; if (blk_exp) e = (size_t)__builtin_amdgcn_readfirstlane(__hip_atomic_load(blk_exp + u.pm, __ATOMIC_RELAXED, __HIP_MEMORY_SCOPE_AGENT)) * estride;
        int pn = u.pn; size_t ko = 0; if (nNr) { ko = (size_t)(pn / nNr) * ksub; pn = pn % nNr; }
        return (const char*)(g.Bt + e + (size_t)pn * 256 * g.ldb + ko); }
};
struct QKVOrder {
    StaticOrder sq, sk; size_t akv, bkv;
    __device__ bool next(int i, Unit& u) const {
        const int L = i * sq.G + sq.c;
        if (L < sq.nwg) return sq.next(i, u);
        StaticOrder t = sk; t.c = L - sq.nwg; if (!t.next(0, u)) return false;
        u.pn += 8; return true; }
    __device__ __forceinline__ int ntiles(const Unit& u, int nt) const { return u.pn >= 8 ? 8 : nt; }
    __device__ __forceinline__ const char* a_ptr(const Gemm& g, const Unit& u) const { return (const char*)g.A + (u.pn >= 8 ? akv : 0) + (size_t)u.pm * 256 * g.lda * 2; }
    __device__ __forceinline__ const char* b_ptr(const Gemm& g, const Unit& u) const { return (const char*)g.Bt + (u.pn >= 8 ? bkv + (size_t)(u.pn - 8) * 256 * g.ldb * 2 : (size_t)u.pn * 256 * g.ldb * 2); }
};
struct TailOrder {
    int nM, nN, nwg, G, c;
    const int* blk_exp; size_t estride;
    int nNr, ksub, ntail;
    __device__ void init(int nM_, int nN_, int G_, int c_) { nM = nM_; nN = nN_; nwg = nM * nN; G = G_; c = opaque_s(c_); blk_exp = nullptr; estride = 0; nNr = 0; ksub = 0; ntail = 0; }
    __device__ bool next(int i, Unit& u) const {
        const int L = i * G + c; if (L >= nwg + ntail) return false;
        if (L >= nwg) { const int t = L - nwg, per = nNr * (KT_SPLIT); u.pm = nM + t / per; u.pn = nNr + t % per; return true; }
        int wgid = L; { const int q = nwg / NXCD, r = nwg % NXCD, xcd = wgid % NXCD, off = wgid / NXCD; wgid = (xcd < r ? xcd * (q + 1) : r * (q + 1) + (xcd - r) * q) + off; }
        const int nig = WGM * nN, gid = wgid / nig, fm = gid * WGM, gsz = (nM - fm) < WGM ? (nM - fm) : WGM;
        u.pm = fm + ((wgid % nig) % gsz); u.pn = (wgid % nig) / gsz; return true;
    }
    __device__ __forceinline__ int ntiles(const Unit& u, int nt) const { return (nNr && u.pn >= nNr) ? ksub / BK : nt; }
    __device__ __forceinline__ const char* a_ptr(const Gemm& g, const Unit& u) const { size_t ko = 0; if (nNr && u.pn >= nNr) ko = (size_t)(u.pn / nNr - 1) * ksub; return (const char*)(g.A + (size_t)u.pm * 256 * g.lda + ko); }
    __device__ __forceinline__ const char* b_ptr(const Gemm& g, const Unit& u) const {
        size_t e = 0; if (blk_exp) e = (size_t)__builtin_amdgcn_readfirstlane(__hip_atomic_load(blk_exp + u.pm, __ATOMIC_RELAXED, __HIP_MEMORY_SCOPE_AGENT)) * estride;
        int pn = u.pn; size_t ko = 0; if (nNr && pn >= nNr) { ko = (size_t)(pn / nNr - 1) * ksub; pn = pn % nNr; }
        return (const char*)(g.Bt + e + (size_t)pn * 256 * g.ldb + ko); }
};

__device__ __forceinline__ i32x8 cat8(bf16x8 a, bf16x8 b) { const i32x4 x = __builtin_bit_cast(i32x4, a), y = __builtin_bit_cast(i32x4, b); return __builtin_shufflevector(x, y, 0, 1, 2, 3, 4, 5, 6, 7); }
struct BranchOrder {
    StaticOrder base;
    __device__ bool next(int i, Unit& u) const { if (i >= 3) return false; Unit t; if (!base.next(0, t)) return false; u.pm = t.pm; u.pn = 4 * i + t.pn; return true; }
    __device__ __forceinline__ int ntiles(const Unit& u, int nt) const { return (u.pn >> 2) == 1 ? nt / 2 : nt; }
    __device__ __forceinline__ const char* a_ptr(const Gemm& g, const Unit& u) const { return (const char*)g.A + (size_t)(u.pn >> 2) * (32u << 20) + (size_t)u.pm * 256 * g.lda * 2; }
    __device__ __forceinline__ const char* b_ptr(const Gemm& g, const Unit& u) const { return (const char*)g.Bt + (size_t)(u.pn >> 2) * (8u << 20) + (size_t)(u.pn & 3) * 256 * g.ldb * 2; }
};
template <bool F8, class Epi, class Sched>
__device__ __forceinline__ void gemm_phase_t(LAS unsigned char* lds, int wave_in, const Gemm g, const Sched& S, const Epi& E) {
    const int wid = opaque_s(wave_in), lane = lane_now(), tid = wid * 64 + lane, wr = wid >> 2, wc = wid & 3, fr = lane & 15, fq = lane >> 4;
    const int K = g.K, nt = K / BK;
    unsigned voffA[2], voffB[2];
#pragma unroll
    for (int i = 0; i < 2; ++i) { int R, C; stage_rc(tid * 16 + i * 8192, R, C); const int Rb = (R & ~31) + perm32(R & 31);
        voffA[i] = (unsigned)(R * g.lda + C) * 2u; voffB[i] = (unsigned)(Rb * g.ldb + C) * 2u; }
    const size_t kstep = (size_t)(BK * 2);
    const size_t hstepA = (size_t)HALF * g.lda * 2, hstepB = (size_t)HALF * g.ldb * 2;
    const unsigned ldsw = (unsigned)wid * 1024u, ldsb = (unsigned)(__SIZE_TYPE__)lds;
    const int aoff = lds_byte(wr * 64 + fr, fq * 8), boff = lds_byte(wc * 32 + fr, fq * 8);
#define PG8_SA(b, h) (((b) * 2 + (h)) * HTB)
#define PG8_SB(b, h) ((4 + (b) * 2 + (h)) * HTB)
#define PG8_STAGE(bufoff, gbase, voff) do { const char* gb_ = (const char*)(gbase); const unsigned l0_ = ldsb + (unsigned)(bufoff) + ldsw; \
        asm volatile("s_mov_b32 m0, %0\n\ts_nop 0\n\tglobal_load_lds_dwordx4 %1, %2" :: "s"(l0_), "v"((voff)[0]), "s"(gb_) : "memory", "m0"); \
        asm volatile("s_mov_b32 m0, %0\n\ts_nop 0\n\tglobal_load_lds_dwordx4 %1, %2" :: "s"(l0_ + 8192u), "v"((voff)[1]), "s"(gb_) : "memory", "m0"); } while (0)
#define PG8_LDA(dst, b, h) do { _Pragma("unroll") for (int m = 0; m < 4; ++m) _Pragma("unroll") for (int k = 0; k < 2; ++k) dst[m][k] = *(const LAS bf16x8*)(lds + PG8_SA(b, h) + aoff + m * 2048 + k * 1024); } while (0)
#define PG8_LDB(dst, b, h) do { _Pragma("unroll") for (int n = 0; n < 2; ++n) _Pragma("unroll") for (int k = 0; k < 2; ++k) dst[n][k] = *(const LAS bf16x8*)(lds + PG8_SB(b, h) + boff + n * 2048 + k * 1024); } while (0)
#define PG8_MMA(ai, bj, At, Bt) do { __builtin_amdgcn_s_setprio(1); _Pragma("unroll") for (int m = 0; m < 4; ++m) _Pragma("unroll") for (int n = 0; n < 2; ++n) { \
        if constexpr (F8) acc[ai][bj][m][n] = __builtin_amdgcn_mfma_scale_f32_16x16x128_f8f6f4(cat8(Bt[n][0], Bt[n][1]), cat8(At[m][0], At[m][1]), acc[ai][bj][m][n], 0, 0, 0, 0, 0, 0); \
        else { _Pragma("unroll") for (int k = 0; k < 2; ++k) acc[ai][bj][m][n] = __builtin_amdgcn_mfma_f32_16x16x32_bf16(Bt[n][k], At[m][k], acc[ai][bj][m][n], 0, 0, 0); } } __builtin_amdgcn_s_setprio(0); } while (0)
#define PG8_WAIT_V(n) asm volatile("s_waitcnt vmcnt(%0)" :: "n"(n) : "memory")
#define PG8_WAIT_L(n) asm volatile("s_waitcnt lgkmcnt(" #n ")" ::: "memory")
#define PG8_BAR __builtin_amdgcn_s_barrier()
#define PG8_SCHED __builtin_amdgcn_sched_barrier(0)
    Unit cur, nxt; int ui = 0;
    if (!S.next(0, cur)) return;
    f32x4 acc[2][2][4][2];
#pragma unroll
    for (int a = 0; a < 2; ++a)
#pragma unroll
        for (int b = 0; b < 2; ++b)
#pragma unroll
            for (int m = 0; m < 4; ++m)
#pragma unroll
                for (int n = 0; n < 2; ++n) acc[a][b][m][n] = (f32x4){0.f, 0.f, 0.f, 0.f};
    bf16x8 At[4][2], B0[2][2], B1[2][2];
    const char* cA = S.a_ptr(g, cur); const char* cB = S.b_ptr(g, cur);
    PG8_STAGE(PG8_SB(0, 0), cB, voffB); PG8_STAGE(PG8_SB(0, 1), cB + hstepB, voffB); PG8_STAGE(PG8_SA(0, 0), cA, voffA); PG8_STAGE(PG8_SA(0, 1), cA + hstepA, voffA);
    if (wr == 1) PG8_BAR;
    PG8_WAIT_V(2); PG8_BAR;
    PG8_STAGE(PG8_SB(1, 0), cB + kstep, voffB); PG8_STAGE(PG8_SA(1, 0), cA + kstep, voffA); PG8_STAGE(PG8_SB(1, 1), cB + hstepB + kstep, voffB);
    PG8_WAIT_V(6); PG8_BAR;
    if constexpr (Epi::kRelax) {
    PG8_STAGE(PG8_SA(1, 1), cA + kstep + hstepA, voffA);
    { const unsigned char* db = gp<unsigned char, (int)__builtin_offsetof(Params, ws)>(lds) + WS_CTL + 262144 + (size_t)blockIdx.x * 2048; const unsigned doff = (unsigned)tid * 4u, dz = 0u;
#pragma unroll
      for (int i = 0; i < Epi::kSt; ++i) asm volatile("global_store_dword %0, %1, %2" :: "v"(doff), "v"(dz), "s"(db) : "memory"); }
    }
    constexpr int VS = Epi::kSt;
    for (;;) {
        const bool has_next = S.next(ui + 1, nxt);
        const char* nA = has_next ? S.a_ptr(g, nxt) : cA; const char* nB = has_next ? S.b_ptr(g, nxt) : cB;
        if constexpr (Epi::kRelax) {
            const char* a2 = cA + (size_t)2 * kstep; const char* b2 = cB + (size_t)2 * kstep;
            const char* a3 = a2 + kstep; const char* b3 = b2 + kstep;
            PG8_LDB(B0, 0, 0); PG8_LDB(B1, 0, 1); PG8_SCHED; PG8_LDA(At, 0, 0);
            PG8_WAIT_V(10 + VS); PG8_WAIT_L(0); PG8_BAR; PG8_MMA(0, 0, At, B0); PG8_MMA(0, 1, At, B1); PG8_BAR; PG8_SCHED;
            PG8_LDA(At, 0, 1); PG8_STAGE(PG8_SB(0, 0), b2, voffB); PG8_STAGE(PG8_SB(0, 1), b2 + hstepB, voffB); PG8_STAGE(PG8_SA(0, 0), a2, voffA);
            PG8_WAIT_V(14 + VS); PG8_WAIT_L(0); PG8_BAR; PG8_MMA(1, 0, At, B0); PG8_MMA(1, 1, At, B1); PG8_BAR; PG8_SCHED;
            PG8_LDB(B0, 1, 0); PG8_LDB(B1, 1, 1); PG8_SCHED; PG8_LDA(At, 1, 0); PG8_STAGE(PG8_SA(0, 1), a2 + hstepA, voffA);
            PG8_WAIT_V(10 + VS); PG8_WAIT_L(0); PG8_BAR; PG8_MMA(0, 0, At, B0); PG8_MMA(0, 1, At, B1); PG8_BAR; PG8_SCHED;
            PG8_LDA(At, 1, 1); PG8_STAGE(PG8_SB(1, 0), b3, voffB); PG8_STAGE(PG8_SB(1, 1), b3 + hstepB, voffB); PG8_STAGE(PG8_SA(1, 0), a3, voffA);
            PG8_WAIT_V(14 + VS); PG8_WAIT_L(0); PG8_BAR; PG8_MMA(1, 0, At, B0); PG8_MMA(1, 1, At, B1); PG8_BAR; PG8_SCHED;
        }
        int ntc = nt; if constexpr (Epi::kTail) ntc = S.ntiles(cur, nt);
#pragma unroll 1
        for (int t = Epi::kRelax ? 2 : 0; t < ntc; t += 2) {
            asm volatile(".p2align 6" ::: "memory");
            const bool last = (t == ntc - 2);
            const char* a1 = cA + (size_t)(t + 1) * kstep;
            const char* a2 = last ? nA : cA + (size_t)(t + 2) * kstep; const char* b2 = last ? nB : cB + (size_t)(t + 2) * kstep;
            const char* a3 = a2 + kstep; const char* b3 = b2 + kstep;
            PG8_LDB(B0, 0, 0); PG8_LDB(B1, 0, 1); PG8_SCHED; PG8_LDA(At, 0, 0); PG8_STAGE(PG8_SA(1, 1), a1 + hstepA, voffA);
            PG8_WAIT_V(8); PG8_WAIT_L(0); PG8_BAR; PG8_MMA(0, 0, At, B0); PG8_MMA(0, 1, At, B1); PG8_BAR; PG8_SCHED;
            PG8_LDA(At, 0, 1); PG8_STAGE(PG8_SB(0, 0), b2, voffB); PG8_STAGE(PG8_SB(0, 1), b2 + hstepB, voffB); PG8_STAGE(PG8_SA(0, 0), a2, voffA);
            PG8_WAIT_V(8); PG8_WAIT_L(0); PG8_BAR; PG8_MMA(1, 0, At, B0); PG8_MMA(1, 1, At, B1); PG8_BAR; PG8_SCHED;
            PG8_LDB(B0, 1, 0); PG8_LDB(B1, 1, 1); PG8_SCHED; PG8_LDA(At, 1, 0); PG8_STAGE(PG8_SA(0, 1), a2 + hstepA, voffA);
            PG8_WAIT_V(8); PG8_WAIT_L(0); PG8_BAR; PG8_MMA(0, 0, At, B0); PG8_MMA(0, 1, At, B1); PG8_BAR; PG8_SCHED;
            PG8_LDA(At, 1, 1); PG8_STAGE(PG8_SB(1, 0), b3, voffB); PG8_STAGE(PG8_SB(1, 1), b3 + hstepB, voffB); PG8_STAGE(PG8_SA(1, 0), a3, voffA);
            PG8_WAIT_V(8); PG8_WAIT_L(0); PG8_BAR; PG8_MMA(1, 0, At, B0); PG8_MMA(1, 1, At, B1); PG8_BAR; PG8_SCHED;
        }
        if constexpr (Epi::kRelax) if (has_next) PG8_STAGE(PG8_SA(1, 1), nA + kstep + hstepA, voffA);
        if (wr == 0) PG8_BAR;
        { const int l2_ = lane_now(); E(acc, cur, wr, wc, l2_ & 15, l2_ >> 4); }
        if (!has_next) break;
#pragma unroll
        for (int a = 0; a < 2; ++a)
#pragma unroll
            for (int b = 0; b < 2; ++b)
#pragma unroll
                for (int m = 0; m < 4; ++m)
#pragma unroll
                    for (int n = 0; n < 2; ++n) acc[a][b][m][n] = (f32x4){0.f, 0.f, 0.f, 0.f};
        cur = nxt; cA = nA; cB = nB; ++ui;
        if (wr == 1) PG8_BAR;
    }
    PG8_WAIT_V(0);
    PG8_BAR;
#undef PG8_SA
#undef PG8_SB
#undef PG8_STAGE
#undef PG8_LDA
#undef PG8_LDB
#undef PG8_MMA
#undef PG8_WAIT_V
#undef PG8_WAIT_L
#undef PG8_BAR
#undef PG8_SCHED
}
template <class Epi, class Sched> __device__ __forceinline__ void gemm_phase(LAS unsigned char* lds, int wave_in, const Gemm g, const Sched& S, const Epi& E) { gemm_phase_t<false>(lds, wave_in, g, S, E); }
template <class Epi, class Sched> __device__ __forceinline__ void gemm_phase8(LAS unsigned char* lds, int wave_in, const Gemm g, const Sched& S, const Epi& E) { gemm_phase_t<true>(lds, wave_in, g, S, E); }
}
using pg8::Unit;
typedef f32x4 (&AccRef)[2][2][4][2];

__device__ __forceinline__ float clamp448(float x) { float y = __builtin_fmaxf(x, -448.f); asm volatile("" : "+v"(y)); return __builtin_fminf(y, 448.f); }
__device__ __forceinline__ unsigned pk4_fp8(float a, float b, float c, float d) {
    int r = 0;
    r = __builtin_amdgcn_cvt_pk_fp8_f32(clamp448(a), clamp448(b), r, false);
    r = __builtin_amdgcn_cvt_pk_fp8_f32(clamp448(c), clamp448(d), r, true);
    return (unsigned)r;
}
__device__ __forceinline__ void unpk8(const u32x4 w, f32x4& a, f32x4& b) {
    a = (f32x4){bf2f(w.x & 0xffffu), bf2f(w.x >> 16), bf2f(w.y & 0xffffu), bf2f(w.y >> 16)}; b = (f32x4){bf2f(w.z & 0xffffu), bf2f(w.z >> 16), bf2f(w.w & 0xffffu), bf2f(w.w >> 16)}; }
__device__ __forceinline__ u32x4 pack8(f32x4 v0, f32x4 v1) { u32x4 w; w.x = pk2(v0[0], v0[1]); w.y = pk2(v0[2], v0[3]); w.z = pk2(v1[0], v1[1]); w.w = pk2(v1[2], v1[3]); return w; }

#define GAS __attribute__((address_space(1)))
__device__ __forceinline__ u32x4 gld16(const void* base, unsigned off) { return *(const GAS u32x4*)((const GAS unsigned char*)base + off); }
__device__ __forceinline__ f32x4 gldf4(const void* base, unsigned off) { return *(const GAS f32x4*)((const GAS unsigned char*)base + off); }
__device__ __forceinline__ void gst16(void* base, unsigned off, u32x4 v) { *(GAS u32x4*)((GAS unsigned char*)base + off) = v; }
__device__ __forceinline__ void gst8(void* base, unsigned off, u32x2 v) { *(GAS u32x2*)((GAS unsigned char*)base + off) = v; }
__device__ __forceinline__ unsigned pk4_u8(f32x4 g) { unsigned r = 0;
    r = __builtin_amdgcn_cvt_pk_u8_f32(__builtin_rintf(g[0] * 255.f), 0, r); r = __builtin_amdgcn_cvt_pk_u8_f32(__builtin_rintf(g[1] * 255.f), 1, r);
    r = __builtin_amdgcn_cvt_pk_u8_f32(__builtin_rintf(g[2] * 255.f), 2, r); r = __builtin_amdgcn_cvt_pk_u8_f32(__builtin_rintf(g[3] * 255.f), 3, r); return r; }
__device__ __forceinline__ f32x4 un4_u8(unsigned w) { return (f32x4){(float)(w & 0xffu), (float)((w >> 8) & 0xffu), (float)((w >> 16) & 0xffu), (float)(w >> 24)} * (1.0f / 255.0f); }
__device__ __forceinline__ void gstf(void* base, unsigned off, float v) { *(GAS float*)((GAS unsigned char*)base + off) = v; }

__device__ __forceinline__ void store_lines(unsigned char* rowp0, unsigned voff, unsigned pitch8, bool lo, u32x4 p0, u32x4 p1) {
    u32x4 x = lo ? p1 : p0, r;
    r.x = (unsigned)__builtin_amdgcn_update_dpp(0, (int)x.x, 0x128, 0xf, 0xf, false); r.y = (unsigned)__builtin_amdgcn_update_dpp(0, (int)x.y, 0x128, 0xf, 0xf, false);
    r.z = (unsigned)__builtin_amdgcn_update_dpp(0, (int)x.z, 0x128, 0xf, 0xf, false); r.w = (unsigned)__builtin_amdgcn_update_dpp(0, (int)x.w, 0x128, 0xf, 0xf, false);
    __builtin_nontemporal_store(lo ? p0 : r, (GAS u32x4*)((GAS unsigned char*)rowp0 + voff));
    __builtin_nontemporal_store(lo ? r : p1, (GAS u32x4*)((GAS unsigned char*)(rowp0 + pitch8) + voff));
}
__device__ __forceinline__ void split_cs(const u32x4 a, const u32x4 b, f32x4& c0, f32x4& c1, f32x4& s0, f32x4& s1) {
    c0 = (f32x4){bf2f(a.x & 0xffffu), bf2f(a.y & 0xffffu), bf2f(a.z & 0xffffu), bf2f(a.w & 0xffffu)}; s0 = (f32x4){bf2f(a.x >> 16), bf2f(a.y >> 16), bf2f(a.z >> 16), bf2f(a.w >> 16)};
    c1 = (f32x4){bf2f(b.x & 0xffffu), bf2f(b.y & 0xffffu), bf2f(b.z & 0xffffu), bf2f(b.w & 0xffffu)}; s1 = (f32x4){bf2f(b.x >> 16), bf2f(b.y >> 16), bf2f(b.z >> 16), bf2f(b.w >> 16)};
}
#define EPI_FOR_AM _Pragma("unroll") for (int ai = 0; ai < 2; ++ai) _Pragma("unroll") for (int m = 0; m < 4; ++m)
struct EpiIn {
    static constexpr bool kTail = false;
    static constexpr bool kRelax = true;
    static constexpr int kSt = 16;
    bf16_t* plain; bf16_t* rope; float* ssq; const unsigned* csT; float sc;
    __device__ __forceinline__ void operator()(AccRef acc, const Unit& u, int wr, int wc, int fr, int fq) const {
        const int rowb = u.pm * 256 + wr * 64;
        const bool lo = fr < 8;
        if (u.pn >= 19 && u.pn < 31) {
            const unsigned vg = (unsigned)(fr * (PLAIN_W * 2) + 16 * fq);
            unsigned char* gb = (unsigned char*)(plain + (size_t)rowb * PLAIN_W + PC_GA) + (u.pn - 19) * 256;
            EPI_FOR_AM {
#pragma unroll
                for (int bj = 0; bj < 2; ++bj) {
                    f32x4 v0 = acc[ai][bj][m][0] * sc, v1 = acc[ai][bj][m][1] * sc;
#pragma unroll
                    for (int j = 0; j < 4; ++j) { v0[j] = fsigmoid(v0[j]); v1[j] = fsigmoid(v1[j]); }
                    u32x2 w; w.x = pk4_u8(v0); w.y = pk4_u8(v1);
                    const int r = 64 * wc + 32 * bj;
                    gst8(gb + (size_t)(ai * 128 + m * 16) * (PLAIN_W * 2) + 64 * ((r & 127) >> 5) + 8 * (r >> 7), vg, w);
                }
                __builtin_amdgcn_sched_barrier(0);
            }
        } else if (u.pn < 31) {
            const int act = u.pn >= 15 ? 2 : 0;
            const unsigned vl = (unsigned)((fr & 7) * (PLAIN_W * 2) + (lo ? 0 : 64) + 16 * fq), vs = (unsigned)(fr * 80);
            unsigned char* pb = (unsigned char*)(plain + (size_t)rowb * PLAIN_W + u.pn * 256 + wc * 64);
            float* sb = ssq + (size_t)rowb * 20 + u.pn * 4 + wc;
            EPI_FOR_AM {
                float ss = 0.f; u32x4 pk[2];
#pragma unroll
                for (int bj = 0; bj < 2; ++bj) {
                    f32x4 v0 = acc[ai][bj][m][0] * sc, v1 = acc[ai][bj][m][1] * sc;
                    if (u.pn < 5) {
#pragma unroll
                        for (int j = 0; j < 4; ++j) ss += v0[j] * v0[j] + v1[j] * v1[j];
                    }
                    if (act == 2) {
#pragma unroll
                        for (int j = 0; j < 4; ++j) { v0[j] = fsilu(v0[j]); v1[j] = fsilu(v1[j]); }
                    }
                    pk[bj] = pack8(v0, v1);
                }
                store_lines(pb + (size_t)(ai * 128 + m * 16) * (PLAIN_W * 2), vl, 8 * PLAIN_W * 2, lo, pk[0], pk[1]);
                if (u.pn < 5) {
                    ss = sum_x32(sum_x16(ss));
                    if (fq == 0) gstf(sb + (size_t)(ai * 128 + m * 16) * 20, vs, ss);
                }
            }
        } else {
            const int slot = (u.pn - 31) * 4 + wc;
            const unsigned vl = (unsigned)((fr & 7) * (ROPE_W * 2) + (lo ? 0 : 64) + 16 * fq), vc = (unsigned)(fr * 128 + fq * 32);
            const unsigned* cb = csT + (size_t)rowb * 32;
            unsigned char* rb = (unsigned char*)(rope + (size_t)rowb * ROPE_W + slot * 64);
            u32x4 csa[2][4], csb[2][4];
            EPI_FOR_AM { csa[ai][m] = gld16(cb + (ai * 128 + m * 16) * 32, vc); csb[ai][m] = gld16(cb + (ai * 128 + m * 16) * 32 + 4, vc); }
            EPI_FOR_AM {
                f32x4 c0, c1, s0, s1; split_cs(csa[ai][m], csb[ai][m], c0, c1, s0, s1);
                const f32x4 a0 = acc[ai][0][m][0] * sc, a1 = acc[ai][0][m][1] * sc, b0 = acc[ai][1][m][0] * sc, b1 = acc[ai][1][m][1] * sc;
                const f32x4 o10 = a0 * c0 - b0 * s0, o11 = a1 * c1 - b1 * s1, o20 = b0 * c0 + a0 * s0, o21 = b1 * c1 + a1 * s1;
                store_lines(rb + (size_t)(ai * 128 + m * 16) * (ROPE_W * 2), vl, 8 * ROPE_W * 2, lo, pack8(o10, o11), pack8(o20, o21));
            }
        }
    }
};
struct EpiQ {
    static constexpr bool kTail = false;
    static constexpr bool kRelax = true;
    static constexpr int kSt = 16;
    bf16_t* q; const float* ssq; const unsigned* csT; float c2;
    __device__ __forceinline__ void operator()(AccRef acc, const Unit& u, int wr, int wc, int fr, int fq) const {
        const int rowb = u.pm * 256 + wr * 64;
        const unsigned vs = (unsigned)(fr * 80), vq = (unsigned)(fr * (QW * 2) + fq * 16);
        const float* sb = ssq + (size_t)rowb * 20;
        float rs[2][4];
#pragma unroll
        for (int ai = 0; ai < 2; ++ai) {
            f32x4 p[4][3];
#pragma unroll
            for (int m = 0; m < 4; ++m) { const float* sp = sb + (ai * 128 + m * 16) * 20; p[m][0] = gldf4(sp, vs); p[m][1] = gldf4(sp + 4, vs); p[m][2] = gldf4(sp + 8, vs); }
#pragma unroll
            for (int m = 0; m < 4; ++m) {
                const float tot = ((p[m][0][0] + p[m][0][1]) + (p[m][0][2] + p[m][0][3])) + ((p[m][1][0] + p[m][1][1]) + (p[m][1][2] + p[m][1][3])) + ((p[m][2][0] + p[m][2][1]) + (p[m][2][2] + p[m][2][3]));
                rs[ai][m] = c2 * __builtin_amdgcn_rsqf(tot * (1.0f / 768.0f) + EPS); }
        }
        if (u.pn < 4) {
            bf16_t* qb = q + (size_t)rowb * QW + 2 * u.pn * 192 + wc * 32;
            EPI_FOR_AM {
                const float r = rs[ai][m];
#pragma unroll
                for (int bj = 0; bj < 2; ++bj) gst16(qb + (size_t)(ai * 128 + m * 16) * QW + bj * 192, vq, pack8(acc[ai][bj][m][0] * r, acc[ai][bj][m][1] * r));
            }
        } else {
            const int head = (u.pn - 4) * 4 + wc;
            const unsigned vc = (unsigned)(fr * 128 + fq * 32);
            const unsigned* cb = csT + (size_t)rowb * 32;
            bf16_t* qb = q + (size_t)rowb * QW + head * 192 + 128;
            u32x4 csa[2][4], csb[2][4];
            EPI_FOR_AM { csa[ai][m] = gld16(cb + (ai * 128 + m * 16) * 32, vc); csb[ai][m] = gld16(cb + (ai * 128 + m * 16) * 32 + 4, vc); }
            EPI_FOR_AM {
                const float r = rs[ai][m];
                f32x4 c0, c1, s0, s1; split_cs(csa[ai][m], csb[ai][m], c0, c1, s0, s1);
                const f32x4 a0 = acc[ai][0][m][0] * r, a1 = acc[ai][0][m][1] * r, b0 = acc[ai][1][m][0] * r, b1 = acc[ai][1][m][1] * r;
                bf16_t* dst = qb + (size_t)(ai * 128 + m * 16) * QW;
                gst16(dst, vq, pack8(a0 * c0 - b0 * s0, a1 * c1 - b1 * s1));
                gst16(dst + 32, vq, pack8(b0 * c0 + a0 * s0, b1 * c1 + a1 * s1));
            }
        }
    }
};
struct EpiKV {
    static constexpr bool kTail = false;
    static constexpr bool kRelax = true;
    static constexpr int kSt = 16;
    bf16_t* kv; const float* ssq;
    __device__ __forceinline__ void operator()(AccRef acc, const Unit& u, int wr, int wc, int fr, int fq) const {
        const int rowb = u.pm * 256 + wr * 64;
        const unsigned vs = (unsigned)(fr * 80), vk = (unsigned)(fr * (KVW * 2) + fq * 16);
        const float* sb = ssq + (size_t)rowb * 20 + 12;
        bf16_t* kb = kv + (size_t)rowb * KVW + u.pn * 256 + wc * 32;
        f32x4 p[2][4][2];
        EPI_FOR_AM { const float* sp = sb + (ai * 128 + m * 16) * 20; p[ai][m][0] = gldf4(sp, vs); p[ai][m][1] = gldf4(sp + 4, vs); }
        EPI_FOR_AM {
            const f32x4 p0 = p[ai][m][0], p1 = p[ai][m][1];
            const float tot = ((p0[0] + p0[1]) + (p0[2] + p0[3])) + ((p1[0] + p1[1]) + (p1[2] + p1[3]));
            const float rs = __builtin_amdgcn_rsqf(tot * (1.0f / 512.0f) + EPS);
#pragma unroll
            for (int bj = 0; bj < 2; ++bj) gst16(kb + (size_t)(ai * 128 + m * 16) * KVW + bj * 128, vk, pack8(acc[ai][bj][m][0] * rs, acc[ai][bj][m][1] * rs));
        }
    }
};
struct EpiQKV {
    static constexpr bool kAlign = true;
    static constexpr bool kTail = true;
    static constexpr bool kRelax = true;
    static constexpr int kSt = 16;
    EpiQ eq; EpiKV ek;
    __device__ __forceinline__ void operator()(AccRef acc, const Unit& u, int wr, int wc, int fr, int fq) const {
        if (u.pn < 8) eq(acc, u, wr, wc, fr, fq);
        else { Unit v; v.pm = u.pm; v.pn = u.pn - 8; ek(acc, v, wr, wc, fr, fq); }
    }
};
struct EpiBr {
    static constexpr bool kTail = true;
    static constexpr bool kRelax = true;
    static constexpr int kSt = 16;
    bf16_t* mf; bf16_t* mb; const unsigned char* gate;
    __device__ __forceinline__ void operator()(AccRef acc, const Unit& u, int wr, int wc, int fr, int fq) const {
        const int mode = u.pn >> 2, pn = u.pn & 3;
        const int rowb = u.pm * 256 + wr * 64, colb = pn * 256 + wc * 32;
        const unsigned vg = (unsigned)(fr * (PLAIN_W * 2) + fq * 16), vm = (unsigned)(fr * (DM * 2) + fq * 16);
        const unsigned char* gb = gate + mode * 1024 + (size_t)rowb * (PLAIN_W * 2) + pn * 256 + wc * 64;
        const bf16_t* fb = mf + (size_t)rowb * DM + colb;
        u32x4 gw[2][4]; u32x4 pw[2][4][2];
        EPI_FOR_AM { gw[ai][m] = gld16(gb + (size_t)(ai * 128 + m * 16) * (PLAIN_W * 2), vg); }
        if (mode != 0) {
            EPI_FOR_AM {
#pragma unroll
                for (int bj = 0; bj < 2; ++bj) pw[ai][m][bj] = gld16(fb + (size_t)(ai * 128 + m * 16) * DM + bj * 128, vm); }
        }
        EPI_FOR_AM { acc[ai][0][m][0] *= un4_u8(gw[ai][m].x); acc[ai][0][m][1] *= un4_u8(gw[ai][m].y); acc[ai][1][m][0] *= un4_u8(gw[ai][m].z); acc[ai][1][m][1] *= un4_u8(gw[ai][m].w); }
        if (mode != 0) {
            EPI_FOR_AM {
#pragma unroll
                for (int bj = 0; bj < 2; ++bj) { f32x4 v0, v1; unpk8(pw[ai][m][bj], v0, v1); acc[ai][bj][m][0] += v0; acc[ai][bj][m][1] += v1; } }
        }
        bf16_t* ob = ((mode != 2) ? mf : mb) + (size_t)rowb * DM + colb;
        EPI_FOR_AM {
#pragma unroll
            for (int bj = 0; bj < 2; ++bj) gst16(ob + (size_t)(ai * 128 + m * 16) * DM + bj * 128, vm, pack8(acc[ai][bj][m][0], acc[ai][bj][m][1])); }
    }
};
struct EpiRes {
    static constexpr bool kTail = false;
    static constexpr bool kRelax = true;
    static constexpr int kSt = 16;
    bf16_t* x; const float* gate; float sc;
    __device__ __forceinline__ void operator()(AccRef acc, const Unit& u, int wr, int wc, int fr, int fq) const {
        const int rowb = u.pm * 256 + wr * 64, colb = u.pn * 256 + wc * 32;
        const unsigned vm = (unsigned)(fr * (DM * 2) + fq * 16), vg = (unsigned)(fq * 32);
        const float* gp = gate + (size_t)(u.pm >> 3) * 6144 + colb;
        bf16_t* xb = x + (size_t)rowb * DM + colb;
        f32x4 g[2][2];
#pragma unroll
        for (int bj = 0; bj < 2; ++bj) { g[bj][0] = gldf4(gp + bj * 128, vg) * sc; g[bj][1] = gldf4(gp + bj * 128 + 4, vg) * sc; }
        u32x4 bw[2][4][2];
        EPI_FOR_AM {
#pragma unroll
            for (int bj = 0; bj < 2; ++bj) bw[ai][m][bj] = gld16(xb + (size_t)(ai * 128 + m * 16) * DM + bj * 128, vm); }
        EPI_FOR_AM {
#pragma unroll
            for (int bj = 0; bj < 2; ++bj) {
                f32x4 b0, b1; unpk8(bw[ai][m][bj], b0, b1);
                gst16(xb + (size_t)(ai * 128 + m * 16) * DM + bj * 128, vm, pack8(b0 + g[bj][0] * acc[ai][bj][m][0], b1 + g[bj][1] * acc[ai][bj][m][1]));
            } }
    }
};
struct EpiSwi {
    static constexpr bool kTail = false;
    static constexpr bool kRelax = true;
    static constexpr int kSt = 8;
    bf16_t* hid; int ld;
    __device__ __forceinline__ void operator()(AccRef acc, const Unit& u, int wr, int wc, int fr, int fq) const {
        const int rowb = u.pm * 256 + wr * 64;
        const unsigned vh = (unsigned)(fr * ld * 2 + fq * 16);
        bf16_t* hb = hid + (size_t)rowb * ld + u.pn * 128 + wc * 32;
        EPI_FOR_AM {
            f32x4 v0, v1;
#pragma unroll
            for (int j = 0; j < 4; ++j) { v0[j] = fsilu(acc[ai][0][m][0][j]) * acc[ai][1][m][0][j]; v1[j] = fsilu(acc[ai][0][m][1][j]) * acc[ai][1][m][1][j]; }
            gst16(hb + (size_t)(ai * 128 + m * 16) * ld, vh, pack8(v0, v1));
        }
    }
};
struct EpiSwi8 {
    static constexpr bool kTail = false;
    static constexpr bool kRelax = false;
    static constexpr int kSt = 4;
    unsigned char* hid; int ld; float si, so;
    __device__ __forceinline__ void operator()(AccRef acc, const Unit& u, int wr, int wc, int fr, int fq) const {
        const int rowb = u.pm * 256 + wr * 64;
        const unsigned vh = (unsigned)((fr + 16 * (fq & 1)) * ld + 16 * (fq >> 1));
        unsigned char* hb = hid + (size_t)rowb * ld + u.pn * 128 + wc * 32;
        const float s2 = si * so;
#pragma unroll
        for (int ai = 0; ai < 2; ++ai)
#pragma unroll
            for (int mp = 0; mp < 4; mp += 2) {
                unsigned w[2][2];
#pragma unroll
                for (int mm = 0; mm < 2; ++mm)
#pragma unroll
                    for (int n = 0; n < 2; ++n) {
                        float v[4];
#pragma unroll
                        for (int j = 0; j < 4; ++j) v[j] = fsilu(acc[ai][0][mp + mm][n][j] * si) * (acc[ai][1][mp + mm][n][j] * s2);
                        w[mm][n] = pk4_fp8(v[0], v[1], v[2], v[3]);
                    }
                const auto r0 = __builtin_amdgcn_permlane16_swap(w[0][0], w[1][0], false, false);
                const auto r1 = __builtin_amdgcn_permlane16_swap(w[0][1], w[1][1], false, false);
                u32x4 o; o.x = r0[0]; o.y = r1[0]; o.z = r0[1]; o.w = r1[1];
                gst16(hb + (size_t)(ai * 128 + mp * 16) * ld, vh, o);
                __builtin_amdgcn_sched_barrier(0);
            }
    }
};
struct EpiPlain {
    static constexpr bool kTail = true;
    static constexpr bool kRelax = true;
    static constexpr int kSt = 16;
    bf16_t* o; int ld; int nNr; bf16_t* o2; float sc; int nM; size_t pstride;
    __device__ __forceinline__ void operator()(AccRef acc, const Unit& u, int wr, int wc, int fr, int fq) const {
        const bool tail = u.pn >= nNr;
        const int rowb = (tail ? u.pm - nM : u.pm) * 256 + wr * 64;
        const unsigned vo = (unsigned)(fr * ld * 2 + fq * 16);
        bf16_t* ob = (tail ? o2 + (size_t)(u.pn / nNr - 1) * pstride : this->o) + (size_t)rowb * ld + (u.pn % nNr) * 256 + wc * 32;
        EPI_FOR_AM {
#pragma unroll
            for (int bj = 0; bj < 2; ++bj) gst16(ob + (size_t)(ai * 128 + m * 16) * ld + bj * 128, vo, pack8(acc[ai][bj][m][0] * sc, acc[ai][bj][m][1] * sc)); }
    }
};
#undef EPI_FOR_AM

struct Frame {
    LAS unsigned char* lds; int tid, lane, wave, G, gw, ngw;
};
__device__ __forceinline__ Frame mkframe0(LAS unsigned char* lds) { Frame F; F.lds = lds; F.tid = opaque(threadIdx.x); F.lane = F.tid & 63; F.wave = __builtin_amdgcn_readfirstlane(F.tid >> 6);
    F.G = gridDim.x; F.gw = blockIdx.x * 8 + F.wave; F.ngw = F.G * 8; return F; }
__device__ __forceinline__ Frame mkframe(const Frame& F0) { Frame F; F.lds = F0.lds; F.wave = opaque_s(F0.wave); F.lane = lane_now(); F.tid = F.wave * 64 + F.lane;
    F.G = gridDim.x; F.gw = blockIdx.x * 8 + F.wave; F.ngw = F.G * 8; return F; }

constexpr int MOE_MAIN_BLK = 128, MOE_TAIL_ROWS = 8 * 256;
constexpr float W13E_SC = 32.f, W2E_SC = 64.f, HID8_SC = 4.f, WIN_SC = 32.f;
struct CvtDesc { const float* src; const float* gain; unsigned char* dst; int ld, Kd, n0, k0; float sn; int valid, f8; };
__device__ __forceinline__ void cvt_load(const CvtDesc& d, float (&v)[32], int lane) {
    if (d.valid) {
#pragma unroll
        for (int i = 0; i < 32; ++i) v[i] = __builtin_nontemporal_load(d.src + (size_t)(d.k0 + 2 * i + (lane >> 5)) * d.ld + (lane & 31));
    } else {
#pragma unroll
        for (int i = 0; i < 32; ++i) v[i] = 0.f;
    }
}
__device__ __forceinline__ void cvt_store(const CvtDesc& d, float (&v)[32], LAS float* scr, int lane) {
    if (d.gain) {
#pragma unroll
        for (int i = 0; i < 32; ++i) v[i] *= d.gain[d.k0 + 2 * i + (lane >> 5)];
    }
#pragma unroll
    for (int i = 0; i < 32; ++i) scr[(2 * i + (lane >> 5)) * 33 + (lane & 31)] = v[i] * d.sn;
    asm volatile("s_waitcnt lgkmcnt(0)" ::: "memory");
    const int c = lane & 7;
    if (d.f8) {
#pragma unroll
        for (int j = 0; j < 4; ++j) { const int n = (lane >> 3) + 8 * j; const LAS float* s = scr + (8 * c) * 33 + n;
            u32x2 o; o.x = pk4_fp8(s[0 * 33], s[1 * 33], s[2 * 33], s[3 * 33]); o.y = pk4_fp8(s[4 * 33], s[5 * 33], s[6 * 33], s[7 * 33]);
            *(u32x2*)(d.dst + (size_t)(d.n0 + n) * d.Kd + d.k0 + 8 * c) = o; }
    } else {
#pragma unroll
        for (int j = 0; j < 4; ++j) { const int n = (lane >> 3) + 8 * j; const LAS float* s = scr + (8 * c) * 33 + n;
            u32x4 o; o.x = pk2(s[0 * 33], s[1 * 33]); o.y = pk2(s[2 * 33], s[3 * 33]); o.z = pk2(s[4 * 33], s[5 * 33]); o.w = pk2(s[6 * 33], s[7 * 33]);
            __builtin_nontemporal_store(o, (u32x4*)(d.dst + ((size_t)(d.n0 + n) * d.Kd + d.k0 + 8 * c) * 2)); }
    }
    asm volatile("s_waitcnt lgkmcnt(0)" ::: "memory");
}
__device__ __forceinline__ void win_map(int nb, int& c0, float& sn) {
    int n0 = nb * 32; sn = 1.f;
    if (n0 < PLAIN_W) {
        { const int p = n0 & 255, bj = p >> 7, wc_ = (p >> 5) & 3; n0 = (n0 & ~255) + 64 * wc_ + 32 * bj; }
        if (n0 < PC_DV) { c0 = n0; return; }
        if (n0 < PC_RV) { c0 = 4416 + (n0 - PC_DV); return; }
        if (n0 < PC_RG) { c0 = 6976 + (n0 - PC_RV); return; }
        c0 = 8000 + (n0 - PC_RG); return;
    }
    const int r = n0 - PLAIN_W, tile = r >> 8, p = r & 255, bj = p >> 7, hh = (p & 127) >> 5;
    const int slot = tile * 4 + hh;
    int base;
    if (slot == 0) base = 1280;
    else if (slot < RS_DK) { base = 1344 + (slot - RS_DQ) * 64; sn = 0.125f; }
    else if (slot < RS_RQ) base = 2880 + (slot - RS_DK) * 64;
    else if (slot < RS_RK) base = 5952 + (slot - RS_RQ) * 64;
    else if (slot < 65) { base = 6464 + (slot - RS_RK) * 64; sn = 0.125f; }
    else { c0 = -1; return; }
    c0 = base + bj * 32;
}
__device__ __forceinline__ void cvt_decode(Frame& F, unsigned char* ws, int r, bool moe_only, int moe_layer, CvtDesc& d) {
    constexpr int I_WIN = 4 * 16 * 384, I_UQ = 4 * 12 * 48, I_UKV = 4 * 8 * 64, I_BM = 4 * 16 * 32, I_BD = 4 * 8 * 32, I_BR = 4 * 16 * 32, I_WO = 4 * 16 * 32;
    constexpr int I_F13 = 2 * 16 * 176, I_F2 = 2 * 44 * 32, I_M13 = 8 * 16 * 224;
    d.gain = nullptr; d.sn = 1.f; d.valid = 1; d.f8 = 0;
#define CVT_SET(SRC, LD, DST, KD, N0, K0) do { d.src = (SRC); d.ld = (LD); d.dst = (unsigned char*)(DST); d.Kd = (KD); d.n0 = (N0); d.k0 = (K0); } while (0)
    if (!moe_only) {
        if (r < I_WIN) { const int l = r / (16 * 384), q = r % (16 * 384), kb = 2 * (q / 768) + (q & 1), nb = (q % 768) >> 1; int c0; float sn; win_map(nb, c0, sn);
            CVT_SET(GP(const float, w_in) + (size_t)l * DM * IN_COLS + (c0 < 0 ? 0 : c0), IN_COLS, ws + WS_WIN + (size_t)l * NIN * DM, DM, nb * 32, kb * 64); d.valid = c0 >= 0; d.sn = sn * WIN_SC; d.f8 = 1; return; } r -= I_WIN;
        if (r < I_UQ) { const int l = r / (12 * 48), q = r % (12 * 48), kb = q / 48, nb = q % 48; const int n0 = nb * 32; int c0;
            if (n0 < 1024) { const int head = n0 >> 7; c0 = head * 192 + (n0 & 127); }
            else { const int rr = n0 - 1024, tile = rr >> 8, p = rr & 255, bj = p >> 7, hh = (p & 127) >> 5; c0 = (tile * 4 + hh) * 192 + 128 + bj * 32; }
            CVT_SET(GP(const float, w_uq) + (size_t)l * 768 * QW + c0, QW, (bf16_t*)(ws + WS_WUQ) + (size_t)l * QW * 768, 768, n0, kb * 64); d.gain = GP(const float, q_norm) + l * 768; return; } r -= I_UQ;
        if (r < I_UKV) { const int l = r / (8 * 64), q = r % (8 * 64), kb = q / 64, nb = q % 64;
            CVT_SET(GP(const float, w_ukv) + (size_t)l * 512 * KVW + nb * 32, KVW, (bf16_t*)(ws + WS_WUKV) + (size_t)l * KVW * 768, 768, nb * 32, kb * 64); d.gain = GP(const float, kv_norm) + l * 512; return; } r -= I_UKV;
        if (r < I_BM) { const int l = r / (16 * 32), q = r % (16 * 32), kb = q / 32, nb = q % 32;
            CVT_SET(GP(const float, w_br_mla) + (size_t)l * DM * DM + nb * 32, DM, (bf16_t*)(ws + WS_WBM) + (size_t)l * DM * DM, DM, nb * 32, kb * 64); return; } r -= I_BM;
        if (r < I_BD) { const int l = r / (8 * 32), q = r % (8 * 32), kb = q / 32, nb = q % 32;
            CVT_SET(GP(const float, w_br_dil) + (size_t)l * 512 * DM + nb * 32, DM, (bf16_t*)(ws + WS_WBD) + (size_t)l * DM * DM, DM, nb * 32, kb * 64); return; } r -= I_BD;
        if (r < I_BR) { const int l = r / (16 * 32), q = r % (16 * 32), kb = q / 32, nb = q % 32;
            CVT_SET(GP(const float, w_br_ret) + (size_t)l * DM * DM + nb * 32, DM, (bf16_t*)(ws + WS_WBR) + (size_t)l * DM * DM, DM, nb * 32, kb * 64); return; } r -= I_BR;
        if (r < I_WO) { const int l = r / (16 * 32), q = r % (16 * 32), kb = q / 32, nb = q % 32;
            CVT_SET(GP(const float, w_out) + (size_t)l * DM * DM + nb * 32, DM, (bf16_t*)(ws + WS_WO) + (size_t)l * DM * DM, DM, nb * 32, kb * 64); return; } r -= I_WO;
        if (r < I_F13) { const int i = r / (16 * 176), q = r % (16 * 176), kb = q / 176, nb = q % 176; const int n0 = nb * 32, tile = n0 >> 8, p = n0 & 255;
            const float* src = (p < 128 ? GP(const float, ffn_w1) : GP(const float, ffn_w3)) + (size_t)i * DM * DFF;
            CVT_SET(src + tile * 128 + (p & 127), DFF, (bf16_t*)(ws + WS_W13) + (size_t)i * 5632 * DM, DM, n0, kb * 64); return; } r -= I_F13;
        if (r < I_F2) { const int i = r / (44 * 32), q = r % (44 * 32), kb = q / 32, nb = q % 32;
            CVT_SET(GP(const float, ffn_w2) + (size_t)i * DFF * DM + nb * 32, DM, (bf16_t*)(ws + WS_W2) + (size_t)i * DM * DFF, DFF, nb * 32, kb * 64); return; } r -= I_F2;
    }
    if (r < I_M13) { const int e = r / (16 * 224), q = r % (16 * 224), kb = 2 * (q / 448) + (q & 1), nb = (q % 448) >> 1; const int n0 = nb * 32, tile = n0 >> 8, p = n0 & 255;
        const float* src = (p < 128 ? GP(const float, moe_w1) : GP(const float, moe_w3)) + ((size_t)moe_layer * NEXP + e) * DM * DFE;
        CVT_SET(src + tile * 128 + (p & 127), DFE, ws + WS_W13E + (size_t)e * 7168 * DM, DM, n0, kb * 64); d.sn = W13E_SC; d.f8 = 1; return; } r -= I_M13;
    { const int e = r / (56 * 32), q = r % (56 * 32), kb = 2 * (q / 64) + (q & 1), nb = (q % 64) >> 1;
        CVT_SET(GP(const float, moe_w2) + ((size_t)moe_layer * NEXP + e) * DFE * DM + nb * 32, DM, ws + WS_W2E + (size_t)e * DM * DFE, DFE, nb * 32, kb * 64); d.sn = W2E_SC; d.f8 = 1; }
#undef CVT_SET
}
__device__ __forceinline__ void p0_convert(Frame& F0, bool moe_only, int moe_layer) {
    Frame F = mkframe(F0);
    LAS float* scr = (LAS float*)(F.lds + F.wave * 16384);
    unsigned char* ws = WSP();
    constexpr int I_WIN = 4 * 16 * 384, I_UQ = 4 * 12 * 48, I_UKV = 4 * 8 * 64, I_BM = 4 * 16 * 32, I_BD = 4 * 8 * 32, I_BR = 4 * 16 * 32, I_WO = 4 * 16 * 32;
    constexpr int I_F13 = 2 * 16 * 176, I_F2 = 2 * 44 * 32, I_M13 = 8 * 16 * 224, I_M2 = 8 * 56 * 32;
    constexpr int I_ALL = I_WIN + I_UQ + I_UKV + I_BM + I_BD + I_BR + I_WO + I_F13 + I_F2;
    const int total = moe_only ? (I_M13 + I_M2) : (I_ALL + I_M13 + I_M2);
    int it = F.gw;
    if (it < total) {
        CvtDesc dc; float v[32];
        cvt_decode(F, ws, it, moe_only, moe_layer, dc); cvt_load(dc, v, F.lane);
#pragma unroll 1
        for (;;) {
            const int itn = it + F.ngw; const bool hn = itn < total;
            CvtDesc dn; float vn[32];
            if (hn) { cvt_decode(F, ws, itn, moe_only, moe_layer, dn); cvt_load(dn, vn, F.lane); }
            cvt_store(dc, v, scr, F.lane);
            if (!hn) break;
            dc = dn; it = itn;
#pragma unroll
            for (int i = 0; i < 32; ++i) v[i] = vn[i];
        }
    }
    __syncthreads();
}
__device__ __forceinline__ void p0_tables(Frame& F0) {
    Frame F = mkframe(F0);
    unsigned* csT = (unsigned*)(WSP() + WS_COS);
    { const float* xf = GP(const float, x); bf16_t* xb = (bf16_t*)(WSP() + WS_X);
      for (size_t i = (size_t)blockIdx.x * 512 + F.tid; i < (size_t)T * DM / 8; i += (size_t)F.G * 512) {
          const f32x4 a = *((const f32x4*)xf + 2 * i), b = *((const f32x4*)xf + 2 * i + 1); __builtin_nontemporal_store(pack8(a, b), (u32x4*)xb + i); } }
    const int* pos = GP(const int, positions);
    for (int i = blockIdx.x * 512 + F.tid; i < T * 32; i += F.G * 512) {
        const int t = i >> 5, f = i & 31;
        const double rev = (double)pos[t] * ((const volatile LAS double*)(F.lds + LDS_PTRS + (int)__builtin_offsetof(Params, inv_freq)))[f] * 0.15915494309189533577;
        const double fr = rev - __builtin_rint(rev);
        csT[i] = pk2(__builtin_amdgcn_cosf((float)fr), __builtin_amdgcn_sinf((float)fr));
    }
    float* modp = (float*)(WSP() + WS_MODP);
    LAS float* cact = (LAS float*)F.lds;
    { const float* cp = GP(const float, c); for (int i = F.tid; i < 8 * DM; i += 512) cact[i] = fsilu(cp[i]); }
    __syncthreads();
    for (int it = F.gw; it < 4 * 96 * 16; it += F.ngw) {
        const int sl = it & 15, cg = (it >> 4) % 96, l = it / (16 * 96);
        const int n = cg * 64 + F.lane;
        float acc[8];
#pragma unroll
        for (int b = 0; b < 8; ++b) acc[b] = 0.f;
        const float* w = GP(const float, ada_w) + (size_t)l * DM * 6144 + n + (size_t)sl * 64 * 6144;
#pragma unroll 1
        for (int k8 = 0; k8 < 8; ++k8) {
            float wv[8];
#pragma unroll
            for (int q = 0; q < 8; ++q) wv[q] = __builtin_nontemporal_load(w + (size_t)(k8 * 8 + q) * 6144);
#pragma unroll
            for (int q = 0; q < 8; ++q)
#pragma unroll
                for (int b = 0; b < 8; ++b) acc[b] += cact[b * DM + sl * 64 + k8 * 8 + q] * wv[q];
        }
#pragma unroll
        for (int b = 0; b < 8; ++b) modp[(((size_t)sl * 4 + l) * 8 + b) * 6144 + n] = acc[b];
    }
    __syncthreads();
}
__device__ __forceinline__ void p0_modreduce(Frame& F0) {
    Frame F = mkframe(F0);
    const float* modp = (const float*)(WSP() + WS_MODP); float* mod = (float*)(WSP() + WS_MOD);
    for (int i = blockIdx.x * 512 + F.tid; i < 4 * 8 * 6144; i += F.G * 512) {
        const int n = i % 6144, l = i / (8 * 6144);
        float s = GP(const float, ada_b)[l * 6144 + n];
        for (int sl = 0; sl < 16; ++sl) s += modp[(size_t)sl * 4 * 8 * 6144 + i];
        mod[i] = s;
    }
}

__device__ __forceinline__ void unpack8(const u32x4 w, f32x4& a, f32x4& b) {
    a = (f32x4){bf2f(w.x & 0xffffu), bf2f(w.x >> 16), bf2f(w.y & 0xffffu), bf2f(w.y >> 16)}; b = (f32x4){bf2f(w.z & 0xffffu), bf2f(w.z >> 16), bf2f(w.w & 0xffffu), bf2f(w.w >> 16)}; }
template <bool COMBINE, bool ROUTER, bool FINAL, bool H8>
__device__ __forceinline__ void phase_norm(Frame& F0, float* fout, const float* gvec, const float* scale, const float* shift, const float* gate2,
                                           const float* wr) {
    Frame F = mkframe(F0);
    bf16_t* H = (bf16_t*)(WSP() + WS_H); bf16_t* X = (bf16_t*)(WSP() + WS_X);
    int* moei = (int*)(WSP() + WS_MOEI);
    const bf16_t* YB = (const bf16_t*)(WSP() + WS_YB); const bf16_t* YB2 = (const bf16_t*)(WSP() + WS_XG); float* ssq2 = (float*)(WSP() + WS_SSQ);
    (void)ssq2;
#define NIDX(j) (2 * F.lane + 128 * ((j) >> 1) + ((j) & 1))
    for (int ch = F.gw; ch < T / 8; ch += F.ngw) {
        const int b = (ch * 8) >> 11;
        const size_t bo = (size_t)opaque_s(b * 6144);
        int cnt[8];
#pragma unroll
        for (int e = 0; e < 8; ++e) cnt[e] = 0;
        f32x4 gs[4], sh[4], g2[4];
#pragma unroll
        for (int j = 0; j < 4; ++j) {
            const f32x4 g = *((const f32x4*)gvec + NIDX(j));
            if (FINAL) { gs[j] = g; sh[j] = (f32x4){0.f, 0.f, 0.f, 0.f}; }
            else { const f32x4 sc = *((const f32x4*)(scale + bo) + NIDX(j)); sh[j] = *((const f32x4*)(shift + bo) + NIDX(j)); gs[j] = g * (1.0f + sc); }
            if (COMBINE) g2[j] = *((const f32x4*)(gate2 + bo) + NIDX(j));
        }
        constexpr int RF = COMBINE ? 4 : 8;
        for (int half = 0; half < 8 / RF; ++half) {
            const int row0 = ch * 8 + half * RF;
            f32x4 v[RF][4];
#pragma unroll
            for (int r = 0; r < RF; ++r)
#pragma unroll
                for (int c = 0; c < 2; ++c) unpack8(*((const u32x4*)(X + (size_t)(row0 + r) * DM) + F.lane + 64 * c), v[r][2 * c], v[r][2 * c + 1]);
            if (COMBINE) {
                u32x4 ya[RF][2], yc[RF][2]; float w0[RF], w1[RF]; int pp[RF][2];
#pragma unroll
                for (int r = 0; r < RF; ++r) {
                    pp[r][0] = moei[MI_TOKP + 2 * (row0 + r)]; pp[r][1] = moei[MI_TOKP + 2 * (row0 + r) + 1];
                    w0[r] = __int_as_float(moei[MI_TOKW + 2 * (row0 + r)]); w1[r] = __int_as_float(moei[MI_TOKW + 2 * (row0 + r) + 1]); }
#pragma unroll
                for (int r = 0; r < RF; ++r)
#pragma unroll
                    for (int c = 0; c < 2; ++c) { ya[r][c] = *((const u32x4*)(YB + (size_t)pp[r][0] * DM) + F.lane + 64 * c); yc[r][c] = *((const u32x4*)(YB + (size_t)pp[r][1] * DM) + F.lane + 64 * c); }
                bool anyt = false;
#pragma unroll
                for (int r = 0; r < RF; ++r) anyt = anyt || (pp[r][0] >= MOE_MAIN_BLK * 256) || (pp[r][1] >= MOE_MAIN_BLK * 256);
                if (anyt) {
#pragma unroll
                    for (int r = 0; r < RF; ++r)
#pragma unroll
                        for (int q = 0; q < 2; ++q) {
                            if (pp[r][q] >= MOE_MAIN_BLK * 256) {
#pragma unroll
                                for (int c = 0; c < 2; ++c) { f32x4 s0 = {0.f, 0.f, 0.f, 0.f}, s1 = s0;
#pragma unroll
                                    for (int k = 0; k < pg8::KT_SPLIT; ++k) { f32x4 a0, a1; unpack8(*((const u32x4*)(YB2 + ((size_t)k * MOE_TAIL_ROWS + (pp[r][q] - MOE_MAIN_BLK * 256)) * DM) + F.lane + 64 * c), a0, a1); s0 += a0; s1 += a1; }
                                    if (q == 0) ya[r][c] = pack8(s0, s1); else yc[r][c] = pack8(s0, s1); } } }
                }
#pragma unroll
                for (int r = 0; r < RF; ++r)
#pragma unroll
                    for (int c = 0; c < 2; ++c) {
                        f32x4 a0, a1, c0, c1; unpack8(ya[r][c], a0, a1); unpack8(yc[r][c], c0, c1);
                        v[r][2 * c] = v[r][2 * c] + g2[2 * c] * (w0[r] * a0 + w1[r] * c0);
                        v[r][2 * c + 1] = v[r][2 * c + 1] + g2[2 * c + 1] * (w0[r] * a1 + w1[r] * c1);
                        if (!FINAL) __builtin_nontemporal_store(pack8(v[r][2 * c], v[r][2 * c + 1]), (u32x4*)(X + (size_t)(row0 + r) * DM) + F.lane + 64 * c);
                    }
            }
#pragma unroll
            for (int r = 0; r < RF; ++r) {
                const int row = row0 + r;
                float s = 0.f;
#pragma unroll
                for (int j = 0; j < 4; ++j) s += (v[r][j][0] * v[r][j][0] + v[r][j][1] * v[r][j][1]) + (v[r][j][2] * v[r][j][2] + v[r][j][3] * v[r][j][3]);
                const float rs = __builtin_amdgcn_rsqf(wave_sum(s) * (1.0f / DM) + EPS);
                if (FINAL) {
#pragma unroll
                    for (int j = 0; j < 4; ++j) __builtin_nontemporal_store(v[r][j] * rs * gs[j], (f32x4*)(fout + (size_t)row * DM) + NIDX(j));
                    continue;
                }
                f32x4 h[4];
#pragma unroll
                for (int j = 0; j < 4; ++j) h[j] = v[r][j] * rs * gs[j] + sh[j];
#pragma unroll
                for (int c = 0; c < 2; ++c) {
                    if (H8) { u32x2 o; o.x = pk4_fp8(h[2 * c][0], h[2 * c][1], h[2 * c][2], h[2 * c][3]); o.y = pk4_fp8(h[2 * c + 1][0], h[2 * c + 1][1], h[2 * c + 1][2], h[2 * c + 1][3]);
                        __builtin_nontemporal_store(o, (u32x2*)((unsigned char*)H + (size_t)row * DM) + F.lane + 64 * c); }
                    else __builtin_nontemporal_store(pack8(h[2 * c], h[2 * c + 1]), (u32x4*)(H + (size_t)row * DM) + F.lane + 64 * c);
                }
                if (ROUTER) {
                    float lg[8];
#pragma unroll
                    for (int e = 0; e < 8; ++e) lg[e] = 0.f;
#pragma unroll
                    for (int j = 0; j < 4; ++j)
#pragma unroll
                        for (int q = 0; q < 4; ++q) {
                            const int k = 8 * F.lane + 512 * (j >> 1) + 4 * (j & 1) + q;
                            const f32x4 wa = *(const f32x4*)(wr + (size_t)k * 8), wb = *(const f32x4*)(wr + (size_t)k * 8 + 4);
                            const float hv = h[j][q];
                            lg[0] += hv * wa[0]; lg[1] += hv * wa[1]; lg[2] += hv * wa[2]; lg[3] += hv * wa[3];
                            lg[4] += hv * wb[0]; lg[5] += hv * wb[1]; lg[6] += hv * wb[2]; lg[7] += hv * wb[3];
                        }
#pragma unroll
                    for (int e = 0; e < 8; ++e) lg[e] = wave_sum(lg[e]);
                    int e0 = 0; float v0 = lg[0];
#pragma unroll
                    for (int e = 1; e < 8; ++e) if (lg[e] > v0) { v0 = lg[e]; e0 = e; }
                    int e1 = -1; float v1 = __int_as_float(opaque((int)0xff61b1e6));
#pragma unroll
                    for (int e = 0; e < 8; ++e) if (e != e0 && lg[e] > v1) { v1 = lg[e]; e1 = e; }
                    const float ex = __expf(v1 - v0), w0 = 1.0f / (1.0f + ex), w1 = ex / (1.0f + ex);
                    if (F.lane == 0) { moei[MI_TOKE + 2 * row] = e0; moei[MI_TOKE + 2 * row + 1] = e1; moei[MI_TOKW + 2 * row] = __float_as_int(w0); moei[MI_TOKW + 2 * row + 1] = __float_as_int(w1); }
#pragma unroll
                    for (int e = 0; e < 8; ++e) cnt[e] += (e == e0) + (e == e1);
                }
            }
        }
        if (ROUTER && F.lane == 0) {
#pragma unroll
            for (int e = 0; e < 8; ++e) moei[MI_CNT + ch * 8 + e] = cnt[e];
        }
    }
#undef NIDX
}

__device__ __forceinline__ void phase_moe_gather(Frame& F0) {
    Frame F = mkframe(F0);
    int* moei = (int*)(WSP() + WS_MOEI);
    LAS int* pre = (LAS int*)F.lds;
    LAS int* seg = (LAS int*)(F.lds + 65536);
    LAS int* pst = (LAS int*)(F.lds + 65536 + 4096);
    const int e = F.tid & 7, sg = F.tid >> 3;
    {
        int run = 0;
        for (int i = 0; i < 32; ++i) { const int ch = sg * 32 + i; const int c = moei[MI_CNT + ch * 8 + e]; pre[ch * 8 + e] = run; run += c; }
        seg[sg * 8 + e] = run;
    }
    __syncthreads();
    if (F.tid < 8) {
        int run = 0;
        for (int s = 0; s < 64; ++s) { const int c = seg[s * 8 + F.tid]; seg[s * 8 + F.tid] = run; run += c; }
        seg[64 * 8 + F.tid] = run;
    }
    __syncthreads();
    if (F.tid < 8) {
        const int tot = seg[64 * 8 + F.tid]; const int padded = (tot + 255) & ~255;
        int ps = 0;
        for (int q = 0; q < 8; ++q) { const int pq = __builtin_amdgcn_readlane(padded, q); if (q < F.tid) ps += pq; }
        pst[F.tid] = ps;
        if (blockIdx.x == 0) {
            for (int q = 0; q < (padded >> 8); ++q) moei[MI_BLK + 1 + (ps >> 8) + q] = F.tid;
            if (F.tid == 7) moei[MI_BLK] = (ps + padded) >> 8;
        }
    }
    __syncthreads();
    const unsigned char* H = WSP() + WS_H; unsigned char* XG = WSP() + WS_XG;
    for (int ch = F.gw; ch < T / 8; ch += F.ngw) {
        const int a = F.lane & 15; const int row = ch * 8 + (a >> 1);
        const int ea = moei[MI_TOKE + 2 * row + (a & 1)];
        int rank = 0;
        for (int q = 0; q < 16; ++q) { const int eq = __builtin_amdgcn_readlane(ea, q); if (q < a && eq == ea) ++rank; }
        const int dest = pst[ea] + seg[(ch >> 5) * 8 + ea] + pre[ch * 8 + ea] + rank;
        if (F.lane < 16) moei[MI_TOKP + 2 * row + (a & 1)] = dest;
        for (int q = 0; q < 16; ++q) {
            const int dq = __builtin_amdgcn_readlane(dest, q); const int rq = ch * 8 + (q >> 1);
            __builtin_nontemporal_store(*(const u32x4*)(H + (size_t)rq * DM + 16 * F.lane), (u32x4*)(XG + (size_t)dq * DM + 16 * F.lane));
        }
    }
    __syncthreads();
}

namespace mla {
constexpr int KROW = 400;
constexpr int SHM_K = 64 * KROW, SHM_V = 64 * 128 * 2;
constexpr int OFF_V = 0, OFF_K = 2 * SHM_V, OFF_WS = 2 * SHM_V + 2 * SHM_K;
__device__ __forceinline__ int crow(int r, int hi) { return (r & 3) + 8 * (r >> 2) + 4 * hi; }
__device__ __forceinline__ int v_st(int k, int c) { const int kk = (k & ~0xC) | ((k & 4) << 1) | ((k & 8) >> 1); return ((kk >> 3) * 4 + (c >> 5)) * 512 + ((kk & 7) * 32 + (c & 31)) * 2; }
__device__ __forceinline__ int v_rd_base(int lane) { return ((lane & 3) << 3) | (((lane >> 2) & 3) << 6) | (((lane >> 4) & 1) << 5) | (((lane >> 5) & 1) << 8); }
constexpr int v_rd_off(int d0, int ks, int half) { return d0 * 512 + ks * 4096 + half * 2048; }
template <int OFF> __device__ __forceinline__ s16x4 tr_read(LAS unsigned char* vb) { return __builtin_amdgcn_ds_read_tr16_b64_v4i16((LAS s16x4*)(vb + OFF)); }
template <int D0> __device__ __forceinline__ void pv_one(f32x16& od, LAS unsigned char* vb, bf16x8 pa0, bf16x8 pa1, bf16x8 pa2, bf16x8 pa3) {
    const s16x4 l0 = tr_read<v_rd_off(D0, 0, 0)>(vb), h0 = tr_read<v_rd_off(D0, 0, 1)>(vb), l1 = tr_read<v_rd_off(D0, 1, 0)>(vb), h1 = tr_read<v_rd_off(D0, 1, 1)>(vb);
    const s16x4 l2 = tr_read<v_rd_off(D0, 2, 0)>(vb), h2 = tr_read<v_rd_off(D0, 2, 1)>(vb), l3 = tr_read<v_rd_off(D0, 3, 0)>(vb), h3 = tr_read<v_rd_off(D0, 3, 1)>(vb);
#define PK(L, H) (bf16x8){L[0], L[1], L[2], L[3], H[0], H[1], H[2], H[3]}
    od = __builtin_amdgcn_mfma_f32_32x32x16_bf16(pa0, PK(l0, h0), od, 0, 0, 0);
    od = __builtin_amdgcn_mfma_f32_32x32x16_bf16(pa1, PK(l1, h1), od, 0, 0, 0);
    od = __builtin_amdgcn_mfma_f32_32x32x16_bf16(pa2, PK(l2, h2), od, 0, 0, 0);
    od = __builtin_amdgcn_mfma_f32_32x32x16_bf16(pa3, PK(l3, h3), od, 0, 0, 0);
#undef PK
}
template <int D0> __device__ __forceinline__ void pv_load(s16x4 (&v)[8], LAS unsigned char* vb) {
    v[0] = tr_read<v_rd_off(D0, 0, 0)>(vb); v[1] = tr_read<v_rd_off(D0, 0, 1)>(vb); v[2] = tr_read<v_rd_off(D0, 1, 0)>(vb); v[3] = tr_read<v_rd_off(D0, 1, 1)>(vb);
    v[4] = tr_read<v_rd_off(D0, 2, 0)>(vb); v[5] = tr_read<v_rd_off(D0, 2, 1)>(vb); v[6] = tr_read<v_rd_off(D0, 3, 0)>(vb); v[7] = tr_read<v_rd_off(D0, 3, 1)>(vb); }
__device__ __forceinline__ void pv_mma(f32x16& od, const s16x4 (&v)[8], bf16x8 pa0, bf16x8 pa1, bf16x8 pa2, bf16x8 pa3) {
#define PK(L, H) (bf16x8){L[0], L[1], L[2], L[3], H[0], H[1], H[2], H[3]}
    od = __builtin_amdgcn_mfma_f32_32x32x16_bf16(pa0, PK(v[0], v[1]), od, 0, 0, 0);
    od = __builtin_amdgcn_mfma_f32_32x32x16_bf16(pa1, PK(v[2], v[3]), od, 0, 0, 0);
    od = __builtin_amdgcn_mfma_f32_32x32x16_bf16(pa2, PK(v[4], v[5]), od, 0, 0, 0);
    od = __builtin_amdgcn_mfma_f32_32x32x16_bf16(pa3, PK(v[6], v[7]), od, 0, 0, 0);
#undef PK
}
constexpr int G_V = 0, G_KN = 16384, G_KR = 32768, G_SLOT = 40960, G_WS = 2 * G_SLOT;
__device__ __forceinline__ void unit(const bf16_t* Qb, const bf16_t* Kn, const bf16_t* Kr, const bf16_t* Vh, bf16_t* Ob, LAS unsigned char* lds, int tid) {
    const int wid = __builtin_amdgcn_readfirstlane(tid >> 6), lane = tid & 63, r32 = lane & 31, hi = lane >> 5;
    LAS float* wsf = (LAS float*)(lds + G_WS) + wid * 64; LAS float* li_l = wsf; LAS float* al_l = wsf + 32;
    float m_reg = -1e30f, l_reg = 0.f; f32x16 o[4];
#pragma unroll
    for (int d = 0; d < 4; ++d)
#pragma unroll
        for (int r = 0; r < 16; ++r) o[d][r] = 0.f;
    bf16x8 qr[12];
    const bf16_t* Qw = Qb + (size_t)(wid * 32 + r32) * QW + hi * 8;
#pragma unroll
    for (int d0 = 0; d0 < 12; ++d0) qr[d0] = *(const bf16x8*)(Qw + d0 * 16);
    unsigned okn[2], ov[2], okr;
#pragma unroll
    for (int i = 0; i < 2; ++i) { const int p = wid + 8 * i;
        { const int row = 4 * p + (lane >> 4), c = (lane & 15) ^ (row & 15); okn[i] = (unsigned)(row * KVW * 2 + c * 16); }
        { const int d = p * 1024 + lane * 16, sub = d >> 9, within = d & 511, kk = (sub >> 2) * 8 + (within >> 6), col = (sub & 3) * 32 + ((within & 63) >> 4) * 8;
          const int k = (kk & ~0xC) | ((kk & 4) << 1) | ((kk & 8) >> 1); ov[i] = (unsigned)(k * KVW * 2 + col * 2); } }
    { const int row = 8 * wid + (lane >> 3), c = (lane & 7) ^ ((row >> 1) & 7); okr = (unsigned)(row * ROPE_W * 2 + c * 16); }
#define MLA_DMA(gp, off, ldsoff) asm volatile("s_mov_b32 m0, %0\n\ts_nop 0\n\tglobal_load_lds_dwordx4 %1, %2" :: "s"(ldsb + (unsigned)(ldsoff)), "v"(off), "s"(gp) : "memory", "m0")
#define MLA_GLDS(k0, s) do { const char* kn_ = (const char*)Kn + (size_t)(k0) * KVW * 2; const char* v_ = (const char*)Vh + (size_t)(k0) * KVW * 2; const char* kr_ = (const char*)Kr + (size_t)(k0) * ROPE_W * 2; \
        const unsigned sb_ = (unsigned)((s) * G_SLOT) + (unsigned)wid * 1024u; \
        MLA_DMA(kn_, okn[0], sb_ + G_KN); MLA_DMA(kn_, okn[1], sb_ + G_KN + 8192); MLA_DMA(kr_, okr, sb_ + G_KR); MLA_DMA(v_, ov[0], sb_ + G_V); MLA_DMA(v_, ov[1], sb_ + G_V + 8192); } while (0)
    const unsigned ldsb = (unsigned)(__SIZE_TYPE__)lds;
    const int vrb = v_rd_base(lane);
    const int knx = (r32 & 15) << 4, krx = ((r32 >> 1) & 7) << 4;
    constexpr int NT = SEQ / 64;
    MLA_GLDS(0, 0);
    asm volatile("s_waitcnt vmcnt(0)" ::: "memory"); __syncthreads();
    for (int j = 0; j < NT; ++j) {
        const int bsel = j & 1;
        if (j + 1 < NT) MLA_GLDS((j + 1) * 64, bsel ^ 1);
        LAS unsigned char* sb = lds + bsel * G_SLOT;
        f32x16 p0, p1;
#pragma unroll
        for (int r = 0; r < 16; ++r) { p0[r] = 0.f; p1[r] = 0.f; }
        bf16x8 kb0[2], kb1[2];
#define MLA_KLD(d0_, s_) do { if ((d0_) < 8) { const int cb = (((d0_) * 2 + hi) << 4) ^ knx; kb0[s_] = *(const LAS bf16x8*)(sb + G_KN + r32 * 256 + cb); kb1[s_] = *(const LAS bf16x8*)(sb + G_KN + (32 + r32) * 256 + cb); } \
            else { const int cb = ((((d0_) - 8) * 2 + hi) << 4) ^ krx; kb0[s_] = *(const LAS bf16x8*)(sb + G_KR + r32 * 128 + cb); kb1[s_] = *(const LAS bf16x8*)(sb + G_KR + (32 + r32) * 128 + cb); } } while (0)
        MLA_KLD(0, 0);
#pragma unroll
        for (int d0 = 0; d0 < 12; ++d0) {
            if (d0 + 1 < 12) MLA_KLD(d0 + 1, (d0 + 1) & 1);
            __builtin_amdgcn_sched_barrier(0);
            p0 = __builtin_amdgcn_mfma_f32_32x32x16_bf16(kb0[d0 & 1], qr[d0], p0, 0, 0, 0);
            p1 = __builtin_amdgcn_mfma_f32_32x32x16_bf16(kb1[d0 & 1], qr[d0], p1, 0, 0, 0);
            __builtin_amdgcn_sched_barrier(0);
        }
#undef MLA_KLD
        float pmax = p0[0];
#pragma unroll
        for (int r = 1; r < 16; ++r) pmax = fmaxf(pmax, p0[r]);
#pragma unroll
        for (int r = 0; r < 16; ++r) pmax = fmaxf(pmax, p1[r]);
        { auto sw = __builtin_amdgcn_permlane32_swap(__float_as_uint(pmax), __float_as_uint(pmax), false, false); pmax = fmaxf(__uint_as_float(sw[0]), __uint_as_float(sw[1])); }
        float alpha = 1.f;
        if (!__all(pmax - m_reg <= 11.0f)) { const float mn = fmaxf(m_reg, pmax); alpha = __builtin_amdgcn_exp2f(m_reg - mn); m_reg = mn; }
#pragma unroll
        for (int r = 0; r < 16; ++r) { p0[r] = __builtin_amdgcn_exp2f(p0[r] - m_reg); p1[r] = __builtin_amdgcn_exp2f(p1[r] - m_reg); }
        float ps = 0.f;
#pragma unroll
        for (int r = 0; r < 16; ++r) ps += p0[r];
#pragma unroll
        for (int r = 0; r < 16; ++r) ps += p1[r];
        { auto sw = __builtin_amdgcn_permlane32_swap(__float_as_uint(ps), __float_as_uint(ps), false, false); ps = __uint_as_float(sw[0]) + __uint_as_float(sw[1]); }
        l_reg = l_reg * alpha + ps;
        if (__any(alpha < 1.f)) {
            if (hi == 0) al_l[r32] = alpha;
            asm volatile("s_waitcnt lgkmcnt(0)" ::: "memory");
#pragma unroll
            for (int r = 0; r < 16; ++r) { const float al = al_l[crow(r, hi)];
#pragma unroll
                for (int d = 0; d < 4; ++d) o[d][r] *= al; }
        }
        bf16x8 pa0, pa1, pa2, pa3;
#define PK4(P_, BASE, OUT) do { unsigned a0 = pk2(P_[BASE + 0], P_[BASE + 1]), a1 = pk2(P_[BASE + 2], P_[BASE + 3]); \
    unsigned b0 = pk2(P_[BASE + 4], P_[BASE + 5]), b1 = pk2(P_[BASE + 6], P_[BASE + 7]); \
    auto r0 = __builtin_amdgcn_permlane32_swap(a0, b0, false, false); auto r1 = __builtin_amdgcn_permlane32_swap(a1, b1, false, false); \
    u32x4 w = {r0[0], r1[0], r0[1], r1[1]}; OUT = *reinterpret_cast<bf16x8*>(&w); } while (0)
        PK4(p0, 0, pa0); PK4(p0, 8, pa1); PK4(p1, 0, pa2); PK4(p1, 8, pa3);
#undef PK4
        LAS unsigned char* vb = sb + G_V + vrb;
        {
            s16x4 vf[2][8];
            pv_load<0>(vf[0], vb);
            __builtin_amdgcn_sched_barrier(0);
            pv_load<1>(vf[1], vb); __builtin_amdgcn_sched_barrier(0); pv_mma(o[0], vf[0], pa0, pa1, pa2, pa3); __builtin_amdgcn_sched_barrier(0);
            pv_load<2>(vf[0], vb); __builtin_amdgcn_sched_barrier(0); pv_mma(o[1], vf[1], pa0, pa1, pa2, pa3); __builtin_amdgcn_sched_barrier(0);
            pv_load<3>(vf[1], vb); __builtin_amdgcn_sched_barrier(0); pv_mma(o[2], vf[0], pa0, pa1, pa2, pa3); __builtin_amdgcn_sched_barrier(0);
            pv_mma(o[3], vf[1], pa0, pa1, pa2, pa3);
        }
        asm volatile("s_waitcnt vmcnt(0)" ::: "memory");
        __syncthreads();
    }
    if (hi == 0) li_l[r32] = l_reg;
    asm volatile("s_waitcnt lgkmcnt(0)" ::: "memory");
    bf16_t* Ow = Ob + (size_t)(wid * 32) * DM;
#pragma unroll
    for (int r = 0; r < 16; ++r) { const int orow = crow(r, hi); const float rl = 1.0f / li_l[orow];
#pragma unroll
        for (int d0 = 0; d0 < 4; ++d0) Ow[(size_t)orow * DM + d0 * 32 + r32] = (bf16_t)f2bf(o[d0][r] * rl); }
    __syncthreads();
#undef MLA_GLDS
#undef MLA_DMA
}
}
__device__ __forceinline__ void phase_mla(Frame& F0) {
    Frame F = mkframe(F0);
    const bf16_t* Q = (const bf16_t*)(WSP() + WS_Q); const bf16_t* KV = (const bf16_t*)(WSP() + WS_KV); const bf16_t* RP = (const bf16_t*)(WSP() + WS_ROPE);
    bf16_t* Y = (bf16_t*)(WSP() + WS_YMLA);
    for (int u0 = blockIdx.x; u0 < 512; u0 += F.G) {
        int u = u0;
        if (F.G == 256) { const int x = blockIdx.x & 7, i = blockIdx.x >> 3; u = (u0 & 256) + ((x * 4 + (i >> 3)) << 3) + (i & 7); }
        const int qb = u & 7, h = (u >> 3) & 7, b = u >> 6;
        const size_t t0 = (size_t)b * SEQ;
        mla::unit(Q + (t0 + qb * 256) * QW + h * 192, KV + t0 * KVW + h * 256, RP + t0 * ROPE_W + RS_KR * 64, KV + t0 * KVW + h * 256 + 128,
                  Y + (t0 + qb * 256) * DM + h * 128, F.lds, F.tid);
    }
}

__device__ __forceinline__ void phase_dilated(Frame& F0) {
    Frame F = mkframe(F0);
    const bf16_t* RP = (const bf16_t*)(WSP() + WS_ROPE); const bf16_t* PL = (const bf16_t*)(WSP() + WS_PLAIN);
    bf16_t* DO = (bf16_t*)(WSP() + WS_DILO); float* LSE = (float*)(WSP() + WS_LSE);
    constexpr int LD = 72;
    const int slot = F.wave >> 2, qt = F.wave & 3, tt = F.tid & 255, g4 = F.lane >> 4, l15 = F.lane & 15;
    LAS bf16_t* Kl = (LAS bf16_t*)(F.lds + slot * 55296); LAS bf16_t* Vl = Kl + 192 * LD;
    int p_lo, p_hi, p_st;
    if (F.G == 256) { const int c = blockIdx.x; constexpr int PA = 20, PB = 24 - PA; if (c < 128) { p_lo = c * PA; p_hi = p_lo + PA; } else { p_lo = 128 * PA + (c - 128) * PB; p_hi = p_lo + PB; } p_st = 1; }
    else { p_lo = blockIdx.x; p_hi = 3072; p_st = F.G; }
    bf16x8 kreg[6], vreg[6];
#define DIL_DECODE(pair_) const int it = (pair_) * 2 + slot; const int b = it / 768, rem = it % 768, g = rem >> 8, hh = (rem >> 5) & 7, blk = rem & 31; \
        const int sh = 2 * g, nbk = 32 >> sh, L = SEQ >> sh; const int r = blk / nbk, n = blk % nbk;
#define DIL_LOAD(pair_) do { DIL_DECODE(pair_) \
        _Pragma("unroll") for (int q = 0; q < 6; ++q) { const int ci = tt + 256 * q, c = ci >> 3, col8 = (ci & 7) * 8; \
            const int jk = (n - 1) * 64 + c; const bool ok = (jk >= 0) && (jk < L); \
            kreg[q] = (bf16x8){0, 0, 0, 0, 0, 0, 0, 0}; vreg[q] = (bf16x8){0, 0, 0, 0, 0, 0, 0, 0}; \
            if (ok) { const size_t tok = (size_t)b * SEQ + ((size_t)jk << sh) + r; \
                kreg[q] = *(const bf16x8*)(RP + tok * ROPE_W + (RS_DK + g * 8 + hh) * 64 + col8); \
                vreg[q] = *(const bf16x8*)(PL + tok * PLAIN_W + PC_DV + (g * 8 + hh) * 64 + col8); } } } while (0)
    if (p_lo < p_hi) DIL_LOAD(p_lo);
    for (int pair = p_lo; pair < p_hi; pair += p_st) {
        DIL_DECODE(pair)
#pragma unroll
        for (int q = 0; q < 6; ++q) { const int ci = tt + 256 * q, c = ci >> 3, col8 = (ci & 7) * 8;
            *(LAS bf16x8*)(Kl + c * LD + col8) = kreg[q]; *(LAS bf16x8*)(Vl + c * LD + col8) = vreg[q]; }
        __syncthreads();
        if (pair + p_st < p_hi) DIL_LOAD(pair + p_st);
        const int iq = qt * 16 + l15;
        const size_t tokq = (size_t)b * SEQ + ((size_t)(n * 64 + iq) << sh) + r;
        bf16x8 qf[2];
#pragma unroll
        for (int ks = 0; ks < 2; ++ks) qf[ks] = *(const bf16x8*)(RP + tokq * ROPE_W + (RS_DQ + g * 8 + hh) * 64 + ks * 32 + 8 * g4);
        f32x4 s[9];
        const float NEG = __int_as_float(opaque((int)0xf149f2ca));
        LAS bf16_t* Kq = Kl + (16 * qt) * LD; LAS bf16_t* Vq = Vl + (16 * qt) * LD;
        {
            bf16x8 kfa[9][2];
#pragma unroll
            for (int ct = 0; ct < 9; ++ct)
#pragma unroll
                for (int ks = 0; ks < 2; ++ks) kfa[ct][ks] = *(const LAS bf16x8*)(Kq + (16 * ct + l15) * LD + ks * 32 + 8 * g4);
            __builtin_amdgcn_sched_barrier(0);
#pragma unroll
            for (int ct = 0; ct < 9; ++ct) { s[ct] = (f32x4){0.f, 0.f, 0.f, 0.f};
#pragma unroll
                for (int ks = 0; ks < 2; ++ks) s[ct] = __builtin_amdgcn_mfma_f32_16x16x32_bf16(kfa[ct][ks], qf[ks], s[ct], 0, 0, 0); }
            __builtin_amdgcn_sched_barrier(0);
        }
#pragma unroll
        for (int rg = 0; rg < 4; ++rg) { const int e = 4 * g4 + rg; s[0][rg] = (e >= l15) ? s[0][rg] : NEG; s[8][rg] = (e <= l15) ? s[8][rg] : NEG; }
        if (n == 0) {
#pragma unroll
            for (int ct = 0; ct < 9; ++ct)
#pragma unroll
                for (int rg = 0; rg < 4; ++rg) { const int c = 16 * (qt + ct) + 4 * g4 + rg; s[ct][rg] = (c >= 64) ? s[ct][rg] : NEG; }
        }
        if (n == nbk - 1) {
#pragma unroll
            for (int ct = 0; ct < 9; ++ct)
#pragma unroll
                for (int rg = 0; rg < 4; ++rg) { const int c = 16 * (qt + ct) + 4 * g4 + rg; s[ct][rg] = (c < 128) ? s[ct][rg] : NEG; }
        }
        float mx = NEG;
#pragma unroll
        for (int ct = 0; ct < 9; ++ct)
#pragma unroll
            for (int rg = 0; rg < 4; ++rg) mx = fmaxf(mx, s[ct][rg]);
        mx = max_x32(max_x16(mx));
        float sum = 0.f;
#pragma unroll
        for (int ct = 0; ct < 9; ++ct)
#pragma unroll
            for (int rg = 0; rg < 4; ++rg) { const float pv = __builtin_amdgcn_exp2f((s[ct][rg] - mx) * 1.4426950408889634f); s[ct][rg] = pv; sum += pv; }
        sum = sum_x32(sum_x16(sum));
        const float inv = __builtin_amdgcn_rcpf(sum);
        f32x4 o[4];
#pragma unroll
        for (int dt = 0; dt < 4; ++dt) o[dt] = (f32x4){0.f, 0.f, 0.f, 0.f};
        bf16x8 pfa[5];
#pragma unroll
        for (int s2 = 0; s2 < 5; ++s2) {
            const int ta = (s2 < 4) ? 2 * s2 : 7, tb = ta + 1;
            u32x4 pw; pw.x = (s2 < 4) ? pk2(s[ta][0], s[ta][1]) : 0u; pw.y = (s2 < 4) ? pk2(s[ta][2], s[ta][3]) : 0u; pw.z = pk2(s[tb][0], s[tb][1]); pw.w = pk2(s[tb][2], s[tb][3]);
            pfa[s2] = *reinterpret_cast<bf16x8*>(&pw); }
#pragma unroll
        for (int dh = 0; dh < 2; ++dh) {
            s16x4 vlo[5][2], vhi[5][2];
#pragma unroll
            for (int s2 = 0; s2 < 5; ++s2)
#pragma unroll
                for (int d2 = 0; d2 < 2; ++d2) { const int ta = (s2 < 4) ? 2 * s2 : 7, dt = 2 * dh + d2;
                    LAS bf16_t* va = Vq + (16 * ta + 4 * g4 + ((F.lane >> 2) & 3)) * LD + 16 * dt + 4 * (F.lane & 3);
                    vlo[s2][d2] = __builtin_amdgcn_ds_read_tr16_b64_v4i16((LAS s16x4*)va); vhi[s2][d2] = __builtin_amdgcn_ds_read_tr16_b64_v4i16((LAS s16x4*)(va + 16 * LD)); }
            __builtin_amdgcn_sched_barrier(0);
#pragma unroll
            for (int s2 = 0; s2 < 5; ++s2)
#pragma unroll
                for (int d2 = 0; d2 < 2; ++d2) { const s16x4 lo = vlo[s2][d2], hi = vhi[s2][d2];
                    const bf16x8 vf = {lo[0], lo[1], lo[2], lo[3], hi[0], hi[1], hi[2], hi[3]};
                    o[2 * dh + d2] = __builtin_amdgcn_mfma_f32_16x16x32_bf16(vf, pfa[s2], o[2 * dh + d2], 0, 0, 0); }
            __builtin_amdgcn_sched_barrier(0);
        }
        bf16_t* dst = DO + ((size_t)g * T + tokq) * 512 + hh * 64 + 4 * g4;
#pragma unroll
        for (int dt = 0; dt < 4; ++dt) { u32x2 w; w.x = pk2(o[dt][0] * inv, o[dt][1] * inv); w.y = pk2(o[dt][2] * inv, o[dt][3] * inv); *(u32x2*)(dst + 16 * dt) = w; }
        if (g4 == 0) LSE[((size_t)g * T + tokq) * 8 + hh] = mx + __logf(sum);
        __syncthreads();
    }
#undef DIL_DECODE
#undef DIL_LOAD
}
__device__ __forceinline__ void phase_dil_merge(Frame& F0) {
    Frame F = mkframe(F0);
    const bf16_t* DO = (const bf16_t*)(WSP() + WS_DILO); const float* LSE = (const float*)(WSP() + WS_LSE); bf16_t* Y = (bf16_t*)(WSP() + WS_YDIL);
    const int hh = F.lane >> 3;
    for (int t0 = F.gw; t0 < T; t0 += 4 * F.ngw) {
        float l[4][3]; u32x4 v[4][3];
#pragma unroll
        for (int k = 0; k < 4; ++k) { const int t = t0 + k * F.ngw;
#pragma unroll
            for (int g = 0; g < 3; ++g) { l[k][g] = 0.f; v[k][g] = (u32x4){0u, 0u, 0u, 0u};
                if (t < T) { l[k][g] = LSE[((size_t)g * T + t) * 8 + hh]; v[k][g] = *((const u32x4*)(DO + ((size_t)g * T + t) * 512) + F.lane); } } }
#pragma unroll
        for (int k = 0; k < 4; ++k) { const int t = t0 + k * F.ngw; if (t >= T) continue;
            const float m = fmaxf(l[k][0], fmaxf(l[k][1], l[k][2])); const float e0 = __expf(l[k][0] - m), e1 = __expf(l[k][1] - m), e2 = __expf(l[k][2] - m); const float is = __builtin_amdgcn_rcpf(e0 + e1 + e2);
            const float w[3] = {e0 * is, e1 * is, e2 * is};
            float acc[8];
#pragma unroll
            for (int j = 0; j < 8; ++j) acc[j] = 0.f;
#pragma unroll
            for (int g = 0; g < 3; ++g) { const u32x4 q = v[k][g];
                acc[0] += w[g] * bf2f(q.x & 0xffffu); acc[1] += w[g] * bf2f(q.x >> 16); acc[2] += w[g] * bf2f(q.y & 0xffffu); acc[3] += w[g] * bf2f(q.y >> 16);
                acc[4] += w[g] * bf2f(q.z & 0xffffu); acc[5] += w[g] * bf2f(q.z >> 16); acc[6] += w[g] * bf2f(q.w & 0xffffu); acc[7] += w[g] * bf2f(q.w >> 16); }
            u32x4 o; o.x = pk2(acc[0], acc[1]); o.y = pk2(acc[2], acc[3]); o.z = pk2(acc[4], acc[5]); o.w = pk2(acc[6], acc[7]);
            __builtin_nontemporal_store(o, (u32x4*)(Y + (size_t)t * DM) + F.lane); }
    }
}

__device__ __forceinline__ void phase_retention(Frame& F0, int layer) {
    Frame F = mkframe(F0);
    const bf16_t* RP = (const bf16_t*)(WSP() + WS_ROPE); const bf16_t* PL = (const bf16_t*)(WSP() + WS_PLAIN);
    constexpr int LQ = 72, LV = 136;
    LAS bf16_t* Ql = (LAS bf16_t*)F.lds; LAS bf16_t* Kl = Ql + 128 * LQ; LAS bf16_t* Stl = Kl + 128 * LQ; LAS bf16_t* Vl = Stl + 128 * LQ;
    LAS float* Stf = (LAS float*)(F.lds + 90112);
    const int w = F.wave, g4 = F.lane >> 4, l15 = F.lane & 15;
    const int u0 = (F.G == 256) ? ((int)blockIdx.x - 128) : (int)blockIdx.x;
    for (int u = u0; u >= 0 && u < 128; u += F.G) {
        const int b = u >> 4, hh = (u >> 1) & 7, dir = u & 1;
        const float lg = GP(const float, ret_ld)[(layer * 2 + dir) * 8 + hh];
        bf16_t* YR = (bf16_t*)(WSP() + (dir ? WS_YRB : WS_YRF));
        for (int i = F.tid; i < 128 * LQ / 2; i += 512) ((LAS unsigned*)Stl)[i] = 0u;
        for (int i = F.tid; i < 128 * 64; i += 512) Stf[i] = 0.f;
        const float cdec = __expf(lg * 128.0f), ginv = __expf(-lg);
        bf16x8 rq[2], rk[2], rv[4];
#define RET_LOAD(c_) do { _Pragma("unroll") for (int q = 0; q < 2; ++q) { const int ci = F.tid + 512 * q, i = ci >> 3, col8 = (ci & 7) * 8; \
                const size_t tok = (size_t)b * SEQ + (dir ? (SEQ - 1 - (128 * (c_) + i)) : (128 * (c_) + i)); \
                rq[q] = *(const bf16x8*)(RP + tok * ROPE_W + (RS_RQ + hh) * 64 + col8); rk[q] = *(const bf16x8*)(RP + tok * ROPE_W + (RS_RK + hh) * 64 + col8); } \
            _Pragma("unroll") for (int q = 0; q < 4; ++q) { const int ci = F.tid + 512 * q, i = ci >> 4, col8 = (ci & 15) * 8; \
                const size_t tok = (size_t)b * SEQ + (dir ? (SEQ - 1 - (128 * (c_) + i)) : (128 * (c_) + i)); \
                rv[q] = *(const bf16x8*)(PL + tok * PLAIN_W + PC_RV + hh * 128 + col8); } } while (0)
        RET_LOAD(0);
        for (int c = 0; c < 16; ++c) {
#pragma unroll
            for (int q = 0; q < 2; ++q) { const int ci = F.tid + 512 * q, i = ci >> 3, col8 = (ci & 7) * 8;
                *(LAS bf16x8*)(Ql + i * LQ + col8) = rq[q]; *(LAS bf16x8*)(Kl + i * LQ + col8) = rk[q]; }
#pragma unroll
            for (int q = 0; q < 4; ++q) { const int ci = F.tid + 512 * q, i = ci >> 4, col8 = (ci & 15) * 8;
                *(LAS bf16x8*)(Vl + i * LV + col8) = rv[q]; }
            __syncthreads();
            if (c + 1 < 16) RET_LOAD(c + 1);
            const int iq = 16 * w + l15;
            bf16x8 qf[2];
#pragma unroll
            for (int ks = 0; ks < 2; ++ks) qf[ks] = *(const LAS bf16x8*)(Ql + iq * LQ + ks * 32 + 8 * g4);
            bf16x8 pf[4];
#pragma unroll
            for (int s2 = 0; s2 < 4; ++s2) {
                f32x4 sa[2];
#pragma unroll
                for (int h2 = 0; h2 < 2; ++h2) { const int jt = 2 * s2 + h2; sa[h2] = (f32x4){0.f, 0.f, 0.f, 0.f};
                    if (jt <= w) {
#pragma unroll
                        for (int ks = 0; ks < 2; ++ks) { const bf16x8 kf = *(const LAS bf16x8*)(Kl + (16 * jt + l15) * LQ + ks * 32 + 8 * g4);
                            sa[h2] = __builtin_amdgcn_mfma_f32_16x16x32_bf16(kf, qf[ks], sa[h2], 0, 0, 0); }
#pragma unroll
                        for (int rg = 0; rg < 4; ++rg) { const int j = 16 * jt + 4 * g4 + rg; const int df = iq - j; const bool ok = dir ? (df > 0) : (df >= 0);
                            sa[h2][rg] = ok ? sa[h2][rg] * __expf(lg * (float)df) : 0.f; } } }
                u32x4 pw; pw.x = pk2(sa[0][0], sa[0][1]); pw.y = pk2(sa[0][2], sa[0][3]); pw.z = pk2(sa[1][0], sa[1][1]); pw.w = pk2(sa[1][2], sa[1][3]);
                pf[s2] = *reinterpret_cast<bf16x8*>(&pw);
            }
            const float qd = __expf(lg * (float)(iq + 1));
            const size_t tokq = (size_t)b * SEQ + (dir ? (SEQ - 1 - (128 * c + iq)) : (128 * c + iq));
#pragma unroll 1
            for (int hf = 0; hf < 2; ++hf) {
                f32x4 y[4];
#pragma unroll
                for (int d4 = 0; d4 < 4; ++d4) { const int dvt = hf * 4 + d4; y[d4] = (f32x4){0.f, 0.f, 0.f, 0.f};
#pragma unroll
                    for (int ks = 0; ks < 2; ++ks) { const bf16x8 sf = *(const LAS bf16x8*)(Stl + (16 * dvt + l15) * LQ + ks * 32 + 8 * g4);
                        y[d4] = __builtin_amdgcn_mfma_f32_16x16x32_bf16(sf, qf[ks], y[d4], 0, 0, 0); }
                    y[d4] = y[d4] * qd; }
#pragma unroll
                for (int s2 = 0; s2 < 4; ++s2) {
                    if (2 * s2 <= w) {
#pragma unroll
                        for (int d4 = 0; d4 < 4; ++d4) { const int dvt = hf * 4 + d4;
                            LAS bf16_t* va = Vl + (32 * s2 + 4 * g4 + ((F.lane >> 2) & 3)) * LV + 16 * dvt + 4 * (F.lane & 3);
                            const s16x4 lo = __builtin_amdgcn_ds_read_tr16_b64_v4i16((LAS s16x4*)va), hi = __builtin_amdgcn_ds_read_tr16_b64_v4i16((LAS s16x4*)(va + 16 * LV));
                            const bf16x8 vf = {lo[0], lo[1], lo[2], lo[3], hi[0], hi[1], hi[2], hi[3]};
                            y[d4] = __builtin_amdgcn_mfma_f32_16x16x32_bf16(vf, pf[s2], y[d4], 0, 0, 0);
                        }
                    }
                }
                bf16_t* dst = YR + tokq * DM + hh * 128 + hf * 64 + 4 * g4;
#pragma unroll
                for (int d4 = 0; d4 < 4; ++d4) { u32x2 wv; wv.x = pk2(y[d4][0], y[d4][1]); wv.y = pk2(y[d4][2], y[d4][3]); *(u32x2*)(dst + 16 * d4) = wv; }
            }
            f32x4 nu[4];
#pragma unroll
            for (int dkt = 0; dkt < 4; ++dkt) nu[dkt] = (f32x4){0.f, 0.f, 0.f, 0.f};
#pragma unroll 1
            for (int s2 = 0; s2 < 4; ++s2) {
                LAS bf16_t* va = Vl + (32 * s2 + 8 * g4 + ((F.lane >> 2) & 3)) * LV + 16 * w + 4 * (F.lane & 3);
                const s16x4 vlo = __builtin_amdgcn_ds_read_tr16_b64_v4i16((LAS s16x4*)va), vhi = __builtin_amdgcn_ds_read_tr16_b64_v4i16((LAS s16x4*)(va + 4 * LV));
                float kd[8]; kd[0] = __expf(lg * (float)(127 - (32 * s2 + 8 * g4)));
#pragma unroll
                for (int e = 1; e < 8; ++e) kd[e] = kd[e - 1] * ginv;
                u32x4 vw;
                vw.x = pk2(bf2f((unsigned short)vlo[0]) * kd[0], bf2f((unsigned short)vlo[1]) * kd[1]); vw.y = pk2(bf2f((unsigned short)vlo[2]) * kd[2], bf2f((unsigned short)vlo[3]) * kd[3]);
                vw.z = pk2(bf2f((unsigned short)vhi[0]) * kd[4], bf2f((unsigned short)vhi[1]) * kd[5]); vw.w = pk2(bf2f((unsigned short)vhi[2]) * kd[6], bf2f((unsigned short)vhi[3]) * kd[7]);
                const bf16x8 vf = *reinterpret_cast<bf16x8*>(&vw);
#pragma unroll
                for (int dkt = 0; dkt < 4; ++dkt) {
                    LAS bf16_t* ka = Kl + (32 * s2 + 8 * g4 + ((F.lane >> 2) & 3)) * LQ + 16 * dkt + 4 * (F.lane & 3);
                    const s16x4 klo = __builtin_amdgcn_ds_read_tr16_b64_v4i16((LAS s16x4*)ka), khi = __builtin_amdgcn_ds_read_tr16_b64_v4i16((LAS s16x4*)(ka + 4 * LQ));
                    const bf16x8 kf = {klo[0], klo[1], klo[2], klo[3], khi[0], khi[1], khi[2], khi[3]};
                    nu[dkt] = __builtin_amdgcn_mfma_f32_16x16x32_bf16(vf, kf, nu[dkt], 0, 0, 0);
                }
            }
            __syncthreads();
#pragma unroll
            for (int dkt = 0; dkt < 4; ++dkt)
#pragma unroll
                for (int rg = 0; rg < 4; ++rg) { LAS float* sp = Stf + (16 * w + 4 * g4 + rg) * 64 + 16 * dkt + l15; const float sv = *sp * cdec + nu[dkt][rg]; *sp = sv;
                    Stl[(16 * w + 4 * g4 + rg) * LQ + 16 * dkt + l15] = (bf16_t)f2bf(sv); }
        }
        __syncthreads();
#undef RET_LOAD
    }
}
__device__ __forceinline__ void phase_ret_final(Frame& F0, int layer) {
    Frame F = mkframe(F0);
    const bf16_t* YF = (const bf16_t*)(WSP() + WS_YRF); const bf16_t* YBk = (const bf16_t*)(WSP() + WS_YRB); const bf16_t* PL = (const bf16_t*)(WSP() + WS_PLAIN);
    bf16_t* Y = (bf16_t*)(WSP() + WS_YRET); const float* rn = GP(const float, ret_norm) + layer * DM;
    float rnv[16];
#pragma unroll
    for (int j = 0; j < 16; ++j) rnv[j] = rn[F.lane * 16 + j];
    for (int t0 = F.gw; t0 < T; t0 += 2 * F.ngw) {
        u32x4 ra[2][2], rc[2][2], rg[2][2];
#pragma unroll
        for (int k = 0; k < 2; ++k) { const int t = t0 + k * F.ngw;
#pragma unroll
            for (int h2 = 0; h2 < 2; ++h2) { ra[k][h2] = (u32x4){0u, 0u, 0u, 0u}; rc[k][h2] = ra[k][h2]; rg[k][h2] = ra[k][h2];
                if (t < T) { ra[k][h2] = *((const u32x4*)(YF + (size_t)t * DM) + F.lane * 2 + h2); rc[k][h2] = *((const u32x4*)(YBk + (size_t)t * DM) + F.lane * 2 + h2);
                    rg[k][h2] = *((const u32x4*)(PL + (size_t)t * PLAIN_W + PC_RG) + F.lane * 2 + h2); } } }
#pragma unroll
        for (int k = 0; k < 2; ++k) { const int t = t0 + k * F.ngw; if (t >= T) continue;
            float v[16];
#pragma unroll
            for (int h2 = 0; h2 < 2; ++h2) { const unsigned aw[4] = {ra[k][h2].x, ra[k][h2].y, ra[k][h2].z, ra[k][h2].w}, cw[4] = {rc[k][h2].x, rc[k][h2].y, rc[k][h2].z, rc[k][h2].w};
#pragma unroll
                for (int j = 0; j < 4; ++j) { v[h2 * 8 + 2 * j] = bf2f(aw[j] & 0xffffu) + bf2f(cw[j] & 0xffffu); v[h2 * 8 + 2 * j + 1] = bf2f(aw[j] >> 16) + bf2f(cw[j] >> 16); } }
            float s = 0.f;
#pragma unroll
            for (int j = 0; j < 16; ++j) s += v[j];
            s = sum8(s);
            const float mu = s * (1.0f / 128.0f); float q = 0.f;
#pragma unroll
            for (int j = 0; j < 16; ++j) { v[j] -= mu; q += v[j] * v[j]; }
            q = sum8(q);
            const float rstd = __builtin_amdgcn_rsqf(q * (1.0f / 128.0f) + EPS);
            u32x4 o[2];
#pragma unroll
            for (int h2 = 0; h2 < 2; ++h2) { const unsigned gq[4] = {rg[k][h2].x, rg[k][h2].y, rg[k][h2].z, rg[k][h2].w}; unsigned ow[4];
#pragma unroll
                for (int j = 0; j < 4; ++j)
                    ow[j] = pk2(v[h2 * 8 + 2 * j] * rstd * rnv[h2 * 8 + 2 * j] * bf2f(gq[j] & 0xffffu), v[h2 * 8 + 2 * j + 1] * rstd * rnv[h2 * 8 + 2 * j + 1] * bf2f(gq[j] >> 16));
                o[h2] = (u32x4){ow[0], ow[1], ow[2], ow[3]}; }
            *((u32x4*)(Y + (size_t)t * DM) + F.lane * 2) = o[0]; *((u32x4*)(Y + (size_t)t * DM) + F.lane * 2 + 1) = o[1]; }
    }
}

__global__ void __launch_bounds__(512, 2) fwd_kernel(Params P) {
    extern __shared__ __attribute__((aligned(16))) unsigned char lds_raw[];
    Frame F = mkframe0((LAS unsigned char*)lds_raw);
    {
        volatile LAS unsigned* misc = (volatile LAS unsigned*)(F.lds + LDS_MISC);
        if (F.tid < 64) misc[F.tid] = 0u;
        if (F.tid < (int)(sizeof(Params) / 4)) ((volatile LAS unsigned*)(F.lds + LDS_PTRS))[F.tid] = ((const unsigned*)&P)[F.tid];
        __syncthreads();
        (void)xcd_barrier_post((unsigned*)(WSP() + WS_CTL) + 4096, misc + 8, F.wave);
    }
#define GRID_BAR() do { XcdBarrier b_; b_.bar = (unsigned*)(WSP() + WS_CTL) + 4096; b_.x = (unsigned)__builtin_amdgcn_readfirstlane(opaque((int)xb_xcc_id())); \
        b_.st = (volatile LAS unsigned*)(F.lds + LDS_MISC) + 8; b_.w = F.wave; xcd_barrier(b_); if (DUPN == 100) xcd_barrier(b_); } while (0)
#define WSB(off) (WSP() + (off))
#define MODL (((const float*)WSB(WS_MOD)) + (size_t)layer * 8 * 6144)
#define XOUT GP(float, out)
    const int bx = blockIdx.x;

    PH(0) p0_convert(F, false, 0);
    PH(1) p0_tables(F);
    GRID_BAR();
    PH(1) p0_modreduce(F);
    GRID_BAR();

    for (int layer = 0; layer < DEPTH; ++layer) {
        PH(2) {
            if (layer > 0 && ((layer - 1) & 1)) {
                const float* modp = ((const float*)WSB(WS_MOD)) + (size_t)(layer - 1) * 8 * 6144;
                phase_norm<true, false, false, true>(F, nullptr, GP(const float, norm_mix) + layer * DM, MODL + 1024, MODL, modp + 5 * 1024, nullptr);
            } else {
                phase_norm<false, false, false, true>(F, nullptr, GP(const float, norm_mix) + layer * DM, MODL + 1024, MODL, nullptr, nullptr);
            }
        }
        PH(0) if (layer == 2) p0_convert(F, true, 1);
        GRID_BAR();
        PH(3) {
            pg8::Gemm g{(const bf16_t*)WSB(WS_H), (const bf16_t*)(WSB(WS_WIN) + (size_t)layer * NIN * DM), DM / 2, DM / 2, DM / 2};
            pg8::StaticOrder S; S.init(T / 256, NIN / 256, F.G, bx);
            EpiIn E{(bf16_t*)WSB(WS_PLAIN), (bf16_t*)WSB(WS_ROPE), (float*)WSB(WS_SSQ), (const unsigned*)WSB(WS_COS), 1.f / WIN_SC};
            pg8::gemm_phase8(F.lds, F.wave, g, S, E);
        }
        GRID_BAR();
        PH(4) {
            pg8::Gemm g{(const bf16_t*)WSB(WS_PLAIN) + PC_CQ, (const bf16_t*)WSB(WS_WUQ) + (size_t)layer * QW * 768, PLAIN_W, 768, 768};
            pg8::QKVOrder S; S.sq.init(T / 256, QW / 256, F.G, bx); S.sk.init(T / 256, KVW / 256, F.G, 0);
            S.akv = (size_t)(PC_CKV - PC_CQ) * 2; S.bkv = (size_t)(WS_WUKV - WS_WUQ) + ((size_t)layer * KVW * 768 - (size_t)layer * QW * 768) * 2;
            EpiQKV E{EpiQ{(bf16_t*)WSB(WS_Q), (const float*)WSB(WS_SSQ), (const unsigned*)WSB(WS_COS), 0.07216878364870322f * 1.4426950408889634f},
                     EpiKV{(bf16_t*)WSB(WS_KV), (const float*)WSB(WS_SSQ)}};
            pg8::gemm_phase(F.lds, F.wave, g, S, E);
        }
        PH(6) phase_retention(F, layer);
        PH(7) phase_dilated(F);
        GRID_BAR();
        PH(8) phase_mla(F);
        PH(9) phase_dil_merge(F);
        PH(9) phase_ret_final(F, layer);
        GRID_BAR();
        PH(10) {
            static_assert(WS_YDIL == WS_YMLA + 32 * MiB && WS_YRET == WS_YMLA + 64 * MiB && WS_WBD == WS_WBM + 8 * MiB && WS_WBR == WS_WBM + 16 * MiB, "branch operand layout");
            pg8::BranchOrder S; S.base.init(T / 256, DM / 256, F.G, bx);
            pg8::Gemm g{(const bf16_t*)WSB(WS_YMLA), (const bf16_t*)WSB(WS_WBM) + (size_t)layer * DM * DM, DM, DM, DM};
            EpiBr E{(bf16_t*)WSB(WS_MF), (bf16_t*)WSB(WS_MB), WSB(WS_PLAIN) + PC_GA * 2};
            pg8::gemm_phase(F.lds, F.wave, g, S, E);
        }
        GRID_BAR();
        PH(11) {
            pg8::Gemm g{(const bf16_t*)WSB(WS_MB), (const bf16_t*)WSB(WS_WO) + (size_t)layer * DM * DM, DM, DM, DM};
            pg8::StaticOrder S; S.init(T / 256, DM / 256, F.G, bx);
            EpiRes E{(bf16_t*)WSB(WS_X), MODL + 2 * 1024, 1.f};
            pg8::gemm_phase(F.lds, F.wave, g, S, E);
        }
        GRID_BAR();
        PH(12) {
            if (layer & 1) phase_norm<false, true, false, true>(F, nullptr, GP(const float, norm_ffn) + layer * DM, MODL + 4 * 1024, MODL + 3 * 1024, nullptr, GP(const float, moe_router) + (size_t)(layer >> 1) * DM * 8);
            else phase_norm<false, false, false, false>(F, nullptr, GP(const float, norm_ffn) + layer * DM, MODL + 4 * 1024, MODL + 3 * 1024, nullptr, nullptr);
        }
        GRID_BAR();
        if (!(layer & 1)) {
            const int fi = layer >> 1;
            PH(13) { pg8::Gemm g{(const bf16_t*)WSB(WS_H), (const bf16_t*)WSB(WS_W13) + (size_t)fi * 5632 * DM, DM, DM, DM};
              pg8::StaticOrder S; S.init(T / 256, 5632 / 256, F.G, bx);
              EpiSwi E{(bf16_t*)WSB(WS_HID), DFF}; pg8::gemm_phase(F.lds, F.wave, g, S, E); }
            GRID_BAR();
            PH(14) { pg8::Gemm g{(const bf16_t*)WSB(WS_HID), (const bf16_t*)WSB(WS_W2) + (size_t)fi * DM * DFF, DFF, DFF, DFF};
              pg8::StaticOrder S; S.init(T / 256, DM / 256, F.G, bx);
              EpiRes E{(bf16_t*)WSB(WS_X), MODL + 5 * 1024, 1.f}; pg8::gemm_phase(F.lds, F.wave, g, S, E); }
            GRID_BAR();
        } else {
            PH(15) phase_moe_gather(F);
            GRID_BAR();
            PH(16) { const int* moei = (const int*)WSB(WS_MOEI); const int nblk = __builtin_amdgcn_readfirstlane(__hip_atomic_load(moei + MI_BLK, __ATOMIC_RELAXED, __HIP_MEMORY_SCOPE_AGENT));
              pg8::Gemm g{(const bf16_t*)WSB(WS_XG), (const bf16_t*)WSB(WS_W13E), DM / 2, DM / 2, DM / 2};
              pg8::StaticOrder S; S.init(nblk, 7168 / 256, F.G, bx); S.blk_exp = moei + MI_BLK + 1; S.estride = (size_t)7168 * (DM / 2);
              EpiSwi8 E{WSB(WS_HID), DFE, 1.f / W13E_SC, HID8_SC}; pg8::gemm_phase8(F.lds, F.wave, g, S, E); }
            GRID_BAR();
            PH(17) { const int* moei = (const int*)WSB(WS_MOEI); const int nblk = __builtin_amdgcn_readfirstlane(__hip_atomic_load(moei + MI_BLK, __ATOMIC_RELAXED, __HIP_MEMORY_SCOPE_AGENT));
              pg8::Gemm g{(const bf16_t*)WSB(WS_HID), (const bf16_t*)WSB(WS_W2E), DFE / 2, DFE / 2, DFE / 2};
              pg8::TailOrder S; S.init(MOE_MAIN_BLK, DM / 256, F.G, bx); S.blk_exp = moei + MI_BLK + 1; S.estride = (size_t)DM * (DFE / 2);
              S.nNr = DM / 256; S.ksub = DFE / 2 / pg8::KT_SPLIT; S.ntail = (nblk - MOE_MAIN_BLK) * (DM / 256) * pg8::KT_SPLIT;
              EpiPlain E{(bf16_t*)WSB(WS_YB), DM, DM / 256, (bf16_t*)WSB(WS_XG), 1.f / (W2E_SC * HID8_SC), MOE_MAIN_BLK, (size_t)MOE_TAIL_ROWS * DM}; pg8::gemm_phase8(F.lds, F.wave, g, S, E); }
            GRID_BAR();
        }
    }
    PH(18) {
        const float* modp = ((const float*)WSB(WS_MOD)) + (size_t)3 * 8 * 6144;
        phase_norm<true, false, true, false>(F, XOUT, GP(const float, final_norm), nullptr, nullptr, modp + 5 * 1024, nullptr);
    }
}

extern "C" void kernel_launch(void* const* d_in, const int* in_sizes, int n_in, void* d_out, int out_size, void* d_ws, size_t ws_size, hipStream_t stream) {
    static int grid = 0;
    if (grid == 0) {
        if (n_in != 26 || in_sizes[0] != T * DM || out_size != T * DM || ws_size < WS_END) {
            fprintf(stderr, "kernel_launch: unexpected shapes / workspace: n_in %d in0 %d out %d ws %zu (need %zu)\n", n_in, n_in > 0 ? in_sizes[0] : -1, out_size, ws_size, (size_t)WS_END);
            grid = -1; return; }
        int dev = 0, cus = 0, per_cu = 0;
        if (hipGetDevice(&dev) != hipSuccess || hipDeviceGetAttribute(&cus, hipDeviceAttributeMultiprocessorCount, dev) != hipSuccess) { grid = -1; return; }
        if (hipFuncSetAttribute((const void*)fwd_kernel, hipFuncAttributeMaxDynamicSharedMemorySize, LDS_BYTES) != hipSuccess) { fprintf(stderr, "kernel_launch: hipFuncSetAttribute failed\n"); grid = -1; return; }
        if (hipOccupancyMaxActiveBlocksPerMultiprocessor(&per_cu, (const void*)fwd_kernel, 512, LDS_BYTES) != hipSuccess || per_cu < 1) {
            fprintf(stderr, "kernel_launch: occupancy query reports %d blocks per CU\n", per_cu); (void)hipGetLastError(); grid = -1; return; }
        grid = cus;
    }
    if (grid < 0) return;
    (void)hipMemsetAsync((char*)d_ws + WS_CTL, 0, CTL_BYTES, stream);
    Params p{};
    const float* const* fin = (const float* const*)d_in;
    p.x = fin[0]; p.c = fin[1]; p.positions = (const int*)d_in[2]; p.ada_w = fin[3]; p.ada_b = fin[4]; p.norm_mix = fin[5]; p.norm_ffn = fin[6]; p.w_in = fin[7];
    p.q_norm = fin[8]; p.w_uq = fin[9]; p.kv_norm = fin[10]; p.w_ukv = fin[11]; p.ret_ld = fin[12]; p.ret_norm = fin[13];
    p.w_br_mla = fin[14]; p.w_br_dil = fin[15]; p.w_br_ret = fin[16]; p.w_out = fin[17]; p.ffn_w1 = fin[18]; p.ffn_w3 = fin[19]; p.ffn_w2 = fin[20];
    p.moe_router = fin[21]; p.moe_w1 = fin[22]; p.moe_w3 = fin[23]; p.moe_w2 = fin[24]; p.final_norm = fin[25];
    p.out = (float*)d_out; p.ws = (unsigned char*)d_ws;
    for (int i = 0; i < 32; ++i) p.inv_freq[i] = std::pow(10000.0, -(double)i / 32.0);
    hipLaunchKernelGGL(fwd_kernel, dim3(grid), dim3(512), LDS_BYTES, stream, p);
    const hipError_t le = hipPeekAtLastError();
    if (le != hipSuccess) fprintf(stderr, "kernel_launch: launch failed: %s\n", hipGetErrorName(le));
}
```
